# Optimizing an MI355X kernel written in HIP

```python
import math
import jax, jax.numpy as jnp
from jax import lax
import numpy as np

D_MODEL = 2048
BATCH = 4
SEQ = 2048
DEPTH = 4
DEC_BATCH = 16
DEC_SEQ = 64
PAST_LEN = 2048

CHUNK = 64
D_SSM = D_MODEL // 2
SSM_GROUP = 16
N_SSM_GROUPS = D_SSM // SSM_GROUP
SSM_STATE = 64
HEAD_DIM = 64
N_HEADS = (D_MODEL // 2) // HEAD_DIM
N_KV_HEADS = 4
KV_REP = N_HEADS // N_KV_HEADS
D_ATTN = N_HEADS * HEAD_DIM
D_KV = N_KV_HEADS * HEAD_DIM
IN_WIDTH = D_SSM + D_ATTN + 2 * D_KV
WINDOW = 128
WINDOW_CHUNKS = WINDOW // CHUNK
ROPE_DIM = HEAD_DIM // 4
ROPE_THETA = 500000.0
D_FF = ((8 * D_MODEL // 3 + 255) // 256) * 256
EPS = 1e-6

kernel_name = 'hybrid_s5_swa_streaming_step'


def rms_norm(x, g):
    xf = x.astype(jnp.float32)
    y = xf * lax.rsqrt(jnp.mean(xf * xf, axis=-1, keepdims=True) + EPS)
    return (y * g.astype(jnp.float32)).astype(x.dtype)


def partial_rope(x, pos):
    half = ROPE_DIM // 2
    inv_freq = ROPE_THETA ** (-jnp.arange(half, dtype=jnp.float32) / half)
    ang = pos.astype(jnp.float32)[:, None] * inv_freq[None, :]
    cos = jnp.cos(ang)[None, :, None, :]
    sin = jnp.sin(ang)[None, :, None, :]
    xr = x[..., :ROPE_DIM].astype(jnp.float32)
    x1, x2 = xr[..., :half], xr[..., half:]
    rot = jnp.concatenate([x1 * cos - x2 * sin, x2 * cos + x1 * sin], axis=-1)
    return jnp.concatenate([rot.astype(x.dtype), x[..., ROPE_DIM:]], axis=-1)


def s5_discretize(a_re, a_im, log_dt, b_re, b_im):
    a_re = a_re.astype(jnp.float32)
    a_im = a_im.astype(jnp.float32)
    dt = jnp.exp(log_dt.astype(jnp.float32))[:, None]
    z_re, z_im = a_re * dt, a_im * dt
    mag = jnp.exp(z_re)
    l_re, l_im = mag * jnp.cos(z_im), mag * jnp.sin(z_im)
    den = a_re * a_re + a_im * a_im
    n_re = l_re - 1.0
    f_re = (n_re * a_re + l_im * a_im) / den
    f_im = (l_im * a_re - n_re * a_im) / den
    b_re = b_re.astype(jnp.float32)
    b_im = b_im.astype(jnp.float32)
    bb_re = f_re[..., None] * b_re - f_im[..., None] * b_im
    bb_im = f_re[..., None] * b_im + f_im[..., None] * b_re
    return z_re, z_im, l_re, l_im, bb_re, bb_im


def _complex_affine_combine(e1, e2):
    a1r, a1i, b1r, b1i = e1
    a2r, a2i, b2r, b2i = e2
    return (a1r * a2r - a1i * a2i,
            a1r * a2i + a1i * a2r,
            a2r * b1r - a2i * b1i + b2r,
            a2r * b1i + a2i * b1r + b2i)


def s5_mixer(u, a_re, a_im, log_dt, b_re, b_im, c_re, c_im, d_skip, w_glu, b_glu, h0):
    bsz, t_len, _ = u.shape
    z_re, z_im, l_re, l_im, bb_re, bb_im = s5_discretize(a_re, a_im, log_dt, b_re, b_im)
    uf = u.astype(jnp.float32)
    ug = uf.reshape(bsz, t_len, N_SSM_GROUPS, SSM_GROUP)
    bu_re = jnp.einsum('btgc,gpc->btgp', ug, bb_re)
    bu_im = jnp.einsum('btgc,gpc->btgp', ug, bb_im)
    a_re_b = jnp.broadcast_to(l_re, bu_re.shape)
    a_im_b = jnp.broadcast_to(l_im, bu_im.shape)
    _, _, h_re, h_im = lax.associative_scan(_complex_affine_combine,
                                            (a_re_b, a_im_b, bu_re, bu_im), axis=1)
    if h0 is not None:
        steps = jnp.arange(1, t_len + 1, dtype=jnp.float32)[:, None, None]
        mag = jnp.exp(z_re[None] * steps)
        ang = z_im[None] * steps
        p_re, p_im = mag * jnp.cos(ang), mag * jnp.sin(ang)
        h0_re = h0[0].astype(jnp.float32)[:, None]
        h0_im = h0[1].astype(jnp.float32)[:, None]
        h_re = h_re + p_re * h0_re - p_im * h0_im
        h_im = h_im + p_re * h0_im + p_im * h0_re
    y = (jnp.einsum('btgp,gcp->btgc', h_re, c_re.astype(jnp.float32))
         - jnp.einsum('btgp,gcp->btgc', h_im, c_im.astype(jnp.float32)))
    y = y.reshape(bsz, t_len, D_SSM) + d_skip.astype(jnp.float32) * uf
    z = jax.nn.gelu(y)
    out = z * jax.nn.sigmoid(z @ w_glu.astype(jnp.float32) + b_glu.astype(jnp.float32))
    return out.astype(u.dtype), h_re[:, -1], h_im[:, -1]


def banded_attention(q, k, v, valid, sink):
    s = jnp.einsum('bnqhrd,bnkhd->bnhrqk', q.astype(jnp.float32), k.astype(jnp.float32))
    s = s * (HEAD_DIM ** -0.5)
    s = jnp.where(valid[None, :, None, None, None, :], s, -1e30)
    sk = sink.astype(jnp.float32).reshape(1, 1, N_KV_HEADS, KV_REP, 1, 1)
    m = jnp.maximum(jnp.max(s, axis=-1, keepdims=True), sk)
    p = jnp.exp(s - m)
    den = jnp.sum(p, axis=-1, keepdims=True) + jnp.exp(sk - m)
    return jnp.einsum('bnhrqk,bnkhd->bnqhrd', p / den, v.astype(jnp.float32))


def chunk_windows(t, n_chunks):
    bsz = t.shape[0]
    tc = t.reshape(bsz, n_chunks, CHUNK, N_KV_HEADS, HEAD_DIM)
    tp = jnp.pad(tc, ((0, 0), (WINDOW_CHUNKS, 0), (0, 0), (0, 0), (0, 0)))
    return jnp.concatenate([tp[:, i:i + n_chunks] for i in range(WINDOW_CHUNKS + 1)], axis=2)


def layer(x, c, pos, p, kv_cache, ssm_state):
    bsz, t_len, _ = x.shape
    mod = (c @ p['w_mod'] + p['b_mod'])[:, None, :]
    sh1, sc1, g1, sh2, sc2, g2 = jnp.split(mod, 6, axis=-1)
    h = rms_norm(x, p['norm1_g']) * (1 + sc1) + sh1
    proj = h @ p['w_in']
    u = proj[..., :D_SSM]
    q = proj[..., D_SSM:D_SSM + D_ATTN].reshape(bsz, t_len, N_HEADS, HEAD_DIM)
    k = proj[..., D_SSM + D_ATTN:D_SSM + D_ATTN + D_KV].reshape(bsz, t_len, N_KV_HEADS, HEAD_DIM)
    v = proj[..., D_SSM + D_ATTN + D_KV:].reshape(bsz, t_len, N_KV_HEADS, HEAD_DIM)
    q = partial_rope(rms_norm(q, p['q_norm_g']), pos)
    k = partial_rope(rms_norm(k, p['k_norm_g']), pos)

    ssm_out, s_re, s_im = s5_mixer(u, p['ssm_a_re'], p['ssm_a_im'], p['ssm_log_dt'],
                                   p['ssm_b_re'], p['ssm_b_im'], p['ssm_c_re'], p['ssm_c_im'],
                                   p['ssm_d'], p['w_glu'], p['b_glu'], ssm_state)

    if kv_cache is None:
        n_chunks = t_len // CHUNK
        qc = q.reshape(bsz, n_chunks, CHUNK, N_KV_HEADS, KV_REP, HEAD_DIM)
        key_chunk = (jnp.arange(n_chunks)[:, None] - WINDOW_CHUNKS
                     + jnp.arange((WINDOW_CHUNKS + 1) * CHUNK)[None, :] // CHUNK)
        valid = key_chunk >= 0
        o = banded_attention(qc, chunk_windows(k, n_chunks), chunk_windows(v, n_chunks),
                             valid, p['attn_sink'])
        new_k, new_v = k[:, -WINDOW:], v[:, -WINDOW:]
    else:
        kk = jnp.concatenate([kv_cache[0].astype(k.dtype), k], axis=1)
        vv = jnp.concatenate([kv_cache[1].astype(v.dtype), v], axis=1)
        qc = q.reshape(bsz, 1, t_len, N_KV_HEADS, KV_REP, HEAD_DIM)
        valid = jnp.ones((1, kk.shape[1]), dtype=bool)
        o = banded_attention(qc, kk[:, None], vv[:, None], valid, p['attn_sink'])
        new_k, new_v = kk[:, -WINDOW:], vv[:, -WINDOW:]
    attn_out = o.reshape(bsz, t_len, D_ATTN).astype(x.dtype)

    gates = jax.nn.sigmoid(h @ p['w_gate'] + p['b_gate'])
    gate_a, gate_b = jnp.split(gates, 2, axis=-1)
    mixed = gate_a * (ssm_out @ p['w_proj_ssm']) + gate_b * (attn_out @ p['w_proj_attn'])
    x = x + g1 * (mixed @ p['w_out'])

    h2 = rms_norm(x, p['norm2_g']) * (1 + sc2) + sh2
    ffn = (jax.nn.silu(h2 @ p['w_ffn_gate']) * (h2 @ p['w_ffn_up'])) @ p['w_ffn_down']
    x = x + g2 * ffn
    return x, new_k, new_v, s_re, s_im


def setup_inputs(seed: int = 0) -> dict:
    key = jax.random.key(seed)
    keys = iter(jax.random.split(key, 48))
    f32 = jnp.float32

    def nrm(shape, scale):
        return scale * jax.random.normal(next(keys), shape, f32)

    def gain(shape):
        return 1.0 + nrm(shape, 0.02)

    L, G, P = DEPTH, N_SSM_GROUPS, SSM_STATE
    a_im_init = math.pi * jnp.arange(P, dtype=f32)
    return {
        'x_prompt': nrm((BATCH, SEQ, D_MODEL), 1.0),
        'x_sample': nrm((DEC_BATCH, DEC_SEQ, D_MODEL), 1.0),
        'cache_k': nrm((DEPTH, DEC_BATCH, WINDOW, N_KV_HEADS, HEAD_DIM), 1.0),
        'cache_v': nrm((DEPTH, DEC_BATCH, WINDOW, N_KV_HEADS, HEAD_DIM), 1.0),
        'state_ssm_re': nrm((DEPTH, DEC_BATCH, G, P), 0.1),
        'state_ssm_im': nrm((DEPTH, DEC_BATCH, G, P), 0.1),
        'c_prompt': nrm((BATCH, D_MODEL), 1.0),
        'c_sample': nrm((DEC_BATCH, D_MODEL), 1.0),
        'w_mod': nrm((L, D_MODEL, 6 * D_MODEL), 0.2 * D_MODEL ** -0.5),
        'b_mod': nrm((L, 6 * D_MODEL), 0.01),
        'norm1_g': gain((L, D_MODEL)),
        'norm2_g': gain((L, D_MODEL)),
        'w_in': nrm((L, D_MODEL, IN_WIDTH), D_MODEL ** -0.5),
        'ssm_a_re': -0.5 + nrm((L, G, P), 0.01),
        'ssm_a_im': a_im_init[None, None, :] + nrm((L, G, P), 0.01),
        'ssm_log_dt': jax.random.uniform(next(keys), (L, G), f32, math.log(1e-3), math.log(1e-1)),
        'ssm_b_re': nrm((L, G, P, SSM_GROUP), (0.5 / SSM_GROUP) ** 0.5),
        'ssm_b_im': nrm((L, G, P, SSM_GROUP), (0.5 / SSM_GROUP) ** 0.5),
        'ssm_c_re': nrm((L, G, SSM_GROUP, P), (0.5 / P) ** 0.5),
        'ssm_c_im': nrm((L, G, SSM_GROUP, P), (0.5 / P) ** 0.5),
        'ssm_d': nrm((L, D_SSM), 0.5),
        'w_glu': nrm((L, D_SSM, D_SSM), D_SSM ** -0.5),
        'b_glu': nrm((L, D_SSM), 0.01),
        'q_norm_g': gain((L, HEAD_DIM)),
        'k_norm_g': gain((L, HEAD_DIM)),
        'attn_sink': nrm((L, N_HEADS), 0.5),
        'w_gate': nrm((L, D_MODEL, 2 * D_MODEL), D_MODEL ** -0.5),
        'b_gate': nrm((L, 2 * D_MODEL), 0.01),
        'w_proj_ssm': nrm((L, D_SSM, D_MODEL), D_SSM ** -0.5),
        'w_proj_attn': nrm((L, D_ATTN, D_MODEL), D_ATTN ** -0.5),
        'w_out': nrm((L, D_MODEL, D_MODEL), D_MODEL ** -0.5),
        'w_ffn_gate': nrm((L, D_MODEL, D_FF), D_MODEL ** -0.5),
        'w_ffn_up': nrm((L, D_MODEL, D_FF), D_MODEL ** -0.5),
        'w_ffn_down': nrm((L, D_FF, D_MODEL), D_FF ** -0.5),
    }


def reference(x_prompt, x_sample, cache_k, cache_v, state_ssm_re, state_ssm_im, c_prompt, c_sample,
              w_mod, b_mod, norm1_g, norm2_g, w_in, ssm_a_re, ssm_a_im, ssm_log_dt, ssm_b_re, ssm_b_im,
              ssm_c_re, ssm_c_im, ssm_d, w_glu, b_glu, q_norm_g, k_norm_g, attn_sink, w_gate, b_gate,
              w_proj_ssm, w_proj_attn, w_out, w_ffn_gate, w_ffn_up, w_ffn_down):
    pos_prompt = jnp.arange(x_prompt.shape[1])
    pos_sample = PAST_LEN + jnp.arange(x_sample.shape[1])
    xp, xs = x_prompt, x_sample
    pk, pv, pre, pim = [], [], [], []
    sk, sv, sre, sim = [], [], [], []
    for l in range(DEPTH):
        p = {
            'w_mod': w_mod[l], 'b_mod': b_mod[l], 'norm1_g': norm1_g[l], 'norm2_g': norm2_g[l],
            'w_in': w_in[l], 'ssm_a_re': ssm_a_re[l], 'ssm_a_im': ssm_a_im[l],
            'ssm_log_dt': ssm_log_dt[l], 'ssm_b_re': ssm_b_re[l], 'ssm_b_im': ssm_b_im[l],
            'ssm_c_re': ssm_c_re[l], 'ssm_c_im': ssm_c_im[l], 'ssm_d': ssm_d[l],
            'w_glu': w_glu[l], 'b_glu': b_glu[l], 'q_norm_g': q_norm_g[l], 'k_norm_g': k_norm_g[l],
            'attn_sink': attn_sink[l], 'w_gate': w_gate[l], 'b_gate': b_gate[l],
            'w_proj_ssm': w_proj_ssm[l], 'w_proj_attn': w_proj_attn[l], 'w_out': w_out[l],
            'w_ffn_gate': w_ffn_gate[l], 'w_ffn_up': w_ffn_up[l], 'w_ffn_down': w_ffn_down[l],
        }
        xp, k_p, v_p, re_p, im_p = layer(xp, c_prompt, pos_prompt, p, None, None)
        xs, k_s, v_s, re_s, im_s = layer(xs, c_sample, pos_sample, p,
                                         (cache_k[l], cache_v[l]),
                                         (state_ssm_re[l], state_ssm_im[l]))
        pk.append(k_p); pv.append(v_p); pre.append(re_p); pim.append(im_p)
        sk.append(k_s); sv.append(v_s); sre.append(re_s); sim.append(im_s)
    return (xp, xs,
            jnp.stack(pk), jnp.stack(pv), jnp.stack(pre), jnp.stack(pim),
            jnp.stack(sk), jnp.stack(sv), jnp.stack(sre), jnp.stack(sim))
```

```cpp
#include <hip/hip_runtime.h>
#include <cstdio>
#include <cstdint>
#define GAS __attribute__((address_space(1)))
namespace pg8 {
#define PG8_LAS __attribute__((address_space(3)))
typedef unsigned short bf16_t;
typedef short bf16x8 __attribute__((ext_vector_type(8)));
typedef float f32x4 __attribute__((ext_vector_type(4)));
typedef unsigned u32x4 __attribute__((ext_vector_type(4)));
constexpr int BM = 256, BK = 64, HALF = 128, HTB = HALF * BK * 2  , STAGE_BYTES = 8 * HTB, NXCD = 8, WGM = 6;

__host__ __device__ __forceinline__ int lds_byte(int r, int c) { const int st = (r >> 4) * 2 + (c >> 5), rr = r & 15, cc = c & 31, ob = rr * 64 + cc * 2; return st * 1024 + (ob ^ (((ob >> 9) & 1) << 5)); }
__host__ __device__ __forceinline__ void stage_rc(int b, int& R, int& C) { const int st = b / 1024, sb = b % 1024, swz = sb ^ (((sb >> 9) & 1) << 5); R = (st >> 1) * 16 + swz / 64; C = (st & 1) * 32 + (swz % 64) / 2; }
__host__ __device__ __forceinline__ int perm32(int rho) { const int n = rho >> 4, i = rho & 15; return 8 * (i >> 2) + 4 * n + (i & 3); }

#ifndef SPLIT_SWAP
#define SPLIT_SWAP 0
#endif
#ifndef ORD_TR
#define ORD_TR 0
#endif
#ifndef KROT
#define KROT 0
#endif
struct Unit { int pm, pn, kt0, nkt, slab, krot; };
struct Gemm { const bf16_t* A; const bf16_t* Bt; int M, N, K; };

struct StaticOrder {
    int nM, nN, nwg, G, c, nkt;
    __host__ __device__ void init(int M, int N, int K, int G_, int c_) { nM = M / BM; nN = N / BM; nwg = nM * nN; G = G_; c = c_; nkt = K / BK; }
    __host__ __device__ bool next(int i, Unit& u) const {
        const long L = (long)i * G + c; if (L >= nwg) return false;
        int wgid = (int)L; { const int q = nwg / NXCD, r = nwg % NXCD, xcd = wgid % NXCD, off = wgid / NXCD; wgid = (xcd < r ? xcd * (q + 1) : r * (q + 1) + (xcd - r) * q) + off; }
        if (ORD_TR > 0) {
            const int nig = ORD_TR * nM, gid = wgid / nig, fn = gid * ORD_TR, gsz = (nN - fn) < ORD_TR ? (nN - fn) : ORD_TR;
            u.pn = fn + ((wgid % nig) % gsz); u.pm = (wgid % nig) / gsz; u.kt0 = 0; u.nkt = nkt; u.slab = -1; u.krot = 0; return true; }
        const int nig = WGM * nN, gid = wgid / nig, fm = gid * WGM, gsz = (nM - fm) < WGM ? (nM - fm) : WGM;
        u.pm = fm + ((wgid % nig) % gsz); u.pn = (wgid % nig) / gsz; u.kt0 = 0; u.nkt = nkt; u.slab = -1; u.krot = KROT ? 2 * (((c & 7) * (nkt >> 1)) >> 3) : 0; return true;
    }
    __device__ __forceinline__ void a_ready(const Unit&) const {}
    __device__ __forceinline__ void done(const Unit&) const {}
};
struct PanelOrder {
    StaticOrder so; int nN, nkt, G, c;
    __host__ __device__ void init(int M, int N, int K, int G_, int c_) { so.init(M, N, K, G_, c_); nN = N / BM; nkt = K / BK; G = G_; c = c_; }
    __host__ __device__ bool next(int i, Unit& u) const {
        if (G != 256 || so.nM != 36) return so.next(i, u);
        const int x = c & 7, j = c >> 3, id = 32 * i + j, np = 4 * nN, ns = np >> 3;
        if (id >= np + ns) return false;
        if (id < np) { u.pm = 4 * x + (id & 3); int pn = (id >> 2) + (x * nN) / 8; u.pn = pn >= nN ? pn - nN : pn; }
        else { const int s = x * ns + (id - np); u.pm = 32 + (s & 3); u.pn = s >> 2; }
        u.kt0 = 0; u.nkt = nkt; u.slab = -1; u.krot = 0; return true;
    }
    __device__ __forceinline__ void a_ready(const Unit&) const {}
    __device__ __forceinline__ void done(const Unit&) const {}
};
struct PROrder {
    StaticOrder so; int G, c, nkt, sj0;
    __host__ __device__ void init(int M, int N, int K, int G_, int c_, int sj0_) { so.init(M, N, K, G_, c_); G = G_; c = c_; nkt = K / BK; sj0 = sj0_; }
    __host__ __device__ bool next(int i, Unit& u) const {
        if (G != 256) return so.next(i, u);
        const int x = c & 7, j = c >> 3;
        if (i == 0) { u.pm = 4 * x + (j & 3); const int pn = (j >> 2) + x; u.pn = pn & 7; }
        else if (i == 1) { const int jj = j - sj0; if (jj < 0 || jj >= 4) return false; const int s = 4 * x + jj; u.pm = 32 + (s & 3); u.pn = s >> 2; }
        else return false;
        u.kt0 = 0; u.nkt = nkt; u.slab = -1; u.krot = 0; return true;
    }
    __device__ __forceinline__ void a_ready(const Unit&) const {}
    __device__ __forceinline__ void done(const Unit&) const {}
};
struct BlockOrder {
    StaticOrder so; int nN, nkt, G, c;
    __host__ __device__ void init(int M, int N, int K, int G_, int c_) { so.init(M, N, K, G_, c_); nN = N / BM; nkt = K / BK; G = G_; c = c_; }
    __host__ __device__ bool next(int i, Unit& u) const {
        if (G != 256 || so.nM != 36 || (nN & 1)) return so.next(i, u);
        const int x = c & 7, j = c >> 3, id = 32 * i + j, hn = nN >> 1;
        if (id >= 9 * hn) return false;
        u.pm = 9 * (x >> 1) + id % 9; u.pn = (x & 1) * hn + id / 9; u.kt0 = 0; u.nkt = nkt; u.slab = -1; u.krot = 0; return true;
    }
    __device__ __forceinline__ void a_ready(const Unit&) const {}
    __device__ __forceinline__ void done(const Unit&) const {}
};
struct SplitOrder {
    int G, c, nkt;
    __host__ __device__ void init(int K, int G_, int c_) { G = G_; c = c_; nkt = K / BK; }
    __host__ __device__ bool next(int i, Unit& u) const {
        int e = i * G + c; if (e >= 512) return false;
        if (SPLIT_SWAP && G == 256 && (c & 1)) e ^= 256;
        const int f = e & 255, x = f & 7, j = f >> 3;
        if (e < 256) { u.pm = 4 * x + (j >> 3); u.pn = j & 7; u.kt0 = 0; u.nkt = nkt; u.slab = -1; u.krot = KROT ? 2 * ((x * (nkt >> 1)) >> 3) : 0; }
        else { const int np = nkt >> 1, base = np >> 3, rem = np & 7, pairs = base + (x < rem ? 1 : 0), start = x * base + (x < rem ? x : rem);
            u.pm = 32 + (j >> 3); u.pn = j & 7; u.kt0 = 2 * start; u.nkt = 2 * pairs; u.slab = x; u.krot = 0; }
        return true;
    }
    __device__ __forceinline__ void a_ready(const Unit&) const {}
    __device__ __forceinline__ void done(const Unit&) const {}
};

__device__ __forceinline__ unsigned cvt_pk_bf16(float lo, float hi) { unsigned r; asm volatile("v_cvt_pk_bf16_f32 %0, %1, %2" : "=v"(r) : "v"(lo), "v"(hi)); return r; }
typedef float f32x2 __attribute__((ext_vector_type(2)));
typedef unsigned u32x2 __attribute__((ext_vector_type(2)));
__device__ __forceinline__ float bflo(unsigned w) { return __uint_as_float(w << 16); }
__device__ __forceinline__ float bfhi(unsigned w) { return __uint_as_float(w & 0xffff0000u); }
__device__ __forceinline__ float sigmoidf_(float x) { return __builtin_amdgcn_rcpf(1.0f + __builtin_amdgcn_exp2f(-1.4426950408889634f * x)); }
__device__ __forceinline__ f32x4 sigmoid4(f32x4 v) { f32x4 o; o[0] = sigmoidf_(v[0]); o[1] = sigmoidf_(v[1]); o[2] = sigmoidf_(v[2]); o[3] = sigmoidf_(v[3]); return o; }
__device__ __forceinline__ u32x4 pack8(f32x4 v0, f32x4 v1) { u32x4 w; w.x = cvt_pk_bf16(v0[0], v0[1]); w.y = cvt_pk_bf16(v0[2], v0[3]); w.z = cvt_pk_bf16(v1[0], v1[1]); w.w = cvt_pk_bf16(v1[2], v1[3]); return w; }
#ifndef WT_STORES
#define WT_STORES 0
#endif
__device__ __forceinline__ void store16_wt(void* p, u32x4 w) {
    if (WT_STORES) asm volatile("global_store_dwordx4 %0, %1, off sc1\n\ts_nop 1" :: "v"(p), "v"(w) : "memory");
    else *(GAS u32x4*)p = w;
}
__device__ __forceinline__ void unpack8(u32x4 w, f32x4& v0, f32x4& v1) { v0 = (f32x4){bflo(w.x), bfhi(w.x), bflo(w.y), bfhi(w.y)}; v1 = (f32x4){bflo(w.z), bfhi(w.z), bflo(w.w), bfhi(w.w)}; }

constexpr int NPJ = 6656;
struct EpiG1 {
    static constexpr bool PERM = true, AFTER_DRAIN = false, IDEMPOTENT = true;
    bf16_t* P; const float* bgate; bf16_t* QN; bf16_t* KN; const float* qg; const float* kg; const float* rope; float* out; int l;
    size_t o_pk, o_pv, o_sk, o_sv;
    __device__ __forceinline__ void operator()(const f32x4 (&acc)[2][2][4][2], const Unit& u, int wr, int wc, int fr_in, int fq_in) const {
        int fr = fr_in, fq = fq_in; asm volatile("" : "+v"(fr), "+v"(fq));
        const int row0 = u.pm * BM + wr * 64 + fr;
        if (u.pn >= 4 && u.pn <= 8) {
            const bool isk = u.pn == 8;
            const float* g = isk ? kg : qg;
            f32x4 gv[2][2];
#pragma unroll
            for (int bj = 0; bj < 2; ++bj)
#pragma unroll
                for (int n = 0; n < 2; ++n) gv[bj][n] = *(const f32x4*)(g + 32 * bj + 8 * fq + 4 * n);
#pragma unroll
            for (int ai = 0; ai < 2; ++ai)
#pragma unroll
                for (int m = 0; m < 4; ++m) {
                    const int row = row0 + ai * HALF + m * 16;
                    const bool smp = row >= 8192; const int t = smp ? ((row - 8192) & 63) : (row & 2047); const int bb = smp ? ((row - 8192) >> 6) : (row >> 11);
                    const float* rt = rope + (smp ? 2048 + t : t) * 16;
                    const f32x4 c0 = *(const GAS f32x4*)(rt), c1 = *(const GAS f32x4*)(rt + 4), s0 = *(const GAS f32x4*)(rt + 8), s1 = *(const GAS f32x4*)(rt + 12);
                    f32x4 y[2][2]; float ss = 0.f;
#pragma unroll
                    for (int bj = 0; bj < 2; ++bj)
#pragma unroll
                        for (int n = 0; n < 2; ++n) { y[bj][n] = acc[ai][bj][m][n]; ss += (y[bj][n][0] * y[bj][n][0] + y[bj][n][1] * y[bj][n][1]) + (y[bj][n][2] * y[bj][n][2] + y[bj][n][3] * y[bj][n][3]); }
                    ss += __shfl_xor(ss, 16); ss += __shfl_xor(ss, 32);
                    const float rstd = 1.0f / sqrtf(ss * (1.0f / 64.0f) + 1e-6f);
#pragma unroll
                    for (int bj = 0; bj < 2; ++bj)
#pragma unroll
                        for (int n = 0; n < 2; ++n) y[bj][n] = y[bj][n] * rstd * gv[bj][n];
                    f32x4 p0, p1;
#pragma unroll
                    for (int i = 0; i < 4; ++i) { p0[i] = __shfl_xor(y[0][0][i], 16); p1[i] = __shfl_xor(y[0][1][i], 16); }
                    if (fq == 0) { y[0][0] = y[0][0] * c0 - p0 * s0; y[0][1] = y[0][1] * c1 - p1 * s1; }
                    else if (fq == 1) { y[0][0] = y[0][0] * c0 + p0 * s0; y[0][1] = y[0][1] * c1 + p1 * s1; }
                    if (!isk) { bf16_t* qp = QN + (size_t)row * 1024 + (4 * (u.pn - 4) + wc) * 64 + 8 * fq;
                        *(GAS u32x4*)(qp) = pack8(y[0][0], y[0][1]); *(GAS u32x4*)(qp + 32) = pack8(y[1][0], y[1][1]); }
                    else { const int co = wc * 64 + 8 * fq; bf16_t* kp = KN + (size_t)row * 256 + co;
                        *(GAS u32x4*)(kp) = pack8(y[0][0], y[0][1]); *(GAS u32x4*)(kp + 32) = pack8(y[1][0], y[1][1]);
                        if (smp || t >= 1920) { float* d = out + (smp ? o_sk + ((size_t)(l * 16 + bb) * 128 + 64 + t) * 256 : o_pk + ((size_t)(l * 4 + bb) * 128 + (t - 1920)) * 256) + co;
                            *(f32x4*)(d) = y[0][0]; *(f32x4*)(d + 4) = y[0][1]; *(f32x4*)(d + 32) = y[1][0]; *(f32x4*)(d + 36) = y[1][1]; } }
                }
            return;
        }
        const int col0 = u.pn * BM + wc * 32 + 8 * fq;
        const bool isg = u.pn >= 10, isv = u.pn == 9;
        f32x4 bv[2][2];
#pragma unroll
        for (int bj = 0; bj < 2; ++bj)
#pragma unroll
            for (int n = 0; n < 2; ++n) bv[bj][n] = isg ? *(const f32x4*)(bgate + (col0 - 2560) + bj * HALF + 4 * n) : (f32x4){0.f, 0.f, 0.f, 0.f};
#pragma unroll
        for (int ai = 0; ai < 2; ++ai)
#pragma unroll
            for (int m = 0; m < 4; ++m) { const int row = row0 + ai * HALF + m * 16; bf16_t* rowp = P + (size_t)row * NPJ + col0;
#pragma unroll
                for (int bj = 0; bj < 2; ++bj) { f32x4 v0 = acc[ai][bj][m][0] + bv[bj][0], v1 = acc[ai][bj][m][1] + bv[bj][1];
                    if (isg) { v0 = sigmoid4(v0); v1 = sigmoid4(v1); }
                    const u32x4 w = pack8(v0, v1); store16_wt(rowp + bj * HALF, w);
                    if (isv) { const bool smp = row >= 8192; const int t = smp ? ((row - 8192) & 63) : (row & 2047); const int bb = smp ? ((row - 8192) >> 6) : (row >> 11);
                        if (smp || t >= 1920) { float* d = out + (smp ? o_sv + ((size_t)(l * 16 + bb) * 128 + 64 + t) * 256 : o_pv + ((size_t)(l * 4 + bb) * 128 + (t - 1920)) * 256) + (col0 - 2304) + bj * HALF;
                            f32x4 r0, r1; unpack8(w, r0, r1); *(f32x4*)(d) = r0; *(f32x4*)(d + 4) = r1; } } } }
    }
};
struct EpiGLU {
    static constexpr bool PERM = true, AFTER_DRAIN = false, IDEMPOTENT = true;
    const bf16_t* Z; bf16_t* SO; const float* bglu;
    __device__ __forceinline__ void operator()(const f32x4 (&acc)[2][2][4][2], const Unit& u, int wr, int wc, int fr, int fq) const {
        const int row0 = u.pm * BM + wr * 64 + fr, col0 = u.pn * BM + wc * 32 + 8 * fq;
        f32x4 bv[2][2];
#pragma unroll
        for (int bj = 0; bj < 2; ++bj)
#pragma unroll
            for (int n = 0; n < 2; ++n) bv[bj][n] = *(const f32x4*)(bglu + col0 + bj * HALF + 4 * n);
#pragma unroll
        for (int ai = 0; ai < 2; ++ai)
#pragma unroll
            for (int m = 0; m < 4; ++m) { const size_t off = (size_t)(row0 + ai * HALF + m * 16) * 1024 + col0;
#pragma unroll
                for (int bj = 0; bj < 2; ++bj) { f32x4 z0, z1; unpack8(*(const GAS u32x4*)(Z + off + bj * HALF), z0, z1);
                    const f32x4 v0 = z0 * sigmoid4(acc[ai][bj][m][0] + bv[bj][0]), v1 = z1 * sigmoid4(acc[ai][bj][m][1] + bv[bj][1]);
                    *(GAS u32x4*)(SO + off + bj * HALF) = pack8(v0, v1); } }
    }
};
template <int MODE> struct EpiPR {
    static constexpr bool PERM = true, AFTER_DRAIN = false, IDEMPOTENT = true;
    const bf16_t* P; const bf16_t* T1; bf16_t* O; unsigned* flags;
    __device__ __forceinline__ void operator()(const f32x4 (&acc)[2][2][4][2], const Unit& u, int wr, int wc, int fr, int fq) const {
        const int row0 = u.pm * BM + wr * 64 + fr, col0 = u.pn * BM + wc * 32 + 8 * fq;
        const bool samp = u.pm >= 32;
        GAS unsigned* flag = (GAS unsigned*)(flags + 64 * (u.pn * 4 + (u.pm & 3)));
        if (MODE == 1 && samp) {
            unsigned spins = 0u;
            while (__hip_atomic_load(flag, __ATOMIC_RELAXED, __HIP_MEMORY_SCOPE_AGENT) < 8u) { __builtin_amdgcn_s_sleep(2); if (++spins > (1u << 18)) break; }
            __builtin_amdgcn_fence(__ATOMIC_ACQUIRE, "agent"); asm volatile("s_waitcnt vmcnt(0)" ::: "memory");
        }
#pragma unroll
        for (int ai = 0; ai < 2; ++ai)
#pragma unroll
            for (int m = 0; m < 4; ++m) { const size_t r = (size_t)(row0 + ai * HALF + m * 16); const size_t off = r * 2048 + col0; const bf16_t* gp = P + r * NPJ + 2560 + MODE * 2048 + col0;
#pragma unroll
                for (int bj = 0; bj < 2; ++bj) { f32x4 g0, g1; unpack8(*(const GAS u32x4*)(gp + bj * HALF), g0, g1);
                    f32x4 v0 = g0 * acc[ai][bj][m][0], v1 = g1 * acc[ai][bj][m][1];
                    if (MODE == 1) { f32x4 t0, t1; unpack8(*(const GAS u32x4*)(T1 + off + bj * HALF), t0, t1); v0 += t0; v1 += t1; }
                    const u32x4 w = pack8(v0, v1);
                    if (MODE == 0 && samp) asm volatile("global_store_dwordx4 %0, %1, off sc1\n\ts_nop 1" :: "v"(O + off + bj * HALF), "v"(w) : "memory");
                    else *(GAS u32x4*)(O + off + bj * HALF) = w; } }
        if (MODE == 0 && samp) {
            asm volatile("s_waitcnt vmcnt(0)" ::: "memory");
            if (fr == 0 && fq == 0) __hip_atomic_fetch_add(flag, 1u, __ATOMIC_RELAXED, __HIP_MEMORY_SCOPE_AGENT);
        }
    }
};
struct EpiRes {
    static constexpr bool PERM = true, AFTER_DRAIN = false, IDEMPOTENT = false;
    bf16_t* XB; float* OUTF; const float* gmod; bf16_t* SL;
    __device__ __forceinline__ void operator()(const f32x4 (&acc)[2][2][4][2], const Unit& u, int wr, int wc, int fr, int fq) const {
        const int col0 = u.pn * BM + wc * 32 + 8 * fq;
        const bool part = u.slab >= 0;
#pragma unroll
        for (int ai = 0; ai < 2; ++ai) {
            const int rb = u.pm * BM + ai * HALF + wr * 64;
            const int cb = rb < 8192 ? (rb >> 11) : 4 + ((rb - 8192) >> 6);
            const float* g = gmod + (size_t)cb * 12288 + col0;
            f32x4 gv[2][2];
#pragma unroll
            for (int bj = 0; bj < 2; ++bj)
#pragma unroll
                for (int n = 0; n < 2; ++n) gv[bj][n] = *(const GAS f32x4*)(g + bj * HALF + 4 * n);
            if (part) { bf16_t* base = SL + ((size_t)u.slab * 1024 + (size_t)(rb - 8192 + fr)) * 2048 + col0;
#pragma unroll
                for (int m = 0; m < 4; ++m)
#pragma unroll
                    for (int bj = 0; bj < 2; ++bj) *(GAS u32x4*)(base + (size_t)(m * 16) * 2048 + bj * HALF) = pack8(gv[bj][0] * acc[ai][bj][m][0], gv[bj][1] * acc[ai][bj][m][1]);
            } else { const size_t o0 = (size_t)(rb + fr) * 2048 + col0;
#pragma unroll
                for (int m = 0; m < 4; ++m)
#pragma unroll
                    for (int bj = 0; bj < 2; ++bj) { const size_t o = o0 + (size_t)(m * 16) * 2048 + bj * HALF; f32x4 x0, x1; unpack8(*(const GAS u32x4*)(XB + o), x0, x1);
                        const f32x4 v0 = x0 + gv[bj][0] * acc[ai][bj][m][0], v1 = x1 + gv[bj][1] * acc[ai][bj][m][1];
                        if (OUTF != nullptr) { *(GAS f32x4*)(OUTF + o) = v0; *(GAS f32x4*)(OUTF + o + 4) = v1; } else *(GAS u32x4*)(XB + o) = pack8(v0, v1); }
            }
        }
    }
};
struct EpiFU {
    static constexpr bool PERM = true, AFTER_DRAIN = false, IDEMPOTENT = true;
    bf16_t* ACT;
    __device__ __forceinline__ void operator()(const f32x4 (&acc)[2][2][4][2], const Unit& u, int wr, int wc, int fr, int fq) const {
        const int row0 = u.pm * BM + wr * 64 + fr, col0 = u.pn * HALF + wc * 32 + 8 * fq;
#pragma unroll
        for (int ai = 0; ai < 2; ++ai)
#pragma unroll
            for (int m = 0; m < 4; ++m) {
                const f32x4 g0 = acc[ai][0][m][0], g1 = acc[ai][0][m][1];
                const f32x4 v0 = g0 * sigmoid4(g0) * acc[ai][1][m][0], v1 = g1 * sigmoid4(g1) * acc[ai][1][m][1];
                store16_wt(ACT + (size_t)(row0 + ai * HALF + m * 16) * 5632 + col0, pack8(v0, v1)); }
    }
};

template <class Epi, class Sched, bool ALIGN_EPI = false, bool SP2 = false>
__device__ __forceinline__ void gemm_phase(PG8_LAS unsigned char* lds, const Gemm g, const Sched& S, const Epi& E) {
    int tid_l = threadIdx.x; asm volatile("" : "+v"(tid_l));
    const int tid = tid_l, wid = __builtin_amdgcn_readfirstlane(tid >> 6), lane = tid & 63, wr = wid >> 2, wc = wid & 3, fr = lane & 15, fq = lane >> 4;
    const int K = g.K;
    unsigned voffA[2], voffB[2];
#pragma unroll
    for (int i = 0; i < 2; ++i) { int R, C; stage_rc(tid * 16 + i * 8192, R, C); const int Rb = Epi::PERM ? ((R & ~31) + perm32(R & 31)) : R;
        voffA[i] = (unsigned)(R * K + C) * 2u; voffB[i] = (unsigned)(Rb * K + C) * 2u; }
    const size_t kstep = (size_t)(BK * 2);
    const size_t hstep = (size_t)HALF * K * 2;
    const size_t tstep = 2 * hstep;
    const unsigned ldsw = (unsigned)wid * 1024u;
    const int aoff = lds_byte(wr * 64 + fr, fq * 8), boff = lds_byte(wc * 32 + fr, fq * 8);
#define PG8_SA(b, h) (((b) * 2 + (h)) * HTB)
#define PG8_SB(b, h) ((4 + (b) * 2 + (h)) * HTB)
#ifndef AUX_A
#define AUX_A 0
#endif
#ifndef AUX_B
#define AUX_B 0
#endif
#define PG8_STAGE(bufoff, gbase, voff) do { _Pragma("unroll") for (int _i = 0; _i < 2; ++_i) \
        __builtin_amdgcn_global_load_lds((const unsigned*)((const char*)(gbase) + (voff)[_i]), (PG8_LAS unsigned*)(lds + (bufoff) + ldsw + _i * 8192), 16, 0, AUX_A); } while (0)
#define PG8_STAGEB(bufoff, gbase, voff) do { _Pragma("unroll") for (int _i = 0; _i < 2; ++_i) \
        __builtin_amdgcn_global_load_lds((const unsigned*)((const char*)(gbase) + (voff)[_i]), (PG8_LAS unsigned*)(lds + (bufoff) + ldsw + _i * 8192), 16, 0, AUX_B); } while (0)
#define PG8_LDA(dst, b, h) do { _Pragma("unroll") for (int m = 0; m < 4; ++m) _Pragma("unroll") for (int k = 0; k < 2; ++k) dst[m][k] = *(const PG8_LAS bf16x8*)(lds + PG8_SA(b, h) + aoff + m * 2048 + k * 1024); } while (0)
#define PG8_LDB(dst, b, h) do { _Pragma("unroll") for (int n = 0; n < 2; ++n) _Pragma("unroll") for (int k = 0; k < 2; ++k) dst[n][k] = *(const PG8_LAS bf16x8*)(lds + PG8_SB(b, h) + boff + n * 2048 + k * 1024); } while (0)
#define PG8_MMA(ai, bj, At, Bt) do { __builtin_amdgcn_s_setprio(1); _Pragma("unroll") for (int m = 0; m < 4; ++m) _Pragma("unroll") for (int n = 0; n < 2; ++n) _Pragma("unroll") for (int k = 0; k < 2; ++k) \
        acc[ai][bj][m][n] = __builtin_amdgcn_mfma_f32_16x16x32_bf16(Bt[n][k], At[m][k], acc[ai][bj][m][n], 0, 0, 0); __builtin_amdgcn_s_setprio(0); } while (0)
#define PG8_WAIT_V(n) asm volatile("s_waitcnt vmcnt(" #n ")" ::: "memory")
#define PG8_WAIT_L(n) asm volatile("s_waitcnt lgkmcnt(" #n ")" ::: "memory")
#define PG8_BAR __builtin_amdgcn_s_barrier()
#define PG8_SCHED __builtin_amdgcn_sched_barrier(0)
    Unit cur, nxt; int ui = 0;
    if (!S.next(0, cur)) return;
    f32x4 acc[2][2][4][2];
#pragma unroll
    for (int a = 0; a < 2; ++a)
#pragma unroll
        for (int b = 0; b < 2; ++b)
#pragma unroll
            for (int m = 0; m < 4; ++m)
#pragma unroll
                for (int n = 0; n < 2; ++n) acc[a][b][m][n] = (f32x4){0.f, 0.f, 0.f, 0.f};
    bf16x8 At[4][2], B0[2][2], B1[2][2];
    const char* cA = (const char*)g.A + (size_t)cur.pm * tstep + (size_t)cur.kt0 * kstep; const char* cB = (const char*)g.Bt + (size_t)cur.pn * tstep + (size_t)cur.kt0 * kstep;
    S.a_ready(cur);
#define PG8_KP(base, p, rot_, nt_) ((base) + (size_t)((p) + (rot_) < (nt_) ? (p) + (rot_) : (p) + (rot_) - (nt_)) * kstep)
    { const int rot0 = cur.krot, nt0 = cur.nkt; const char* sA0 = PG8_KP(cA, 0, rot0, nt0); const char* sA1 = PG8_KP(cA, 1, rot0, nt0); const char* sB0 = PG8_KP(cB, 0, rot0, nt0); const char* sB1 = PG8_KP(cB, 1, rot0, nt0);
    if constexpr (SP2) {
        PG8_STAGEB(PG8_SB(0, 0), sB0, voffB); PG8_STAGEB(PG8_SB(0, 1), sB0 + hstep, voffB); PG8_STAGE(PG8_SA(0, 0), sA0, voffA); PG8_STAGE(PG8_SA(0, 1), sA0 + hstep, voffA);
        if (wr == 1) PG8_BAR;
        PG8_WAIT_V(2); PG8_BAR;
        PG8_STAGEB(PG8_SB(1, 0), sB1, voffB); PG8_STAGE(PG8_SA(1, 0), sA1, voffA); PG8_STAGEB(PG8_SB(1, 1), sB1 + hstep, voffB);
        PG8_WAIT_V(6); PG8_BAR;
    } else {
        PG8_STAGEB(PG8_SB(0, 0), sB0, voffB); PG8_STAGE(PG8_SA(0, 0), sA0, voffA); PG8_STAGEB(PG8_SB(0, 1), sB0 + hstep, voffB); PG8_STAGE(PG8_SA(0, 1), sA0 + hstep, voffA);
        if (wr == 1) PG8_BAR;
        PG8_WAIT_V(4); PG8_BAR;
        PG8_STAGEB(PG8_SB(1, 0), sB1, voffB); PG8_STAGE(PG8_SA(1, 0), sA1, voffA); PG8_STAGEB(PG8_SB(1, 1), sB1 + hstep, voffB);
        PG8_WAIT_V(6); PG8_BAR;
    }
    }
    for (;;) {
        const bool has_next = S.next(ui + 1, nxt);
        const char* nA = has_next ? (const char*)g.A + (size_t)nxt.pm * tstep + (size_t)nxt.kt0 * kstep : cA; const char* nB = has_next ? (const char*)g.Bt + (size_t)nxt.pn * tstep + (size_t)nxt.kt0 * kstep : cB;
        const int nt = cur.nkt, rot = cur.krot;
        const char* nAr = has_next ? nA + (size_t)nxt.krot * kstep : PG8_KP(cA, 0, rot, nt); const char* nBr = has_next ? nB + (size_t)nxt.krot * kstep : PG8_KP(cB, 0, rot, nt);
        for (int t = 0; t < nt; t += 2) {
            const bool last = (t == nt - 2);
            const char* a1 = PG8_KP(cA, t + 1, rot, nt);
            const char* a2 = last ? nAr : PG8_KP(cA, t + 2, rot, nt); const char* b2 = last ? nBr : PG8_KP(cB, t + 2, rot, nt);
            const char* a3 = a2 + kstep; const char* b3 = b2 + kstep;
            if (last && has_next) S.a_ready(nxt);
            if constexpr (SP2) {
            PG8_LDB(B0, 0, 0); PG8_LDB(B1, 0, 1); PG8_SCHED; PG8_LDA(At, 0, 0); PG8_STAGE(PG8_SA(1, 1), a1 + hstep, voffA);
            PG8_WAIT_V(8); PG8_WAIT_L(0); PG8_BAR; PG8_MMA(0, 0, At, B0); PG8_MMA(0, 1, At, B1); PG8_BAR; PG8_SCHED;
            PG8_LDA(At, 0, 1); PG8_STAGEB(PG8_SB(0, 0), b2, voffB); PG8_STAGEB(PG8_SB(0, 1), b2 + hstep, voffB); PG8_STAGE(PG8_SA(0, 0), a2, voffA);
            PG8_WAIT_V(8); PG8_WAIT_L(0); PG8_BAR; PG8_MMA(1, 0, At, B0); PG8_MMA(1, 1, At, B1); PG8_BAR; PG8_SCHED;
            PG8_LDB(B0, 1, 0); PG8_LDB(B1, 1, 1); PG8_SCHED; PG8_LDA(At, 1, 0); PG8_STAGE(PG8_SA(0, 1), a2 + hstep, voffA);
            PG8_WAIT_V(8); PG8_WAIT_L(0); PG8_BAR; PG8_MMA(0, 0, At, B0); PG8_MMA(0, 1, At, B1); PG8_BAR; PG8_SCHED;
            PG8_LDA(At, 1, 1); PG8_STAGEB(PG8_SB(1, 0), b3, voffB); PG8_STAGEB(PG8_SB(1, 1), b3 + hstep, voffB); PG8_STAGE(PG8_SA(1, 0), a3, voffA);
            PG8_WAIT_V(8); PG8_WAIT_L(0); PG8_BAR; PG8_MMA(1, 0, At, B0); PG8_MMA(1, 1, At, B1); PG8_BAR; PG8_SCHED;
            } else {
            PG8_LDB(B0, 0, 0); PG8_SCHED; PG8_LDA(At, 0, 0); PG8_STAGE(PG8_SA(1, 1), a1 + hstep, voffA);
            PG8_WAIT_L(8); PG8_BAR; PG8_WAIT_L(0); PG8_MMA(0, 0, At, B0); PG8_BAR; PG8_SCHED;
            PG8_LDB(B1, 0, 1); PG8_STAGEB(PG8_SB(0, 0), b2, voffB);
            PG8_BAR; PG8_WAIT_L(0); PG8_MMA(0, 1, At, B1); PG8_BAR;
            PG8_LDA(At, 0, 1); PG8_STAGE(PG8_SA(0, 0), a2, voffA);
            PG8_BAR; PG8_WAIT_L(0); PG8_MMA(1, 0, At, B0); PG8_BAR; PG8_SCHED;
            PG8_STAGEB(PG8_SB(0, 1), b2 + hstep, voffB);
            PG8_WAIT_V(6); PG8_BAR; PG8_MMA(1, 1, At, B1); PG8_BAR;
            PG8_LDB(B0, 1, 0); PG8_SCHED; PG8_LDA(At, 1, 0); PG8_STAGE(PG8_SA(0, 1), a2 + hstep, voffA);
            PG8_WAIT_L(8); PG8_BAR; PG8_WAIT_L(0); PG8_MMA(0, 0, At, B0); PG8_BAR; PG8_SCHED;
            PG8_LDB(B1, 1, 1); PG8_STAGEB(PG8_SB(1, 0), b3, voffB);
            PG8_BAR; PG8_WAIT_L(0); PG8_MMA(0, 1, At, B1); PG8_BAR;
            PG8_LDA(At, 1, 1); PG8_STAGE(PG8_SA(1, 0), a3, voffA);
            PG8_BAR; PG8_WAIT_L(0); PG8_MMA(1, 0, At, B0); PG8_BAR; PG8_SCHED;
            PG8_STAGEB(PG8_SB(1, 1), b3 + hstep, voffB);
            PG8_WAIT_V(6); PG8_BAR; PG8_MMA(1, 1, At, B1); PG8_BAR;
            }
        }
        if constexpr (ALIGN_EPI) { if (wr == 0) PG8_BAR; }
#ifndef PROBE_EPI
#define PROBE_EPI 0
#endif
        if constexpr (!Epi::AFTER_DRAIN) { E(acc, cur, wr, wc, fr, fq); if (PROBE_EPI && Epi::IDEMPOTENT) { asm volatile("" ::: "memory"); E(acc, cur, wr, wc, fr, fq); } S.done(cur); }
        if (!has_next) break;
#pragma unroll
        for (int a = 0; a < 2; ++a)
#pragma unroll
            for (int b = 0; b < 2; ++b)
#pragma unroll
                for (int m = 0; m < 4; ++m)
#pragma unroll
                    for (int n = 0; n < 2; ++n) acc[a][b][m][n] = (f32x4){0.f, 0.f, 0.f, 0.f};
        cur = nxt; cA = nA; cB = nB; ++ui;
        if constexpr (ALIGN_EPI) { if (wr == 1) PG8_BAR; }
    }
    PG8_WAIT_V(0);
    if constexpr (!ALIGN_EPI) { if (wr == 0) PG8_BAR; }
    PG8_BAR;
    if constexpr (Epi::AFTER_DRAIN) { E.fused(acc, cur, wr, wc, fr, fq, lds, wid, lane); S.done(cur); }
#undef PG8_KP
#undef PG8_SA
#undef PG8_SB
#undef PG8_STAGE
#undef PG8_STAGEB
#undef PG8_LDA
#undef PG8_LDB
#undef PG8_MMA
#undef PG8_WAIT_V
#undef PG8_WAIT_L
#undef PG8_BAR
#undef PG8_SCHED
}
}

#ifndef PG8_SP2
#define PG8_SP2 true
#endif
#ifndef PG8_ALIGN
#define PG8_ALIGN true
#endif
#ifndef BACKFILL
#define BACKFILL 1
#endif
#ifndef BF_G1_R0
#define BF_G1_R0 0
#define BF_G1_R1 7168
#endif
#ifndef BF_FU_R0
#define BF_FU_R0 16896
#define BF_FU_R1 28160
#endif
#ifndef MK_ONE_LAUNCH
#define MK_ONE_LAUNCH 1
#endif

constexpr int NWAVES = 8;
constexpr int DM = 2048, NTOK = 9216, TPR = 8192, NL = 4, NCB = 20, MODW = 12288, DFF = 5632, NPJ = pg8::NPJ;
constexpr int NPHASE = 2 + 10 * NL;
constexpr size_t O_Y = 0, O_PK = 18874368, O_PV = O_PK + 524288, O_PSR = O_PV + 524288, O_PSI = O_PSR + 65536, O_SK = O_PSI + 65536, O_SV = O_SK + 2097152, O_SSR = O_SV + 2097152, O_SSI = O_SSR + 262144, O_END = O_SSI + 262144;
static_assert(O_END == 24772608, "output map");
constexpr size_t MiB = 1u << 20;
constexpr size_t WS_CTL = 0, CTL_ZERO_BYTES = 64 * 1024;
constexpr size_t WS_MOD = 1 * MiB;
constexpr size_t WS_LAM = 5 * MiB;
constexpr size_t WS_BBAR = 6 * MiB;
constexpr size_t WS_CM = 7 * MiB;
constexpr size_t WS_ROPE = 8 * MiB;
constexpr size_t WS_W1 = 16 * MiB;
constexpr size_t SZ_W1 = (size_t)6656 * 2048 * 2;
constexpr size_t WS_WGLU = WS_W1 + NL * SZ_W1;
constexpr size_t SZ_WGLU = (size_t)1024 * 1024 * 2;
constexpr size_t WS_WPS = WS_WGLU + NL * SZ_WGLU;
constexpr size_t SZ_WP = (size_t)2048 * 1024 * 2;
constexpr size_t WS_WPA = WS_WPS + NL * SZ_WP;
constexpr size_t WS_WOUT = WS_WPA + NL * SZ_WP;
constexpr size_t SZ_WOUT = (size_t)2048 * 2048 * 2;
constexpr size_t WS_WGU = WS_WOUT + NL * SZ_WOUT;
constexpr size_t SZ_WGU = (size_t)11264 * 2048 * 2;
constexpr size_t WS_WDN = WS_WGU + NL * SZ_WGU;
constexpr size_t SZ_WDN = (size_t)2048 * 5632 * 2;
constexpr size_t WS_H = WS_WDN + NL * SZ_WDN;
constexpr size_t WS_P = WS_H + (size_t)NTOK * 2048 * 2;
constexpr size_t WS_QN = WS_P + (size_t)NTOK * NPJ * 2;
constexpr size_t WS_KN = WS_QN + (size_t)NTOK * 1024 * 2;
constexpr size_t WS_Z = WS_KN + (size_t)NTOK * 256 * 2;
constexpr size_t WS_SO = WS_Z + (size_t)NTOK * 1024 * 2;
constexpr size_t WS_AO = WS_SO + (size_t)NTOK * 1024 * 2;
constexpr size_t WS_T1 = WS_AO + (size_t)NTOK * 1024 * 2;
constexpr size_t WS_MX = WS_T1 + (size_t)NTOK * 2048 * 2;
constexpr size_t WS_ACT = WS_MX + (size_t)NTOK * 2048 * 2;
constexpr size_t WS_SL = WS_ACT + (size_t)NTOK * DFF * 2;
constexpr size_t WS_XB = WS_SL + (size_t)8 * 1024 * 2048 * 4;
constexpr size_t WS_END = WS_XB + (size_t)NTOK * 2048 * 2;
static_assert(WS_ROPE + 2112 * 16 * 4 <= WS_W1 && (WS_W1 % 256) == 0 && (WS_H % 256) == 0, "d_ws map");
constexpr int CW_BAR = 4096;

constexpr int RING_OFF = 0, RING_BYTES = 131072;
constexpr int LDSCTL_OFF = RING_BYTES, MISC_OFF = LDSCTL_OFF + 320;
constexpr int LDS_BYTES = 147456;
static_assert(MISC_OFF + 128 <= LDS_BYTES, "LDS map");

#define GAS __attribute__((address_space(1)))
#define LAS __attribute__((address_space(3)))
typedef unsigned short bf16;
typedef unsigned v4u __attribute__((ext_vector_type(4)));
typedef unsigned v2u __attribute__((ext_vector_type(2)));
typedef float f32x4 __attribute__((ext_vector_type(4)));
typedef float f32x2 __attribute__((ext_vector_type(2)));
typedef float f32x16 __attribute__((ext_vector_type(16)));
typedef short bf16x8 __attribute__((ext_vector_type(8)));
typedef GAS unsigned gu32;
#define RLX_AGENT __ATOMIC_RELAXED, __HIP_MEMORY_SCOPE_AGENT
#define LDS_WAIT() asm volatile("s_waitcnt lgkmcnt(0)" ::: "memory")
#define VM_WAIT() asm volatile("s_waitcnt vmcnt(0)" ::: "memory")
using pg8::cvt_pk_bf16; using pg8::bflo; using pg8::bfhi;
__device__ __forceinline__ unsigned f2bf(float f) { unsigned u = __builtin_bit_cast(unsigned, f); return (u + 0x7fffu + ((u >> 16) & 1u)) >> 16; }
__device__ __forceinline__ float bf2f(unsigned short b) { return __uint_as_float((unsigned)b << 16); }
__device__ __forceinline__ float wave_sum(float v) {
#pragma unroll
    for (int o = 1; o < 64; o <<= 1) v += __shfl_xor(v, o);
    return v;
}
#define XB_TMO      128
#define XB_XCNT(j)  (256  + 64 * (j))
#define XB_XSUB(j)  (1280 + 64 * (j))
#define XB_XGEN(j)  (2304 + 64 * (j))
#define XB_TOP      3328
#define XB_TOPGEN   3392
#define XCD_BAR_WORDS 3456
#define XB_SPIN_CAP (1u << 18)

__device__ __forceinline__ unsigned xb_ld(unsigned* p)              { return __hip_atomic_load(p, __ATOMIC_RELAXED, __HIP_MEMORY_SCOPE_AGENT); }
__device__ __forceinline__ unsigned xb_add(unsigned* p, unsigned v) { return __hip_atomic_fetch_add(p, v, __ATOMIC_RELAXED, __HIP_MEMORY_SCOPE_AGENT); }
__device__ __forceinline__ unsigned xb_xcc_id() { return (unsigned)__builtin_amdgcn_s_getreg((3 << 11) | 20) & 0xFu; }
#define XB_SPIN(cond, bar) do { unsigned _sp = 0; while (cond) { __builtin_amdgcn_s_sleep(1); \
    if ((++_sp & 255u) == 0u) { if (xb_ld(&(bar)[XB_TMO])) break; if (_sp > XB_SPIN_CAP) { atomicAdd(&(bar)[XB_TMO], 1u); break; } } } } while (0)

struct XcdBarrier {
    unsigned* bar; unsigned x;
    volatile LAS unsigned* st;
};

__device__ __forceinline__ XcdBarrier xcd_barrier_post(unsigned* bar, volatile LAS unsigned* st) {
    XcdBarrier b; b.bar = bar; b.x = xb_xcc_id(); b.st = st;
    if (threadIdx.x == 0) (void)xb_add(&bar[XB_XCNT(b.x)], 1u);
    return b;
}
__device__ __forceinline__ void xcd_barrier_complete(unsigned* bar, unsigned x, unsigned& nloc, unsigned& nx) {
    const unsigned G = gridDim.x * gridDim.y * gridDim.z;
    unsigned sum, cnt, mine, sp = 0u;
    for (;;) {
        sum = 0u; cnt = 0u; mine = 0u;
#pragma unroll
        for (unsigned j = 0; j < 16; ++j) { const unsigned c = xb_ld(&bar[XB_XCNT(j)]); sum += c; cnt += (c > 0u) ? 1u : 0u; mine = (j == x) ? c : mine; }
        if (sum == G) break;
        __builtin_amdgcn_s_sleep(1);
        if ((++sp & 255u) == 0u) { if (xb_ld(&bar[XB_TMO])) break; if (sp > XB_SPIN_CAP) { atomicAdd(&bar[XB_TMO], 1u); break; } }
    }
    nloc = mine > 0u ? mine : 1u; nx = cnt > 0u ? cnt : 1u;
}

__device__ __forceinline__ void xcd_barrier(const XcdBarrier& b) {
    asm volatile("s_waitcnt vmcnt(0)" ::: "memory");
    __syncthreads();
    if (threadIdx.x == 0) {
        unsigned* bar = b.bar;
        __builtin_amdgcn_s_waitcnt(0);
        unsigned nloc = b.st[0], nx = b.st[1];
        if (nloc == 0u) { xcd_barrier_complete(bar, b.x, nloc, nx); b.st[0] = nloc; b.st[1] = nx; }
        const unsigned old = xb_add(&bar[XB_XSUB(b.x)], 1u);
        const unsigned gen = old / nloc;
        if (old + 1u == (gen + 1u) * nloc) {
            __builtin_amdgcn_fence(__ATOMIC_RELEASE, "agent");
            asm volatile("s_waitcnt vmcnt(0)" ::: "memory");
            const unsigned og = xb_add(&bar[XB_TOP], 1u);
            const unsigned tg = og / nx;
            if (og + 1u == (tg + 1u) * nx) xb_add(&bar[XB_TOPGEN], 1u);
            else XB_SPIN(xb_ld(&bar[XB_TOPGEN]) == tg, bar);
            __builtin_amdgcn_fence(__ATOMIC_ACQUIRE, "agent");
            xb_add(&bar[XB_XGEN(b.x)], 1u);
            asm volatile("s_waitcnt vmcnt(0)" ::: "memory");
        } else {
            XB_SPIN(xb_ld(&bar[XB_XGEN(b.x)]) == gen, bar);
            __builtin_amdgcn_fence(__ATOMIC_ACQUIRE, "agent");
            asm volatile("s_waitcnt vmcnt(0)" ::: "memory");
        }
    }
    __syncthreads();
}

#ifndef NT_STREAM
#define NT_STREAM 1
#endif
__device__ __forceinline__ unsigned pk2(float lo, float hi) { return cvt_pk_bf16(lo, hi); }
struct ConvDesc { const float* src; bf16* dst; int N, K; };
__device__ __forceinline__ void conv_load(const ConvDesc& d, f32x4 (&v)[8]) {
#pragma unroll
    for (int i = 0; i < 8; ++i) v[i] = NT_STREAM ? __builtin_nontemporal_load((const GAS f32x4*)(d.src + (size_t)(8 * i) * d.N)) : *(const GAS f32x4*)(d.src + (size_t)(8 * i) * d.N);
}
__device__ __forceinline__ void conv_store(const ConvDesc& d, const f32x4 (&v)[8], LAS float* scr, int lane) {
    { const int kr = lane >> 3, n4 = lane & 7;
#pragma unroll
      for (int i = 0; i < 8; ++i) { LAS float* p = scr + (8 * i + kr) * 33 + 4 * n4; p[0] = v[i].x; p[1] = v[i].y; p[2] = v[i].z; p[3] = v[i].w; } }
    LDS_WAIT(); asm volatile("" ::: "memory");
    const int c = lane & 7;
#pragma unroll
    for (int j = 0; j < 4; ++j) { const int n = (lane >> 3) + 8 * j; const LAS float* s = scr + (8 * c) * 33 + n;
        v4u o; o.x = pk2(s[0 * 33], s[1 * 33]); o.y = pk2(s[2 * 33], s[3 * 33]); o.z = pk2(s[4 * 33], s[5 * 33]); o.w = pk2(s[6 * 33], s[7 * 33]);
        if (NT_STREAM) __builtin_nontemporal_store(o, (GAS v4u*)(d.dst + (size_t)n * d.K + 8 * c)); else *(GAS v4u*)(d.dst + (size_t)n * d.K + 8 * c) = o; }
    LDS_WAIT(); asm volatile("" ::: "memory");
}
__device__ __forceinline__ void sincos_d(double x, double& s, double& c) {
    const double k = rint(x * 0.63661977236758134308);
    double y = fma(-k, 1.57079632679489655800e+00, x); y = fma(-k, 6.12323399573676603587e-17, y);
    const double y2 = y * y;
    const double sp = y * (1.0 + y2 * (-1.0 / 6.0 + y2 * (1.0 / 120.0 + y2 * (-1.0 / 5040.0 + y2 * (1.0 / 362880.0 + y2 * (-1.0 / 39916800.0 + y2 * (1.0 / 6227020800.0)))))));
    const double cp = 1.0 + y2 * (-0.5 + y2 * (1.0 / 24.0 + y2 * (-1.0 / 720.0 + y2 * (1.0 / 40320.0 + y2 * (-1.0 / 3628800.0 + y2 * (1.0 / 479001600.0 + y2 * (-1.0 / 87178291200.0)))))));
    const int qd = ((int)k) & 3;
    s = (qd == 0) ? sp : (qd == 1) ? cp : (qd == 2) ? -sp : -cp;
    c = (qd == 0) ? cp : (qd == 1) ? -sp : (qd == 2) ? -cp : sp;
}
__device__ __forceinline__ int crow(int r, int hi) { return (r & 3) + 8 * (r >> 2) + 4 * hi; }
__device__ __forceinline__ bf16x8 mk_bf16x8(unsigned a, unsigned b, unsigned c, unsigned d) { v4u w; w.x = a; w.y = b; w.z = c; w.w = d; return __builtin_bit_cast(bf16x8, w); }

struct Args { const float* in[34]; float* out; unsigned char* ws; int ph_lo, ph_hi; };

__device__ __forceinline__ void p0_mod(LAS unsigned char* lds, int tid, int wid, int lane, int t_first, int t_end, int t_stride, const float* cp, const float* cs, const float* wmod, const float* bmod, float* MOD) {
    LAS float* red = (LAS float*)lds;
    const int q = lane & 31, hi = lane >> 5;
    LAS float* scr = (LAS float*)(lds + 32768 + wid * 8448);
    const int kr = lane >> 3, n4 = lane & 7;
    for (int task = t_first; task < t_end; task += t_stride) {
        const int l = task / 384, nb = task % 384;
        const float* wt = wmod + (size_t)l * 2048 * MODW + 32 * nb + 4 * n4;
        const float* csrc = q < 4 ? cp + q * 2048 : cs + (q < 20 ? (q - 4) : 0) * 2048;
        f32x16 acc;
#pragma unroll
        for (int r = 0; r < 16; ++r) acc[r] = 0.f;
        f32x4 vn[8];
#pragma unroll
        for (int i = 0; i < 8; ++i) vn[i] = __builtin_nontemporal_load((const f32x4*)(wt + (size_t)(256 * wid + 8 * i + kr) * MODW));
#pragma unroll 1
        for (int tt = 0; tt < 4; ++tt) {
            f32x4 vc[8];
#pragma unroll
            for (int i = 0; i < 8; ++i) vc[i] = vn[i];
            if (tt < 3) {
#pragma unroll
                for (int i = 0; i < 8; ++i) vn[i] = __builtin_nontemporal_load((const f32x4*)(wt + (size_t)(256 * wid + 64 * (tt + 1) + 8 * i + kr) * MODW)); }
#pragma unroll
            for (int i = 0; i < 8; ++i) { LAS float* p = scr + (8 * i + kr) * 33 + 4 * n4; p[0] = vc[i].x; p[1] = vc[i].y; p[2] = vc[i].z; p[3] = vc[i].w; }
            LDS_WAIT(); asm volatile("" ::: "memory");
#pragma unroll
            for (int ks = 0; ks < 4; ++ks) {
                const int k0 = 256 * wid + 64 * tt + 16 * ks + 8 * hi;
                f32x4 a0 = *(const f32x4*)(csrc + k0), a1 = *(const f32x4*)(csrc + k0 + 4);
                if (q >= 20) { a0 = (f32x4){0.f, 0.f, 0.f, 0.f}; a1 = a0; }
                float b[8];
#pragma unroll
                for (int jj = 0; jj < 8; ++jj) b[jj] = scr[(16 * ks + 8 * hi + jj) * 33 + q];
                const unsigned ah0 = cvt_pk_bf16(a0[0], a0[1]), ah1 = cvt_pk_bf16(a0[2], a0[3]), ah2 = cvt_pk_bf16(a1[0], a1[1]), ah3 = cvt_pk_bf16(a1[2], a1[3]);
                const unsigned al0 = cvt_pk_bf16(a0[0] - bflo(ah0), a0[1] - bfhi(ah0)), al1 = cvt_pk_bf16(a0[2] - bflo(ah1), a0[3] - bfhi(ah1)), al2 = cvt_pk_bf16(a1[0] - bflo(ah2), a1[1] - bfhi(ah2)), al3 = cvt_pk_bf16(a1[2] - bflo(ah3), a1[3] - bfhi(ah3));
                const unsigned bh0 = cvt_pk_bf16(b[0], b[1]), bh1 = cvt_pk_bf16(b[2], b[3]), bh2 = cvt_pk_bf16(b[4], b[5]), bh3 = cvt_pk_bf16(b[6], b[7]);
                const unsigned bl0 = cvt_pk_bf16(b[0] - bflo(bh0), b[1] - bfhi(bh0)), bl1 = cvt_pk_bf16(b[2] - bflo(bh1), b[3] - bfhi(bh1)), bl2 = cvt_pk_bf16(b[4] - bflo(bh2), b[5] - bfhi(bh2)), bl3 = cvt_pk_bf16(b[6] - bflo(bh3), b[7] - bfhi(bh3));
                const bf16x8 ah = mk_bf16x8(ah0, ah1, ah2, ah3), al = mk_bf16x8(al0, al1, al2, al3), bh = mk_bf16x8(bh0, bh1, bh2, bh3), bl = mk_bf16x8(bl0, bl1, bl2, bl3);
                acc = __builtin_amdgcn_mfma_f32_32x32x16_bf16(ah, bh, acc, 0, 0, 0);
                acc = __builtin_amdgcn_mfma_f32_32x32x16_bf16(ah, bl, acc, 0, 0, 0);
                acc = __builtin_amdgcn_mfma_f32_32x32x16_bf16(al, bh, acc, 0, 0, 0);
            }
            LDS_WAIT(); asm volatile("" ::: "memory");
        }
#pragma unroll
        for (int r = 0; r < 16; ++r) red[(wid * 32 + crow(r, hi)) * 32 + q] = acc[r];
        __syncthreads();
        for (int o = tid; o < 640; o += 512) { const int cb = o >> 5, n = o & 31; float s = bmod[l * MODW + 32 * nb + n];
#pragma unroll
            for (int w8 = 0; w8 < 8; ++w8) s += red[(w8 * 32 + cb) * 32 + n];
            ((GAS float*)MOD)[((size_t)l * NCB + cb) * MODW + 32 * nb + n] = s; }
        __syncthreads();
    }
}

constexpr int CONV_PER_L = 28160;
__device__ __forceinline__ ConvDesc conv_desc(const Args& A, unsigned char* ws, int l, int it, int lane) {
    int r = it;
    const float* W; int K, N; bf16* WT; int mode = 0;
    int rb0 = 0;
    if (r < 2560) { W = A.in[12] + (size_t)l * 2048 * 2560; K = 2048; N = 2560; WT = (bf16*)(ws + WS_W1 + l * SZ_W1); mode = 3; }
    else if ((r -= 2560) < 4096) { W = A.in[26] + (size_t)l * 2048 * 4096; K = 2048; N = 4096; WT = (bf16*)(ws + WS_W1 + l * SZ_W1); rb0 = 2560; }
    else if ((r -= 4096) < 512) { W = A.in[21] + (size_t)l * 1024 * 1024; K = 1024; N = 1024; WT = (bf16*)(ws + WS_WGLU + l * SZ_WGLU); }
    else if ((r -= 512) < 1024) { W = A.in[28] + (size_t)l * 1024 * 2048; K = 1024; N = 2048; WT = (bf16*)(ws + WS_WPS + l * SZ_WP); }
    else if ((r -= 1024) < 1024) { W = A.in[29] + (size_t)l * 1024 * 2048; K = 1024; N = 2048; WT = (bf16*)(ws + WS_WPA + l * SZ_WP); }
    else if ((r -= 1024) < 2048) { W = A.in[30] + (size_t)l * 2048 * 2048; K = 2048; N = 2048; WT = (bf16*)(ws + WS_WOUT + l * SZ_WOUT); }
    else if ((r -= 2048) < 5632) { W = A.in[31] + (size_t)l * 2048 * 5632; K = 2048; N = 5632; WT = (bf16*)(ws + WS_WGU + l * SZ_WGU); mode = 1; }
    else if ((r -= 5632) < 5632) { W = A.in[32] + (size_t)l * 2048 * 5632; K = 2048; N = 5632; WT = (bf16*)(ws + WS_WGU + l * SZ_WGU); mode = 2; }
    else { r -= 5632; W = A.in[33] + (size_t)l * 5632 * 2048; K = 5632; N = 2048; WT = (bf16*)(ws + WS_WDN + l * SZ_WDN); }
    const int nblk = N / 32, kb = r / nblk, nb = r % nblk, k0 = 64 * kb, n0 = 32 * nb;
    const int rowbase = mode == 0 ? rb0 + n0 : mode == 3 ? ((n0 >= 1024 && n0 < 2304) ? (n0 & ~255) + 128 * ((n0 >> 5) & 1) + 32 * ((n0 >> 6) & 3) : n0)
                                  : 256 * (n0 >> 7) + (n0 & 127) + (mode == 2 ? 128 : 0);
    ConvDesc d; d.src = W + (size_t)(k0 + (lane >> 3)) * N + n0 + 4 * (lane & 7); d.dst = WT + (size_t)rowbase * K + k0; d.N = N; d.K = K; return d;
}
__device__ __forceinline__ void conv_items(const Args& A, unsigned char* ws, LAS unsigned char* lds, int wid, int lane, int l, int r0, int r1, int pw, int npw) {
    LAS float* scr = (LAS float*)(lds + RING_OFF + wid * 16384);
    int it = r0 + pw; if (it >= r1) return;
    ConvDesc dn = conv_desc(A, ws, l, it, lane); f32x4 vn[8]; conv_load(dn, vn);
    for (;;) {
        const ConvDesc dc = dn; f32x4 vc[8];
#pragma unroll
        for (int i = 0; i < 8; ++i) vc[i] = vn[i];
        it += npw; const bool more = it < r1;
        if (more) { dn = conv_desc(A, ws, l, it, lane); conv_load(dn, vn); }
        conv_store(dc, vc, scr, lane);
        if (!more) break;
    }
}
__device__ __forceinline__ void backfill(const Args& A, unsigned char* ws, LAS unsigned char* lds, int tid, int wid, int lane, int G, int bx, int c0, int lm, int t0, int t1, int lc, int r0, int r1) {
    if (!BACKFILL) return;
    if (c0 >= G) c0 = 0;
    if (bx < c0) return;
    const int pc = bx - c0, npc = G - c0;
    if (lm < NL) p0_mod(lds, tid, wid, lane, lm * 384 + t0 + pc, lm * 384 + t1, npc, A.in[6], A.in[7], A.in[8], A.in[9], (float*)(ws + WS_MOD));
    if (lc < NL) conv_items(A, ws, lds, wid, lane, lc, r0, r1, pc * NWAVES + wid, npc * NWAVES);
    __syncthreads();
}
__device__ __forceinline__ void p0_prologue(const Args& A, LAS unsigned char* lds, int tid, int wid, int lane, int G, int bx) {
    unsigned char* ws = A.ws;
    const int gw = bx * NWAVES + wid, NGW = G * NWAVES;
    { const int N4 = NL * 16 * 64 * 256 / 4;
      for (int i = bx * 512 + tid; i < 2 * N4; i += G * 512) { const int kv = i >= N4, j = kv ? i - N4 : i; const int lb = j / 4096, w = j % 4096;
          const f32x4 v = *((const f32x4*)A.in[2 + kv] + (size_t)lb * 8192 + 4096 + w); *((f32x4*)(A.out + (kv ? O_SV : O_SK)) + (size_t)lb * 8192 + w) = v; } }
    { float* LAM = (float*)(ws + WS_LAM); bf16* BB = (bf16*)(ws + WS_BBAR); bf16* CM = (bf16*)(ws + WS_CM);
      for (int idx = bx * 512 + tid; idx < NL * 4096; idx += G * 512) {
          const int lg = idx >> 6, p = idx & 63;
          const double dt = exp((double)A.in[15][lg]);
          const double are = (double)A.in[13][idx], aim = (double)A.in[14][idx];
          const double zre = are * dt, zim = aim * dt, mag = exp(zre);
          double s, c; sincos_d(zim, s, c);
          const double lre = mag * c, lim = mag * s;
          const double mag64 = exp(64.0 * zre); double s64, c64; sincos_d(64.0 * zim, s64, c64);
          *(f32x4*)(LAM + (size_t)idx * 4) = (f32x4){(float)lre, (float)lim, (float)(mag64 * c64), (float)(mag64 * s64)};
          const double den = are * are + aim * aim, nre = lre - 1.0;
          const double fre = (nre * are + lim * aim) / den, fim = (lim * are - nre * aim) / den;
          const float* bre = A.in[16] + (size_t)idx * 16; const float* bim = A.in[17] + (size_t)idx * 16;
          bf16* b0 = BB + ((size_t)lg * 128 + 2 * p) * 16;
#pragma unroll
          for (int ch = 0; ch < 16; ++ch) { const double br = (double)bre[ch], bi = (double)bim[ch];
              b0[ch] = (bf16)f2bf((float)(fre * br - fim * bi)); b0[16 + ch] = (bf16)f2bf((float)(fre * bi + fim * br)); }
#pragma unroll
          for (int ch = 0; ch < 16; ++ch) { const size_t ci = ((size_t)lg * 16 + ch) * 64 + p; bf16* cd = CM + ((size_t)lg * 16 + ch) * 128 + 2 * p;
              cd[0] = (bf16)f2bf(A.in[18][ci]); cd[1] = (bf16)f2bf(-A.in[19][ci]); }
      } }
    { float* RT = (float*)(ws + WS_ROPE);
      for (int e = bx * 512 + tid; e < 2112 * 8; e += G * 512) { const int pos = e >> 3, i = e & 7;
          const double inv = exp(-((double)i / 8.0) * 13.122363377404328  ); double s, c; sincos_d((double)pos * inv, s, c);
          RT[pos * 16 + i] = (float)c; RT[pos * 16 + 8 + i] = (float)s; } }
    p0_mod(lds, tid, wid, lane, bx, (BACKFILL ? 1 : NL) * 384, G, A.in[6], A.in[7], A.in[8], A.in[9], (float*)(ws + WS_MOD));
    if (BACKFILL) { conv_items(A, ws, lds, wid, lane, 0, 0, 6656, gw, NGW); conv_items(A, ws, lds, wid, lane, 0, 11264, 15360, gw, NGW); }
    else for (int l = 0; l < NL; ++l) conv_items(A, ws, lds, wid, lane, l, 0, CONV_PER_L, gw, NGW);
}

__device__ __forceinline__ void norm_row(int row, int lane, bf16* XB, const float* xin_p, const float* xin_s, const bf16* SL, const float* gn, const float* modl, int sh_off, int sc_off, bf16* H) {
    const int cb = row < TPR ? (row >> 11) : 4 + ((row - TPR) >> 6);
    GAS v4u* xr = (GAS v4u*)(XB + (size_t)row * DM) + lane;
    f32x4 v[8]; float s = 0.f;
    bool wb = false;
    if (xin_p != nullptr) {
        const GAS f32x4* xi = (const GAS f32x4*)(row < TPR ? xin_p + (size_t)row * DM : xin_s + (size_t)(row - TPR) * DM) + 2 * lane;
#pragma unroll
        for (int j = 0; j < 4; ++j) { v[2 * j] = xi[128 * j]; v[2 * j + 1] = xi[128 * j + 1]; }
        wb = true;
    } else {
#pragma unroll
        for (int j = 0; j < 4; ++j) pg8::unpack8(xr[64 * j], v[2 * j], v[2 * j + 1]);
    }
    if (SL != nullptr && row >= TPR) {
        const GAS v4u* sp = (const GAS v4u*)(SL + (size_t)(row - TPR) * DM) + lane;
        v4u sr[8][4];
#pragma unroll
        for (int sl = 0; sl < 8; ++sl)
#pragma unroll
            for (int j = 0; j < 4; ++j) sr[sl][j] = sp[(size_t)sl * (1024 * DM / 8) + 64 * j];
#pragma unroll
        for (int sl = 0; sl < 8; ++sl)
#pragma unroll
            for (int j = 0; j < 4; ++j) { f32x4 a0, a1; pg8::unpack8(sr[sl][j], a0, a1); v[2 * j] = v[2 * j] + a0; v[2 * j + 1] = v[2 * j + 1] + a1; }
        wb = true;
    }
    if (wb) {
#pragma unroll
        for (int j = 0; j < 4; ++j) { const v4u w = pg8::pack8(v[2 * j], v[2 * j + 1]); xr[64 * j] = w; pg8::unpack8(w, v[2 * j], v[2 * j + 1]); }
    }
#pragma unroll
    for (int j = 0; j < 8; ++j) s += (v[j].x * v[j].x + v[j].y * v[j].y) + (v[j].z * v[j].z + v[j].w * v[j].w);
    const float rstd = 1.0f / sqrtf(wave_sum(s) * (1.0f / DM) + 1e-6f);
    const float* mrow = modl + (size_t)cb * MODW;
    GAS v4u* o16 = (GAS v4u*)(H + (size_t)row * DM) + lane;
#pragma unroll
    for (int j = 0; j < 4; ++j) { const int col = 8 * lane + 512 * j; f32x4 o[2];
#pragma unroll
        for (int h2 = 0; h2 < 2; ++h2) { const f32x4 g = *(const GAS f32x4*)(gn + col + 4 * h2), sc = *(const GAS f32x4*)(mrow + sc_off + col + 4 * h2), sh = *(const GAS f32x4*)(mrow + sh_off + col + 4 * h2);
            o[h2] = v[2 * j + h2] * rstd * g * (1.0f + sc) + sh; }
        o16[64 * j] = pg8::pack8(o[0], o[1]); }
}
__device__ __forceinline__ void norm_phase(int gw, int NGW, int lane, bf16* XB, const float* xin_p, const float* xin_s, const bf16* SL, const float* gn, const float* modl, int sh_off, int sc_off, bf16* H) {
    const bool xcd_deal = (NGW == 2048);
    const int bxw = gw >> 3, widw = gw & 7, xq = bxw & 7, jq = bxw >> 3;
    if (xcd_deal && xin_p == nullptr) {
        const int row0 = 1024 * xq + 32 * jq + 4 * widw, cb = row0 >> 11;
        v4u raw[4][4];
#pragma unroll
        for (int ri = 0; ri < 4; ++ri)
#pragma unroll
            for (int j = 0; j < 4; ++j) raw[ri][j] = ((const GAS v4u*)(XB + (size_t)(row0 + ri) * DM) + lane)[64 * j];
        const float* mrow = modl + (size_t)cb * MODW;
        f32x4 Am[8], Sh[8];
#pragma unroll
        for (int j = 0; j < 4; ++j)
#pragma unroll
            for (int h2 = 0; h2 < 2; ++h2) { const int col = 8 * lane + 512 * j + 4 * h2; const f32x4 g = *(const GAS f32x4*)(gn + col), sc = *(const GAS f32x4*)(mrow + sc_off + col); Sh[2 * j + h2] = *(const GAS f32x4*)(mrow + sh_off + col);
                Am[2 * j + h2] = g * (1.0f + sc); }
#pragma unroll
        for (int ri = 0; ri < 4; ++ri) {
            f32x4 v[8]; float s = 0.f;
#pragma unroll
            for (int j = 0; j < 4; ++j) pg8::unpack8(raw[ri][j], v[2 * j], v[2 * j + 1]);
#pragma unroll
            for (int j = 0; j < 8; ++j) s += (v[j].x * v[j].x + v[j].y * v[j].y) + (v[j].z * v[j].z + v[j].w * v[j].w);
            const float rstd = 1.0f / sqrtf(wave_sum(s) * (1.0f / DM) + 1e-6f);
            GAS v4u* o16 = (GAS v4u*)(H + (size_t)(row0 + ri) * DM) + lane;
#pragma unroll
            for (int j = 0; j < 4; ++j) o16[64 * j] = pg8::pack8(v[2 * j] * rstd * Am[2 * j] + Sh[2 * j], v[2 * j + 1] * rstd * Am[2 * j + 1] + Sh[2 * j + 1]);
        }
        if (widw < 4) norm_row(TPR + 4 * bxw + widw, lane, XB, xin_p, xin_s, SL, gn, modl, sh_off, sc_off, H);
        return;
    }
    const int nrows = xcd_deal ? (widw < 4 ? 5 : 4) : (NTOK - gw + NGW - 1) / NGW;
    for (int ri = 0; ri < nrows; ++ri) {
        const int row = xcd_deal ? (ri < 4 ? 1024 * xq + 32 * jq + 4 * widw + ri : TPR + 4 * bxw + widw) : gw + ri * NGW;
        norm_row(row, lane, XB, xin_p, xin_s, SL, gn, modl, sh_off, sc_off, H);
    }
}
__device__ __forceinline__ void final_phase(int gw, int NGW, int lane, float* X, const bf16* XB, const bf16* SL) {
    for (int row = TPR + gw; row < NTOK; row += NGW) {
        GAS f32x4* xo = (GAS f32x4*)(X + (size_t)row * DM) + 2 * lane; const GAS v4u* xr = (const GAS v4u*)(XB + (size_t)row * DM) + lane; const GAS v4u* sp = (const GAS v4u*)(SL + (size_t)(row - TPR) * DM) + lane;
        f32x4 v[8];
#pragma unroll
        for (int j = 0; j < 4; ++j) pg8::unpack8(xr[64 * j], v[2 * j], v[2 * j + 1]);
        v4u sr[8][4];
#pragma unroll
        for (int sl = 0; sl < 8; ++sl)
#pragma unroll
            for (int j = 0; j < 4; ++j) sr[sl][j] = sp[(size_t)sl * (1024 * DM / 8) + 64 * j];
#pragma unroll
        for (int sl = 0; sl < 8; ++sl)
#pragma unroll
            for (int j = 0; j < 4; ++j) { f32x4 a0, a1; pg8::unpack8(sr[sl][j], a0, a1); v[2 * j] = v[2 * j] + a0; v[2 * j + 1] = v[2 * j + 1] + a1; }
#pragma unroll
        for (int j = 0; j < 4; ++j) { xo[128 * j] = v[2 * j]; xo[128 * j + 1] = v[2 * j + 1]; }
    }
}

constexpr int SSM_ROWB = 528;
constexpr int SSM_WSCR = 16 * SSM_ROWB;
template <bool FULL>
__device__ __forceinline__ void ssm_subblock(LAS unsigned char* sb, int lane, bf16x8 uf, const bf16x8 (&af)[8], const bf16x8 (&cf)[4], float lre, float lim, float& hre, float& him,
                                             f32x4 dsk, v2u uraw, bf16* zdst, bool dost = true) {
    const int tok = lane & 15, q = lane >> 4;
    f32x4 dd[8];
#pragma unroll
    for (int nt = 0; nt < 8; ++nt) dd[nt] = __builtin_amdgcn_mfma_f32_16x16x32_bf16(af[nt], uf, (f32x4){0.f, 0.f, 0.f, 0.f}, 0, 0, 0);
#pragma unroll
    for (int nt = 0; nt < 8; ++nt) *(LAS f32x4*)(sb + tok * SSM_ROWB + nt * 64 + q * 16) = dd[nt];
    __builtin_amdgcn_sched_group_barrier(0x008, 8, 0); __builtin_amdgcn_sched_group_barrier(0x200, 8, 0);
    f32x2 bu[16]; unsigned hp[16];
#pragma unroll
    for (int t = 0; t < 16; ++t) bu[t] = *(const LAS f32x2*)(sb + t * SSM_ROWB + 8 * lane);
    f32x2 hv = (f32x2){hre, him}; const f32x2 Lp = (f32x2){lre, lim};
#pragma unroll
    for (int t = 0; t < 16; ++t) {
        f32x2 tt;
        asm("v_pk_fma_f32 %0, %1, %2, %3 op_sel:[1,1,0] op_sel_hi:[1,0,1] neg_lo:[1,0,0]" : "=v"(tt) : "v"(Lp), "v"(hv), "v"(bu[t]));
        asm("v_pk_fma_f32 %0, %1, %2, %3 op_sel:[0,0,0] op_sel_hi:[0,1,1]" : "=v"(hv) : "v"(Lp), "v"(hv), "v"(tt));
        if (FULL) hp[t] = cvt_pk_bf16(hv.x, hv.y); }
    hre = hv.x; him = hv.y;
    if (FULL) {
#pragma unroll
        for (int t = 0; t < 16; ++t) *(LAS unsigned*)(sb + t * SSM_ROWB + 4 * lane) = hp[t]; }
    if (FULL) {
        f32x4 y = (f32x4){0.f, 0.f, 0.f, 0.f};
#pragma unroll
        for (int ks = 0; ks < 4; ++ks) { const bf16x8 hf = *(const LAS bf16x8*)(sb + tok * SSM_ROWB + ks * 64 + q * 16); y = __builtin_amdgcn_mfma_f32_16x16x32_bf16(cf[ks], hf, y, 0, 0, 0); }
        const f32x4 uv = (f32x4){bflo(uraw.x), bfhi(uraw.x), bflo(uraw.y), bfhi(uraw.y)};
        y = y + dsk * uv;
        f32x4 z;
#pragma unroll
        for (int i = 0; i < 4; i += 2) {
            const f32x2 v = (f32x2){y[i], y[i + 1]};
            const f32x2 k2 = (v * v * 0.044715f + 1.0f) * v * (-1.5957691216057308f * 1.4426950408889634f);
            f32x2 e; e.x = __builtin_amdgcn_exp2f(k2.x); e.y = __builtin_amdgcn_exp2f(k2.y);
            const f32x2 d = e + 1.0f; f32x2 r; r.x = __builtin_amdgcn_rcpf(d.x); r.y = __builtin_amdgcn_rcpf(d.y);
            const f32x2 zz = v * r; z[i] = zz.x; z[i + 1] = zz.y; }
        v2u w; w.x = cvt_pk_bf16(z[0], z[1]); w.y = cvt_pk_bf16(z[2], z[3]); if (dost) *(GAS v2u*)zdst = w;
    }
}
template <bool FULL>
__device__ __forceinline__ void ssm_chunk(LAS unsigned char* sb, int lane, const bf16x8 (&uc)[4], const v2u (&ur)[4], const bf16x8 (&af)[8], const bf16x8 (&cf)[4], float lre, float lim, float& hre, float& him,
                                          f32x4 dsk, bf16* Z, size_t row0, int g, bool dost = true) {
    const int tok = lane & 15, q = lane >> 4;
#pragma unroll
    for (int s = 0; s < 4; ++s) ssm_subblock<FULL>(sb, lane, uc[s], af, cf, lre, lim, hre, him, dsk, ur[s], Z + (row0 + 16 * s + tok) * 1024 + 16 * g + 4 * q, dost);
}
__device__ __forceinline__ void ssm_load_u(const bf16* P, size_t row0, int g, int lane, bf16x8 (&u)[4], v2u (&ur)[4], bool full) {
    const int tok = lane & 15, q = lane >> 4;
#pragma unroll
    for (int s = 0; s < 4; ++s) { const bf16* rp = P + (row0 + 16 * s + tok) * NPJ + 16 * g;
        u[s] = q < 2 ? *(const GAS bf16x8*)(rp + 8 * q) : mk_bf16x8(0u, 0u, 0u, 0u);
        ur[s] = full ? *(const GAS v2u*)(rp + 4 * q) : (v2u){0u, 0u}; }
}
__device__ __forceinline__ void ssm_phase(LAS unsigned char* lds, int tid, int wid, int lane, int G, int bx, int l, const Args& A, const bf16* P, bf16* Z) {
    LAS unsigned char* sb = lds + wid * SSM_WSCR;
    LAS f32x2* Sloc = (LAS f32x2*)(lds + 8 * SSM_WSCR);
    const unsigned char* ws = A.ws;
    const int i16 = lane & 15, kb = lane >> 4;
    const int vcu = (G == 256) ? ((bx & 7) >> 1) * 64 + (bx & 1) * 32 + (bx >> 3) : bx;
    for (int unit = vcu; unit < 256; unit += G) {
        const int b = unit >> 6, g = unit & 63, lg = l * 64 + g;
        bf16x8 af[8], cf[4];
        { const bf16* BB = (const bf16*)(ws + WS_BBAR) + (size_t)lg * 128 * 16; const bf16* CM = (const bf16*)(ws + WS_CM) + (size_t)lg * 16 * 128;
#pragma unroll
          for (int nt = 0; nt < 8; ++nt) af[nt] = kb < 2 ? *(const bf16x8*)(BB + (16 * nt + i16) * 16 + 8 * kb) : mk_bf16x8(0u, 0u, 0u, 0u);
#pragma unroll
          for (int ks = 0; ks < 4; ++ks) cf[ks] = *(const bf16x8*)(CM + i16 * 128 + 32 * ks + 8 * kb); }
        const f32x4 lam = *(const f32x4*)((const float*)(ws + WS_LAM) + ((size_t)lg * 64 + lane) * 4);
        const f32x4 dsk = *(const f32x4*)(A.in[20] + (size_t)l * 1024 + 16 * g + 4 * kb);
        const size_t rowb = (size_t)b * 2048 + (size_t)wid * 256;
#ifndef PROBE_SSM
#define PROBE_SSM 0
#endif
        for (int rp1 = 0; rp1 < (PROBE_SSM == 3 ? 2 : 1); ++rp1)
        { bf16x8 un[4]; v2u rn[4]; ssm_load_u(P, rowb, g, lane, un, rn, false);
#pragma unroll 1
          for (int ci = 0; ci < 4; ++ci) { bf16x8 uc[4]; v2u rc[4];
#pragma unroll
              for (int s = 0; s < 4; ++s) { uc[s] = un[s]; rc[s] = rn[s]; }
              if (ci < 3) ssm_load_u(P, rowb + 64 * (ci + 1), g, lane, un, rn, false);
              float hre = 0.f, him = 0.f;
              for (int rp2 = 0; rp2 < (PROBE_SSM == 4 ? 2 : 1); ++rp2) { hre = 0.f; him = 0.f; asm volatile("" : "+v"(hre), "+v"(him));
              ssm_chunk<false>(sb, lane, uc, rc, af, cf, lam.x, lam.y, hre, him, dsk, Z, rowb + 64 * ci, g); }
              Sloc[(4 * wid + ci) * 64 + lane] = (f32x2){hre, him}; } }
        bf16x8 un[4]; v2u rn[4]; ssm_load_u(P, rowb, g, lane, un, rn, true);
        const int sbt = 4 * b + (wid & 3); const size_t so = ((size_t)(l * 16 + sbt) * 64 + g) * 64 + lane; const size_t srow0 = (size_t)TPR + (size_t)sbt * 64;
        bf16x8 us[4]; v2u rs[4]; float sre = 0.f, sim = 0.f;
        if (wid < 4) { ssm_load_u(P, srow0, g, lane, us, rs, true); sre = *(const GAS float*)(A.in[4] + so); sim = *(const GAS float*)(A.in[5] + so); }
        else {
#pragma unroll
            for (int s = 0; s < 4; ++s) { us[s] = mk_bf16x8(0u, 0u, 0u, 0u); rs[s] = (v2u){0u, 0u}; } }
        __syncthreads();
        float hre = 0.f, him = 0.f;
#pragma unroll 4
        for (int c = 0; c < 4 * wid; ++c) { const f32x2 s = Sloc[c * 64 + lane]; const float nre = lam.z * hre - lam.w * him + s.x, nim = lam.z * him + lam.w * hre + s.y; hre = nre; him = nim; }
        {
#pragma unroll 1
          for (int ci = 0; ci < 4; ++ci) { bf16x8 uc[4]; v2u rc[4];
#pragma unroll
              for (int s = 0; s < 4; ++s) { uc[s] = un[s]; rc[s] = rn[s]; }
              if (ci < 3) ssm_load_u(P, rowb + 64 * (ci + 1), g, lane, un, rn, true);
              ssm_chunk<true>(sb, lane, uc, rc, af, cf, lam.x, lam.y, hre, him, dsk, Z, rowb + 64 * ci, g); } }
        if (wid == 7) { const size_t o = ((size_t)(l * 4 + b) * 64 + g) * 64 + lane; A.out[O_PSR + o] = hre; A.out[O_PSI + o] = him; }
        if (wid < 4) {
            ssm_chunk<true>(sb, lane, us, rs, af, cf, lam.x, lam.y, sre, sim, dsk, Z, srow0, g);
            A.out[O_SSR + so] = sre; A.out[O_SSI + so] = sim; }
        __syncthreads();
    }
}

constexpr int AT_KROW = 144, AT_VROW = 392, AT_K = 0, AT_V = 27648, AT_O = 53248, AT_OW = 4608;
__device__ __forceinline__ void attn_unit(LAS unsigned char* lds, int tid, int wid, int lane, int cbk, int hk, const bf16* P, const bf16* QN, const bf16* KN, const float* ck_l, const float* cv_l, const float* sink_l, bf16* AO) {
    LAS unsigned char* Kl = lds + AT_K; LAS unsigned char* Vt = lds + AT_V; LAS unsigned char* Os = lds + AT_O + wid * AT_OW;
    const bool smp = cbk >= 128; const int c = cbk & 31;
    const int kt0 = smp ? 0 : (c >= 2 ? 0 : (c == 1 ? 2 : 4));
    const int q = lane & 31, hi = lane >> 5, rr = wid >> 1, tok0 = 32 * (wid & 1), h = 4 * hk + rr;
    const size_t qrow = (size_t)cbk * 64 + tok0 + q;
    bf16x8 qr[4];
#pragma unroll
    for (int d0 = 0; d0 < 4; ++d0) qr[d0] = *(const GAS bf16x8*)(QN + qrow * 1024 + h * 64 + 16 * d0 + 8 * hi);
    const float sink_h = *(const GAS float*)(sink_l + h);
#pragma unroll
    for (int j = 0; j < 3; ++j) { const int ci = tid + 512 * j, kk = ci >> 3, c8 = ci & 7; v4u kw, vw;
        if (kk < 32 * kt0) { kw = (v4u){0u, 0u, 0u, 0u}; vw = kw; }
        else if (smp && kk < 128) { const size_t so = (((size_t)(cbk - 128) * 128 + kk) * 4 + hk) * 64 + 8 * c8;
            kw = pg8::pack8(*(const f32x4*)(ck_l + so), *(const f32x4*)(ck_l + so + 4)); vw = pg8::pack8(*(const f32x4*)(cv_l + so), *(const f32x4*)(cv_l + so + 4)); }
        else { const size_t grow = (size_t)((cbk - 2) * 64 + kk); kw = *(const GAS v4u*)(KN + grow * 256 + hk * 64 + 8 * c8); vw = *(const GAS v4u*)(P + grow * NPJ + 2304 + hk * 64 + 8 * c8); }
        *(LAS v4u*)(Kl + kk * AT_KROW + 16 * c8) = kw;
        LAS unsigned char* vp = Vt + (8 * c8) * AT_VROW + 2 * kk;
        *(LAS unsigned short*)(vp + 0 * AT_VROW) = (unsigned short)(vw.x & 0xffffu); *(LAS unsigned short*)(vp + 1 * AT_VROW) = (unsigned short)(vw.x >> 16);
        *(LAS unsigned short*)(vp + 2 * AT_VROW) = (unsigned short)(vw.y & 0xffffu); *(LAS unsigned short*)(vp + 3 * AT_VROW) = (unsigned short)(vw.y >> 16);
        *(LAS unsigned short*)(vp + 4 * AT_VROW) = (unsigned short)(vw.z & 0xffffu); *(LAS unsigned short*)(vp + 5 * AT_VROW) = (unsigned short)(vw.z >> 16);
        *(LAS unsigned short*)(vp + 6 * AT_VROW) = (unsigned short)(vw.w & 0xffffu); *(LAS unsigned short*)(vp + 7 * AT_VROW) = (unsigned short)(vw.w >> 16); }
    __syncthreads();
    f32x16 p[6];
#pragma unroll
    for (int T = 0; T < 6; ++T) {
#pragma unroll
        for (int r = 0; r < 16; ++r) p[T][r] = 0.f;
#pragma unroll
        for (int d0 = 0; d0 < 4; ++d0) { const bf16x8 kf = *(const LAS bf16x8*)(Kl + (32 * T + q) * AT_KROW + (16 * d0 + 8 * hi) * 2); p[T] = __builtin_amdgcn_mfma_f32_32x32x16_bf16(kf, qr[d0], p[T], 0, 0, 0); } }
    const float SC = 0.125f * 1.4426950408889634f, sk2 = sink_h * 1.4426950408889634f;
    float mr = -3.0e38f;
#pragma unroll
    for (int T = 0; T < 6; ++T) if (T >= kt0) {
#pragma unroll
        for (int r = 0; r < 16; r += 2) mr = __builtin_fmaxf(__builtin_fmaxf(mr, p[T][r]), p[T][r + 1]); }
    mr = fmaxf(mr, __shfl_xor(mr, 32));
    const float m = fmaxf(mr * SC, sk2), nm = -m;
    float sum = 0.f;
#pragma unroll
    for (int T = 0; T < 6; ++T) {
        if (T >= kt0) {
#pragma unroll
            for (int r = 0; r < 16; ++r) { const float e = __builtin_amdgcn_exp2f(__builtin_fmaf(p[T][r], SC, nm)); p[T][r] = e; sum += e; }
        } else {
#pragma unroll
            for (int r = 0; r < 16; ++r) p[T][r] = 0.f;
        } }
    sum += __shfl_xor(sum, 32);
    const float inv = 1.0f / (sum + __builtin_amdgcn_exp2f(sk2 - m));
    f32x16 o[2];
#pragma unroll
    for (int r = 0; r < 16; ++r) { o[0][r] = 0.f; o[1][r] = 0.f; }
#pragma unroll
    for (int T = 0; T < 6; ++T)
#pragma unroll
        for (int s = 0; s < 2; ++s) {
            const bf16x8 pa = mk_bf16x8(cvt_pk_bf16(p[T][8 * s + 0], p[T][8 * s + 1]), cvt_pk_bf16(p[T][8 * s + 2], p[T][8 * s + 3]), cvt_pk_bf16(p[T][8 * s + 4], p[T][8 * s + 5]), cvt_pk_bf16(p[T][8 * s + 6], p[T][8 * s + 7]));
#pragma unroll
            for (int dt = 0; dt < 2; ++dt) { const LAS unsigned char* vp = Vt + (32 * dt + q) * AT_VROW + 2 * (32 * T + 16 * s + 4 * hi);
                const v2u lo = *(const LAS v2u*)vp, hh = *(const LAS v2u*)(vp + 16);
                o[dt] = __builtin_amdgcn_mfma_f32_32x32x16_bf16(pa, mk_bf16x8(lo.x, lo.y, hh.x, hh.y), o[dt], 0, 0, 0); } }
#pragma unroll
    for (int r = 0; r < 16; ++r) { const int qq = crow(r, hi); const float iv = __shfl(inv, qq);
        *(LAS unsigned short*)(Os + qq * 144 + 2 * q) = (unsigned short)f2bf(o[0][r] * iv);
        *(LAS unsigned short*)(Os + qq * 144 + 2 * (32 + q)) = (unsigned short)f2bf(o[1][r] * iv); }
#pragma unroll
    for (int j = 0; j < 4; ++j) { const int qq = (lane >> 3) + 8 * j, c8 = lane & 7;
        const v4u w = *(const LAS v4u*)(Os + qq * 144 + 16 * c8);
        *(GAS v4u*)(AO + ((size_t)cbk * 64 + tok0 + qq) * 1024 + h * 64 + 8 * c8) = w; }
    __syncthreads();
}

__global__ void __launch_bounds__(NWAVES * 64, 2) enc_fwd(Args args) {
    extern __shared__ __attribute__((aligned(16))) unsigned char lds_raw[];
    LAS unsigned char* lds = (LAS unsigned char*)lds_raw;
    volatile LAS unsigned* MISC = (volatile LAS unsigned*)(lds + MISC_OFF);
    const int wid = __builtin_amdgcn_readfirstlane((int)threadIdx.x >> 6);
    const int G = gridDim.x, bx = blockIdx.x;
    const int gw = bx * NWAVES + wid, NGW = G * NWAVES;
#define MODL ((const float*)(ws + WS_MOD) + (size_t)l * NCB * MODW)
#define FRESH_LANE() int tid_f = threadIdx.x; asm volatile("" : "+v"(tid_f)); const int tid = tid_f, lane = tid & 63; (void)tid; (void)lane
    unsigned char* ws0 = args.ws;
    for (int u = threadIdx.x; u < (LDS_BYTES - LDSCTL_OFF) / 4; u += NWAVES * 64) ((LAS unsigned*)(lds + LDSCTL_OFF))[u] = 0u;
    __syncthreads();
    XcdBarrier bar; bar.bar = (unsigned*)(ws0 + WS_CTL) + CW_BAR; bar.x = 0; bar.st = nullptr;
    if (MK_ONE_LAUNCH) bar = xcd_barrier_post((unsigned*)(ws0 + WS_CTL) + CW_BAR, MISC + 8);
    const int lo = args.ph_lo, hi = args.ph_hi;
#ifndef DISABLE
#define DISABLE 0
#endif
#define IN(k) (lo <= (k) && (k) < hi)
#define EN(i) (((DISABLE >> (i)) & 1) == 0)
#ifndef PROBE_REP
#define PROBE_REP 0
#endif
#ifndef PROBE_L
#define PROBE_L -1
#endif
#define NREP(i) ((((PROBE_REP >> (i)) & 1) && ((i) == 0 || PROBE_L < 0 || l == PROBE_L)) ? 2 : 1)
#ifndef PROBE_BAR
#define PROBE_BAR 1
#endif
#define SEAM(k) do { if (IN((k) + 1)) { for (int nb_ = 0; nb_ < PROBE_BAR; ++nb_) xcd_barrier(bar); } } while (0)
#define H   ((bf16*)(ws + WS_H))
#define P   ((bf16*)(ws + WS_P))
#define QN  ((bf16*)(ws + WS_QN))
#define KN  ((bf16*)(ws + WS_KN))
#define Z   ((bf16*)(ws + WS_Z))
#define SO  ((bf16*)(ws + WS_SO))
#define AO  ((bf16*)(ws + WS_AO))
#define T1  ((bf16*)(ws + WS_T1))
#define MX  ((bf16*)(ws + WS_MX))
#define ACT ((bf16*)(ws + WS_ACT))
#define X   (args.out + O_Y)
#define XB  ((bf16*)(ws + WS_XB))
#define SL  ((bf16*)(ws + WS_SL))
#define FRESH_WS() unsigned char* ws = args.ws; asm volatile("" : "+s"(ws))

#ifndef PROBE_ALL
#define PROBE_ALL 1
#endif
#pragma unroll 1
    for (int pass_ = 0; pass_ < PROBE_ALL; ++pass_) {
    if (EN(0) && IN(0)) { const int l = 0; (void)l; for (int rep = 0; rep < NREP(0); ++rep) { FRESH_LANE(); p0_prologue(args, lds, tid, wid, lane, G, bx); } SEAM(0); }

#pragma unroll 1
    for (int l = 0; l < NL; ++l) {
        const int pb = 1 + 10 * l;
        if (EN(1) && IN(pb + 0)) { for (int rep = 0; rep < NREP(1); ++rep) { FRESH_WS(); FRESH_LANE(); norm_phase(gw, NGW, lane, XB, l == 0 ? args.in[0] : nullptr, args.in[1], l > 0 ? SL : nullptr, args.in[10] + (size_t)l * DM, MODL, 0, 2048, H); } SEAM(pb + 0); }
        if (EN(2) && IN(pb + 1)) { for (int rep = 0; rep < NREP(2); ++rep) { FRESH_WS(); pg8::Gemm g{H, (const bf16*)(ws + WS_W1 + l * SZ_W1), NTOK, 6656, 2048}; pg8::StaticOrder S; S.init(NTOK, 6656, 2048, G, bx);
            pg8::EpiG1 E{P, args.in[27] + (size_t)l * 4096, QN, KN, args.in[23] + l * 64, args.in[24] + l * 64, (const float*)(ws + WS_ROPE), args.out, l, O_PK, O_PV, O_SK, O_SV};
            pg8::gemm_phase<pg8::EpiG1, pg8::StaticOrder, PG8_ALIGN, PG8_SP2>(lds + RING_OFF, g, S, E);
            { FRESH_LANE(); backfill(args, ws, lds, tid, wid, lane, G, bx, 936 - ((936 - 1) / G) * G, NL, 0, 0, l, 6656, 11264); backfill(args, ws, lds, tid, wid, lane, G, bx, 936 - ((936 - 1) / G) * G, NL, 0, 0, l, 15360, 16896); } } SEAM(pb + 1); }
        if (EN(4) && IN(pb + 3)) { for (int rep = 0; rep < NREP(4); ++rep) { FRESH_WS();
#ifndef ATT_IN_GLU
#define ATT_IN_GLU 1
#endif
#ifndef PROBE_SA
#define PROBE_SA 0
#endif
            for (int r2 = 0; r2 < (PROBE_SA == 1 ? 2 : 1); ++r2) { FRESH_LANE(); ssm_phase(lds, tid, wid, lane, G, bx, l, args, P, Z); }
            if (!(ATT_IN_GLU && G == 256)) { FRESH_LANE();
            for (int ai_ = 0; ai_ < 3; ++ai_) { int a = bx + ai_ * G; if (a >= 576) break;
                attn_unit(lds, tid, wid, lane, a >> 2, a & 3, P, QN, KN, args.in[2] + (size_t)l * 16 * 128 * 256, args.in[3] + (size_t)l * 16 * 128 * 256, args.in[25] + l * 16, AO); } }
            } SEAM(pb + 3); }
        if (EN(5) && IN(pb + 4)) { for (int rep = 0; rep < NREP(5); ++rep) { FRESH_WS(); pg8::Gemm g{Z, (const bf16*)(ws + WS_WGLU + l * SZ_WGLU), NTOK, 1024, 1024}; pg8::PanelOrder S; S.init(NTOK, 1024, 1024, G, bx);
            pg8::EpiGLU E{Z, SO, args.in[22] + (size_t)l * 1024};
            pg8::gemm_phase<pg8::EpiGLU, pg8::PanelOrder, PG8_ALIGN, PG8_SP2>(lds + RING_OFF, g, S, E);
            if (ATT_IN_GLU && G == 256) { FRESH_LANE();
                const int j_ = bx >> 3;
                for (int r2 = 0; r2 < (PROBE_SA == 2 ? 2 : 1); ++r2)
                for (int id_ = j_ < 18 ? j_ : 18 + (j_ - 18); id_ < (j_ < 18 ? j_ + 1 : 72); id_ += 14) { const int x_ = bx & 7; const int a = id_ < 64 ? 64 * x_ + id_ : 512 + 8 * x_ + (id_ - 64);
                    attn_unit(lds, tid, wid, lane, a >> 2, a & 3, P, QN, KN, args.in[2] + (size_t)l * 16 * 128 * 256, args.in[3] + (size_t)l * 16 * 128 * 256, args.in[25] + l * 16, AO); } }
            { FRESH_LANE(); backfill(args, ws, lds, tid, wid, lane, G, bx, 144 - ((144 - 1) / G) * G, l + 1, 0, 192, NL, 0, 0); } } SEAM(pb + 4); }
        if (EN(6) && IN(pb + 5)) { for (int rep = 0; rep < NREP(6); ++rep) { FRESH_WS();
            { pg8::Gemm g{SO, (const bf16*)(ws + WS_WPS + l * SZ_WP), NTOK, 2048, 1024}; pg8::PROrder S; S.init(NTOK, 2048, 1024, G, bx, 0);
              pg8::EpiPR<0> E{P, nullptr, T1, (unsigned*)(ws + WS_CTL + 32768) + (size_t)l * 32 * 64};
              pg8::gemm_phase<pg8::EpiPR<0>, pg8::PROrder, PG8_ALIGN, PG8_SP2>(lds + RING_OFF, g, S, E); }
            VM_WAIT(); __syncthreads();
            { pg8::Gemm g{AO, (const bf16*)(ws + WS_WPA + l * SZ_WP), NTOK, 2048, 1024}; pg8::PROrder S; S.init(NTOK, 2048, 1024, G, bx, 4);
              pg8::EpiPR<1> E{P, T1, MX, (unsigned*)(ws + WS_CTL + 32768) + (size_t)l * 32 * 64};
              pg8::gemm_phase<pg8::EpiPR<1>, pg8::PROrder, PG8_ALIGN, PG8_SP2>(lds + RING_OFF, g, S, E); }
            { FRESH_LANE(); backfill(args, ws, lds, tid, wid, lane, G, bx, G == 256 ? 64 : 288 - ((288 - 1) / G) * G, l + 1, 192, 384, l, 16896, 22528); }
            } SEAM(pb + 5); }
        if (EN(7) && IN(pb + 6)) { for (int rep = 0; rep < NREP(7); ++rep) { FRESH_WS(); pg8::Gemm g{MX, (const bf16*)(ws + WS_WOUT + l * SZ_WOUT), NTOK, 2048, 2048}; pg8::SplitOrder S; S.init(2048, G, bx);
            pg8::EpiRes E{(NREP(7) == 2 && rep == 0) ? (bf16*)(ws + WS_ACT) : XB, nullptr, MODL + 4096, SL};
            pg8::gemm_phase<pg8::EpiRes, pg8::SplitOrder, PG8_ALIGN, PG8_SP2>(lds + RING_OFF, g, S, E); } SEAM(pb + 6); }
        if (EN(8) && IN(pb + 7)) { for (int rep = 0; rep < NREP(8); ++rep) { FRESH_WS(); FRESH_LANE(); norm_phase(gw, NGW, lane, XB, nullptr, nullptr, SL, args.in[11] + (size_t)l * DM, MODL, 6144, 8192, H); } SEAM(pb + 7); }
        if (EN(9) && IN(pb + 8)) { for (int rep = 0; rep < NREP(9); ++rep) { FRESH_WS(); pg8::Gemm g{H, (const bf16*)(ws + WS_WGU + l * SZ_WGU), NTOK, 11264, 2048}; pg8::StaticOrder S; S.init(NTOK, 11264, 2048, G, bx);
            pg8::EpiFU E{ACT};
            pg8::gemm_phase<pg8::EpiFU, pg8::StaticOrder, PG8_ALIGN, PG8_SP2>(lds + RING_OFF, g, S, E);
            { FRESH_LANE(); backfill(args, ws, lds, tid, wid, lane, G, bx, 1584 - ((1584 - 1) / G) * G, NL, 0, 0, l, 22528, CONV_PER_L); backfill(args, ws, lds, tid, wid, lane, G, bx, 1584 - ((1584 - 1) / G) * G, NL, 0, 0, l + 1, 0, 6656); backfill(args, ws, lds, tid, wid, lane, G, bx, 1584 - ((1584 - 1) / G) * G, NL, 0, 0, l + 1, 11264, 15360); } } SEAM(pb + 8); }
        if (EN(10) && IN(pb + 9)) { for (int rep = 0; rep < NREP(10); ++rep) { FRESH_WS(); pg8::Gemm g{ACT, (const bf16*)(ws + WS_WDN + l * SZ_WDN), NTOK, 2048, 5632}; pg8::SplitOrder S; S.init(5632, G, bx);
            pg8::EpiRes E{(NREP(10) == 2 && rep == 0) ? (bf16*)(ws + WS_P) : XB, l == NL - 1 ? X : nullptr, MODL + 10240, SL};
            pg8::gemm_phase<pg8::EpiRes, pg8::SplitOrder, PG8_ALIGN, PG8_SP2>(lds + RING_OFF, g, S, E); } SEAM(pb + 9); }
    }
    if (IN(NPHASE - 1)) { FRESH_WS(); FRESH_LANE(); final_phase(gw, NGW, lane, X, XB, SL); }
    if (pass_ + 1 < PROBE_ALL) xcd_barrier(bar);
    }
#undef IN
#undef SEAM
#undef H
#undef P
#undef QN
#undef KN
#undef Z
#undef SO
#undef AO
#undef T1
#undef MX
#undef ACT
#undef X
#undef XB
#undef SL
}

extern "C" void kernel_launch(void* const* d_in, const int* in_sizes, int n_in, void* d_out, int out_size, void* d_ws, size_t ws_size, hipStream_t stream) {
    static int grid = 0;
    if (grid == 0) {
        if (n_in != 34 || out_size != (int)O_END || ws_size < WS_END) { fprintf(stderr, "kernel_launch: built for 34 inputs, %zu outputs, >= %zu bytes of workspace; got n_in %d, out %d, ws %zu; nothing launched\n", (size_t)O_END, (size_t)WS_END, n_in, out_size, ws_size); grid = -1; return; }
        int dev = 0, cus = 0, per_cu = 0;
        if (hipGetDevice(&dev) != hipSuccess || hipDeviceGetAttribute(&cus, hipDeviceAttributeMultiprocessorCount, dev) != hipSuccess) { fprintf(stderr, "kernel_launch: device query failed\n"); grid = -1; return; }
        if (hipFuncSetAttribute((const void*)enc_fwd, hipFuncAttributeMaxDynamicSharedMemorySize, LDS_BYTES) != hipSuccess) { fprintf(stderr, "kernel_launch: hipFuncSetAttribute failed\n"); grid = -1; return; }
        if (hipOccupancyMaxActiveBlocksPerMultiprocessor(&per_cu, (const void*)enc_fwd, NWAVES * 64, LDS_BYTES) != hipSuccess || per_cu < 1)
            fprintf(stderr, "kernel_launch: note: occupancy query reports %d workgroups per CU\n", per_cu);
        (void)hipGetLastError();
        grid = cus;
    }
    if (grid < 0) return;
    if (hipMemsetAsync((char*)d_ws + WS_CTL, 0, CTL_ZERO_BYTES, stream) != hipSuccess) { fprintf(stderr, "kernel_launch: memset failed\n"); return; }
    Args a{};
    for (int i = 0; i < 34; ++i) a.in[i] = (const float*)d_in[i];
    a.out = (float*)d_out; a.ws = (unsigned char*)d_ws;
#if MK_ONE_LAUNCH
    a.ph_lo = 0; a.ph_hi = NPHASE;
    hipLaunchKernelGGL(enc_fwd, dim3(grid), dim3(NWAVES * 64), LDS_BYTES, stream, a);
#else
    for (int ph = 0; ph < NPHASE; ++ph) { a.ph_lo = ph; a.ph_hi = ph + 1; hipLaunchKernelGGL(enc_fwd, dim3(grid), dim3(NWAVES * 64), LDS_BYTES, stream, a); }
#endif
    const hipError_t le = hipPeekAtLastError();
    if (le != hipSuccess) fprintf(stderr, "kernel_launch: launch failed: %s\n", hipGetErrorName(le));
}
```

```cpp
#include <hip/hip_runtime.h>
#include <cstdio>
#include <cstdint>
#define GAS __attribute__((address_space(1)))
namespace pg8 {
#define PG8_LAS __attribute__((address_space(3)))
typedef unsigned short bf16_t;
typedef short bf16x8 __attribute__((ext_vector_type(8)));
typedef float f32x4 __attribute__((ext_vector_type(4)));
typedef unsigned u32x4 __attribute__((ext_vector_type(4)));
constexpr int BM = 256, BK = 64, HALF = 128, HTB = HALF * BK * 2  , STAGE_BYTES = 8 * HTB, NXCD = 8, WGM = 6;

__host__ __device__ __forceinline__ int lds_byte(int r, int c) { const int st = (r >> 4) * 2 + (c >> 5), rr = r & 15, cc = c & 31, ob = rr * 64 + cc * 2; return st * 1024 + (ob ^ (((ob >> 9) & 1) << 5)); }
__host__ __device__ __forceinline__ void stage_rc(int b, int& R, int& C) { const int st = b / 1024, sb = b % 1024, swz = sb ^ (((sb >> 9) & 1) << 5); R = (st >> 1) * 16 + swz / 64; C = (st & 1) * 32 + (swz % 64) / 2; }
__host__ __device__ __forceinline__ int perm32(int rho) { const int n = rho >> 4, i = rho & 15; return 8 * (i >> 2) + 4 * n + (i & 3); }

#ifndef SPLIT_SWAP
#define SPLIT_SWAP 0
#endif
#ifndef ORD_TR
#define ORD_TR 0
#endif
#ifndef KROT
#define KROT 0
#endif
struct Unit { int pm, pn, kt0, nkt, slab, krot; };
struct Gemm { const bf16_t* A; const bf16_t* Bt; int M, N, K; };

struct StaticOrder {
    int nM, nN, nwg, G, c, nkt;
    __host__ __device__ void init(int M, int N, int K, int G_, int c_) { nM = M / BM; nN = N / BM; nwg = nM * nN; G = G_; c = c_; nkt = K / BK; }
    __host__ __device__ bool next(int i, Unit& u) const {
        const long L = (long)i * G + c; if (L >= nwg) return false;
        int wgid = (int)L; { const int q = nwg / NXCD, r = nwg % NXCD, xcd = wgid % NXCD, off = wgid / NXCD; wgid = (xcd < r ? xcd * (q + 1) : r * (q + 1) + (xcd - r) * q) + off; }
        if (ORD_TR > 0) {
            const int nig = ORD_TR * nM, gid = wgid / nig, fn = gid * ORD_TR, gsz = (nN - fn) < ORD_TR ? (nN - fn) : ORD_TR;
            u.pn = fn + ((wgid % nig) % gsz); u.pm = (wgid % nig) / gsz; u.kt0 = 0; u.nkt = nkt; u.slab = -1; u.krot = 0; return true; }
        const int nig = WGM * nN, gid = wgid / nig, fm = gid * WGM, gsz = (nM - fm) < WGM ? (nM - fm) : WGM;
        u.pm = fm + ((wgid % nig) % gsz); u.pn = (wgid % nig) / gsz; u.kt0 = 0; u.nkt = nkt; u.slab = -1; u.krot = KROT ? 2 * (((c & 7) * (nkt >> 1)) >> 3) : 0; return true;
    }
    __device__ __forceinline__ void a_ready(const Unit&) const {}
    __device__ __forceinline__ void done(const Unit&) const {}
};
struct PanelOrder {
    StaticOrder so; int nN, nkt, G, c;
    __host__ __device__ void init(int M, int N, int K, int G_, int c_) { so.init(M, N, K, G_, c_); nN = N / BM; nkt = K / BK; G = G_; c = c_; }
    __host__ __device__ bool next(int i, Unit& u) const {
        if (G != 256 || so.nM != 36) return so.next(i, u);
        const int x = c & 7, j = c >> 3, id = 32 * i + j, np = 4 * nN, ns = np >> 3;
        if (id >= np + ns) return false;
        if (id < np) { u.pm = 4 * x + (id & 3); int pn = (id >> 2) + (x * nN) / 8; u.pn = pn >= nN ? pn - nN : pn; }
        else { const int s = x * ns + (id - np); u.pm = 32 + (s & 3); u.pn = s >> 2; }
        u.kt0 = 0; u.nkt = nkt; u.slab = -1; u.krot = 0; return true;
    }
    __device__ __forceinline__ void a_ready(const Unit&) const {}
    __device__ __forceinline__ void done(const Unit&) const {}
};
struct PROrder {
    StaticOrder so; int G, c, nkt, sj0;
    __host__ __device__ void init(int M, int N, int K, int G_, int c_, int sj0_) { so.init(M, N, K, G_, c_); G = G_; c = c_; nkt = K / BK; sj0 = sj0_; }
    __host__ __device__ bool next(int i, Unit& u) const {
        if (G != 256) return so.next(i, u);
        const int x = c & 7, j = c >> 3;
        if (i == 0) { u.pm = 4 * x + (j & 3); const int pn = (j >> 2) + x; u.pn = pn & 7; }
        else if (i == 1) { const int jj = j - sj0; if (jj < 0 || jj >= 4) return false; const int s = 4 * x + jj; u.pm = 32 + (s & 3); u.pn = s >> 2; }
        else return false;
        u.kt0 = 0; u.nkt = nkt; u.slab = -1; u.krot = 0; return true;
    }
    __device__ __forceinline__ void a_ready(const Unit&) const {}
    __device__ __forceinline__ void done(const Unit&) const {}
};
struct BlockOrder {
    StaticOrder so; int nN, nkt, G, c;
    __host__ __device__ void init(int M, int N, int K, int G_, int c_) { so.init(M, N, K, G_, c_); nN = N / BM; nkt = K / BK; G = G_; c = c_; }
    __host__ __device__ bool next(int i, Unit& u) const {
        if (G != 256 || so.nM != 36 || (nN & 1)) return so.next(i, u);
        const int x = c & 7, j = c >> 3, id = 32 * i + j, hn = nN >> 1;
        if (id >= 9 * hn) return false;
        u.pm = 9 * (x >> 1) + id % 9; u.pn = (x & 1) * hn + id / 9; u.kt0 = 0; u.nkt = nkt; u.slab = -1; u.krot = 0; return true;
    }
    __device__ __forceinline__ void a_ready(const Unit&) const {}
    __device__ __forceinline__ void done(const Unit&) const {}
};
struct SplitOrder {
    int G, c, nkt;
    __host__ __device__ void init(int K, int G_, int c_) { G = G_; c = c_; nkt = K / BK; }
    __host__ __device__ bool next(int i, Unit& u) const {
        int e = i * G + c; if (e >= 512) return false;
        if (SPLIT_SWAP && G == 256 && (c & 1)) e ^= 256;
        const int f = e & 255, x = f & 7, j = f >> 3;
        if (e < 256) { u.pm = 4 * x + (j >> 3); u.pn = j & 7; u.kt0 = 0; u.nkt = nkt; u.slab = -1; u.krot = KROT ? 2 * ((x * (nkt >> 1)) >> 3) : 0; }
        else { const int np = nkt >> 1, base = np >> 3, rem = np & 7, pairs = base + (x < rem ? 1 : 0), start = x * base + (x < rem ? x : rem);
            u.pm = 32 + (j >> 3); u.pn = j & 7; u.kt0 = 2 * start; u.nkt = 2 * pairs; u.slab = x; u.krot = 0; }
        return true;
    }
    __device__ __forceinline__ void a_ready(const Unit&) const {}
    __device__ __forceinline__ void done(const Unit&) const {}
};

__device__ __forceinline__ unsigned cvt_pk_bf16(float lo, float hi) { unsigned r; asm volatile("v_cvt_pk_bf16_f32 %0, %1, %2" : "=v"(r) : "v"(lo), "v"(hi)); return r; }
typedef float f32x2 __attribute__((ext_vector_type(2)));
typedef unsigned u32x2 __attribute__((ext_vector_type(2)));
__device__ __forceinline__ float bflo(unsigned w) { return __uint_as_float(w << 16); }
__device__ __forceinline__ float bfhi(unsigned w) { return __uint_as_float(w & 0xffff0000u); }
__device__ __forceinline__ float sigmoidf_(float x) { return __builtin_amdgcn_rcpf(1.0f + __builtin_amdgcn_exp2f(-1.4426950408889634f * x)); }
__device__ __forceinline__ f32x4 sigmoid4(f32x4 v) { f32x4 o; o[0] = sigmoidf_(v[0]); o[1] = sigmoidf_(v[1]); o[2] = sigmoidf_(v[2]); o[3] = sigmoidf_(v[3]); return o; }
__device__ __forceinline__ u32x4 pack8(f32x4 v0, f32x4 v1) { u32x4 w; w.x = cvt_pk_bf16(v0[0], v0[1]); w.y = cvt_pk_bf16(v0[2], v0[3]); w.z = cvt_pk_bf16(v1[0], v1[1]); w.w = cvt_pk_bf16(v1[2], v1[3]); return w; }
#ifndef WT_STORES
#define WT_STORES 0
#endif
__device__ __forceinline__ void store16_wt(void* p, u32x4 w) {
    if (WT_STORES) asm volatile("global_store_dwordx4 %0, %1, off sc1\n\ts_nop 1" :: "v"(p), "v"(w) : "memory");
    else *(GAS u32x4*)p = w;
}
__device__ __forceinline__ void unpack8(u32x4 w, f32x4& v0, f32x4& v1) { v0 = (f32x4){bflo(w.x), bfhi(w.x), bflo(w.y), bfhi(w.y)}; v1 = (f32x4){bflo(w.z), bfhi(w.z), bflo(w.w), bfhi(w.w)}; }

constexpr int NPJ = 6656;
struct EpiG1 {
    static constexpr bool PERM = true, AFTER_DRAIN = false, IDEMPOTENT = true;
    bf16_t* P; const float* bgate; bf16_t* QN; bf16_t* KN; const float* qg; const float* kg; const float* rope; float* out; int l;
    size_t o_pk, o_pv, o_sk, o_sv;
    __device__ __forceinline__ void operator()(const f32x4 (&acc)[2][2][4][2], const Unit& u, int wr, int wc, int fr_in, int fq_in) const {
        int fr = fr_in, fq = fq_in; asm volatile("" : "+v"(fr), "+v"(fq));
        const int row0 = u.pm * BM + wr * 64 + fr;
        if (u.pn >= 4 && u.pn <= 8) {
            const bool isk = u.pn == 8;
            const float* g = isk ? kg : qg;
            f32x4 gv[2][2];
#pragma unroll
            for (int bj = 0; bj < 2; ++bj)
#pragma unroll
                for (int n = 0; n < 2; ++n) gv[bj][n] = *(const f32x4*)(g + 32 * bj + 8 * fq + 4 * n);
#pragma unroll
            for (int ai = 0; ai < 2; ++ai)
#pragma unroll
                for (int m = 0; m < 4; ++m) {
                    const int row = row0 + ai * HALF + m * 16;
                    const bool smp = row >= 8192; const int t = smp ? ((row - 8192) & 63) : (row & 2047); const int bb = smp ? ((row - 8192) >> 6) : (row >> 11);
                    const float* rt = rope + (smp ? 2048 + t : t) * 16;
                    const f32x4 c0 = *(const GAS f32x4*)(rt), c1 = *(const GAS f32x4*)(rt + 4), s0 = *(const GAS f32x4*)(rt + 8), s1 = *(const GAS f32x4*)(rt + 12);
                    f32x4 y[2][2]; float ss = 0.f;
#pragma unroll
                    for (int bj = 0; bj < 2; ++bj)
#pragma unroll
                        for (int n = 0; n < 2; ++n) { y[bj][n] = acc[ai][bj][m][n]; ss += (y[bj][n][0] * y[bj][n][0] + y[bj][n][1] * y[bj][n][1]) + (y[bj][n][2] * y[bj][n][2] + y[bj][n][3] * y[bj][n][3]); }
                    ss += __shfl_xor(ss, 16); ss += __shfl_xor(ss, 32);
                    const float rstd = 1.0f / sqrtf(ss * (1.0f / 64.0f) + 1e-6f);
#pragma unroll
                    for (int bj = 0; bj < 2; ++bj)
#pragma unroll
                        for (int n = 0; n < 2; ++n) y[bj][n] = y[bj][n] * rstd * gv[bj][n];
                    f32x4 p0, p1;
#pragma unroll
                    for (int i = 0; i < 4; ++i) { p0[i] = __shfl_xor(y[0][0][i], 16); p1[i] = __shfl_xor(y[0][1][i], 16); }
                    if (fq == 0) { y[0][0] = y[0][0] * c0 - p0 * s0; y[0][1] = y[0][1] * c1 - p1 * s1; }
                    else if (fq == 1) { y[0][0] = y[0][0] * c0 + p0 * s0; y[0][1] = y[0][1] * c1 + p1 * s1; }
                    if (!isk) { bf16_t* qp = QN + (size_t)row * 1024 + (4 * (u.pn - 4) + wc) * 64 + 8 * fq;
                        *(GAS u32x4*)(qp) = pack8(y[0][0], y[0][1]); *(GAS u32x4*)(qp + 32) = pack8(y[1][0], y[1][1]); }
                    else { const int co = wc * 64 + 8 * fq; bf16_t* kp = KN + (size_t)row * 256 + co;
                        *(GAS u32x4*)(kp) = pack8(y[0][0], y[0][1]); *(GAS u32x4*)(kp + 32) = pack8(y[1][0], y[1][1]);
                        if (smp || t >= 1920) { float* d = out + (smp ? o_sk + ((size_t)(l * 16 + bb) * 128 + 64 + t) * 256 : o_pk + ((size_t)(l * 4 + bb) * 128 + (t - 1920)) * 256) + co;
                            *(f32x4*)(d) = y[0][0]; *(f32x4*)(d + 4) = y[0][1]; *(f32x4*)(d + 32) = y[1][0]; *(f32x4*)(d + 36) = y[1][1]; } }
                }
            return;
        }
        const int col0 = u.pn * BM + wc * 32 + 8 * fq;
        const bool isg = u.pn >= 10, isv = u.pn == 9;
        f32x4 bv[2][2];
#pragma unroll
        for (int bj = 0; bj < 2; ++bj)
#pragma unroll
            for (int n = 0; n < 2; ++n) bv[bj][n] = isg ? *(const f32x4*)(bgate + (col0 - 2560) + bj * HALF + 4 * n) : (f32x4){0.f, 0.f, 0.f, 0.f};
#pragma unroll
        for (int ai = 0; ai < 2; ++ai)
#pragma unroll
            for (int m = 0; m < 4; ++m) { const int row = row0 + ai * HALF + m * 16; bf16_t* rowp = P + (size_t)row * NPJ + col0;
#pragma unroll
                for (int bj = 0; bj < 2; ++bj) { f32x4 v0 = acc[ai][bj][m][0] + bv[bj][0], v1 = acc[ai][bj][m][1] + bv[bj][1];
                    if (isg) { v0 = sigmoid4(v0); v1 = sigmoid4(v1); }
                    const u32x4 w = pack8(v0, v1); store16_wt(rowp + bj * HALF, w);
                    if (isv) { const bool smp = row >= 8192; const int t = smp ? ((row - 8192) & 63) : (row & 2047); const int bb = smp ? ((row - 8192) >> 6) : (row >> 11);
                        if (smp || t >= 1920) { float* d = out + (smp ? o_sv + ((size_t)(l * 16 + bb) * 128 + 64 + t) * 256 : o_pv + ((size_t)(l * 4 + bb) * 128 + (t - 1920)) * 256) + (col0 - 2304) + bj * HALF;
                            f32x4 r0, r1; unpack8(w, r0, r1); *(f32x4*)(d) = r0; *(f32x4*)(d + 4) = r1; } } } }
    }
};
struct EpiGLU {
    static constexpr bool PERM = true, AFTER_DRAIN = false, IDEMPOTENT = true;
    const bf16_t* Z; bf16_t* SO; const float* bglu;
    __device__ __forceinline__ void operator()(const f32x4 (&acc)[2][2][4][2], const Unit& u, int wr, int wc, int fr, int fq) const {
        const int row0 = u.pm * BM + wr * 64 + fr, col0 = u.pn * BM + wc * 32 + 8 * fq;
        f32x4 bv[2][2];
#pragma unroll
        for (int bj = 0; bj < 2; ++bj)
#pragma unroll
            for (int n = 0; n < 2; ++n) bv[bj][n] = *(const f32x4*)(bglu + col0 + bj * HALF + 4 * n);
#pragma unroll
        for (int ai = 0; ai < 2; ++ai)
#pragma unroll
            for (int m = 0; m < 4; ++m) { const size_t off = (size_t)(row0 + ai * HALF + m * 16) * 1024 + col0;
#pragma unroll
                for (int bj = 0; bj < 2; ++bj) { f32x4 z0, z1; unpack8(*(const GAS u32x4*)(Z + off + bj * HALF), z0, z1);
                    const f32x4 v0 = z0 * sigmoid4(acc[ai][bj][m][0] + bv[bj][0]), v1 = z1 * sigmoid4(acc[ai][bj][m][1] + bv[bj][1]);
                    *(GAS u32x4*)(SO + off + bj * HALF) = pack8(v0, v1); } }
    }
};
template <int MODE> struct EpiPR {
    static constexpr bool PERM = true, AFTER_DRAIN = false, IDEMPOTENT = true;
    const bf16_t* P; const bf16_t* T1; bf16_t* O; unsigned* flags;
    __device__ __forceinline__ void operator()(const f32x4 (&acc)[2][2][4][2], const Unit& u, int wr, int wc, int fr, int fq) const {
        const int row0 = u.pm * BM + wr * 64 + fr, col0 = u.pn * BM + wc * 32 + 8 * fq;
        const bool samp = u.pm >= 32;
        GAS unsigned* flag = (GAS unsigned*)(flags + 64 * (u.pn * 4 + (u.pm & 3)));
        if (MODE == 1 && samp) {
            unsigned spins = 0u;
            while (__hip_atomic_load(flag, __ATOMIC_RELAXED, __HIP_MEMORY_SCOPE_AGENT) < 8u) { __builtin_amdgcn_s_sleep(2); if (++spins > (1u << 18)) break; }
            __builtin_amdgcn_fence(__ATOMIC_ACQUIRE, "agent"); asm volatile("s_waitcnt vmcnt(0)" ::: "memory");
        }
#pragma unroll
        for (int ai = 0; ai < 2; ++ai)
#pragma unroll
            for (int m = 0; m < 4; ++m) { const size_t r = (size_t)(row0 + ai * HALF + m * 16); const size_t off = r * 2048 + col0; const bf16_t* gp = P + r * NPJ + 2560 + MODE * 2048 + col0;
#pragma unroll
                for (int bj = 0; bj < 2; ++bj) { f32x4 g0, g1; unpack8(*(const GAS u32x4*)(gp + bj * HALF), g0, g1);
                    f32x4 v0 = g0 * acc[ai][bj][m][0], v1 = g1 * acc[ai][bj][m][1];
                    if (MODE == 1) { f32x4 t0, t1; unpack8(*(const GAS u32x4*)(T1 + off + bj * HALF), t0, t1); v0 += t0; v1 += t1; }
                    const u32x4 w = pack8(v0, v1);
                    if (MODE == 0 && samp) asm volatile("global_store_dwordx4 %0, %1, off sc1\n\ts_nop 1" :: "v"(O + off + bj * HALF), "v"(w) : "memory");
                    else *(GAS u32x4*)(O + off + bj * HALF) = w; } }
        if (MODE == 0 && samp) {
            asm volatile("s_waitcnt vmcnt(0)" ::: "memory");
            if (fr == 0 && fq == 0) __hip_atomic_fetch_add(flag, 1u, __ATOMIC_RELAXED, __HIP_MEMORY_SCOPE_AGENT);
        }
    }
};
struct EpiRes {
    static constexpr bool PERM = true, AFTER_DRAIN = false, IDEMPOTENT = false;
    bf16_t* XB; float* OUTF; const float* gmod; bf16_t* SL;
    __device__ __forceinline__ void operator()(const f32x4 (&acc)[2][2][4][2], const Unit& u, int wr, int wc, int fr, int fq) const {
        const int col0 = u.pn * BM + wc * 32 + 8 * fq;
        const bool part = u.slab >= 0;
#pragma unroll
        for (int ai = 0; ai < 2; ++ai) {
            const int rb = u.pm * BM + ai * HALF + wr * 64;
            const int cb = rb < 8192 ? (rb >> 11) : 4 + ((rb - 8192) >> 6);
            const float* g = gmod + (size_t)cb * 12288 + col0;
            f32x4 gv[2][2];
#pragma unroll
            for (int bj = 0; bj < 2; ++bj)
#pragma unroll
                for (int n = 0; n < 2; ++n) gv[bj][n] = *(const GAS f32x4*)(g + bj * HALF + 4 * n);
            if (part) { bf16_t* base = SL + ((size_t)u.slab * 1024 + (size_t)(rb - 8192 + fr)) * 2048 + col0;
#pragma unroll
                for (int m = 0; m < 4; ++m)
#pragma unroll
                    for (int bj = 0; bj < 2; ++bj) *(GAS u32x4*)(base + (size_t)(m * 16) * 2048 + bj * HALF) = pack8(gv[bj][0] * acc[ai][bj][m][0], gv[bj][1] * acc[ai][bj][m][1]);
            } else { const size_t o0 = (size_t)(rb + fr) * 2048 + col0;
#pragma unroll
                for (int m = 0; m < 4; ++m)
#pragma unroll
                    for (int bj = 0; bj < 2; ++bj) { const size_t o = o0 + (size_t)(m * 16) * 2048 + bj * HALF; f32x4 x0, x1; unpack8(*(const GAS u32x4*)(XB + o), x0, x1);
                        const f32x4 v0 = x0 + gv[bj][0] * acc[ai][bj][m][0], v1 = x1 + gv[bj][1] * acc[ai][bj][m][1];
                        if (OUTF != nullptr) { *(GAS f32x4*)(OUTF + o) = v0; *(GAS f32x4*)(OUTF + o + 4) = v1; } else *(GAS u32x4*)(XB + o) = pack8(v0, v1); }
            }
        }
    }
};
struct EpiFU {
    static constexpr bool PERM = true, AFTER_DRAIN = false, IDEMPOTENT = true;
    bf16_t* ACT;
    __device__ __forceinline__ void operator()(const f32x4 (&acc)[2][2][4][2], const Unit& u, int wr, int wc, int fr, int fq) const {
        const int row0 = u.pm * BM + wr * 64 + fr, col0 = u.pn * HALF + wc * 32 + 8 * fq;
#pragma unroll
        for (int ai = 0; ai < 2; ++ai)
#pragma unroll
            for (int m = 0; m < 4; ++m) {
                const f32x4 g0 = acc[ai][0][m][0], g1 = acc[ai][0][m][1];
                const f32x4 v0 = g0 * sigmoid4(g0) * acc[ai][1][m][0], v1 = g1 * sigmoid4(g1) * acc[ai][1][m][1];
                store16_wt(ACT + (size_t)(row0 + ai * HALF + m * 16) * 5632 + col0, pack8(v0, v1)); }
    }
};

template <class Epi, class Sched, bool ALIGN_EPI = false, bool SP2 = false>
__device__ __forceinline__ void gemm_phase(PG8_LAS unsigned char* lds, const Gemm g, const Sched& S, const Epi& E) {
    int tid_l = threadIdx.x; asm volatile("" : "+v"(tid_l));
    const int tid = tid_l, wid = __builtin_amdgcn_readfirstlane(tid >> 6), lane = tid & 63, wr = wid >> 2, wc = wid & 3, fr = lane & 15, fq = lane >> 4;
    const int K = g.K;
    unsigned voffA[2], voffB[2];
#pragma unroll
    for (int i = 0; i < 2; ++i) { int R, C; stage_rc(tid * 16 + i * 8192, R, C); const int Rb = Epi::PERM ? ((R & ~31) + perm32(R & 31)) : R;
        voffA[i] = (unsigned)(R * K + C) * 2u; voffB[i] = (unsigned)(Rb * K + C) * 2u; }
    const size_t kstep = (size_t)(BK * 2);
    const size_t hstep = (size_t)HALF * K * 2;
    const size_t tstep = 2 * hstep;
    const unsigned ldsw = (unsigned)wid * 1024u;
    const int aoff = lds_byte(wr * 64 + fr, fq * 8), boff = lds_byte(wc * 32 + fr, fq * 8);
#define PG8_SA(b, h) (((b) * 2 + (h)) * HTB)
#define PG8_SB(b, h) ((4 + (b) * 2 + (h)) * HTB)
#ifndef AUX_A
#define AUX_A 0
#endif
#ifndef AUX_B
#define AUX_B 0
#endif
#define PG8_STAGE(bufoff, gbase, voff) do { _Pragma("unroll") for (int _i = 0; _i < 2; ++_i) \
        __builtin_amdgcn_global_load_lds((const unsigned*)((const char*)(gbase) + (voff)[_i]), (PG8_LAS unsigned*)(lds + (bufoff) + ldsw + _i * 8192), 16, 0, AUX_A); } while (0)
#define PG8_STAGEB(bufoff, gbase, voff) do { _Pragma("unroll") for (int _i = 0; _i < 2; ++_i) \
        __builtin_amdgcn_global_load_lds((const unsigned*)((const char*)(gbase) + (voff)[_i]), (PG8_LAS unsigned*)(lds + (bufoff) + ldsw + _i * 8192), 16, 0, AUX_B); } while (0)
#define PG8_LDA(dst, b, h) do { _Pragma("unroll") for (int m = 0; m < 4; ++m) _Pragma("unroll") for (int k = 0; k < 2; ++k) dst[m][k] = *(const PG8_LAS bf16x8*)(lds + PG8_SA(b, h) + aoff + m * 2048 + k * 1024); } while (0)
#define PG8_LDB(dst, b, h) do { _Pragma("unroll") for (int n = 0; n < 2; ++n) _Pragma("unroll") for (int k = 0; k < 2; ++k) dst[n][k] = *(const PG8_LAS bf16x8*)(lds + PG8_SB(b, h) + boff + n * 2048 + k * 1024); } while (0)
#define PG8_MMA(ai, bj, At, Bt) do { __builtin_amdgcn_s_setprio(1); _Pragma("unroll") for (int m = 0; m < 4; ++m) _Pragma("unroll") for (int n = 0; n < 2; ++n) _Pragma("unroll") for (int k = 0; k < 2; ++k) \
        acc[ai][bj][m][n] = __builtin_amdgcn_mfma_f32_16x16x32_bf16(Bt[n][k], At[m][k], acc[ai][bj][m][n], 0, 0, 0); __builtin_amdgcn_s_setprio(0); } while (0)
#define PG8_WAIT_V(n) asm volatile("s_waitcnt vmcnt(" #n ")" ::: "memory")
#define PG8_WAIT_L(n) asm volatile("s_waitcnt lgkmcnt(" #n ")" ::: "memory")
#define PG8_BAR __builtin_amdgcn_s_barrier()
#define PG8_SCHED __builtin_amdgcn_sched_barrier(0)
    Unit cur, nxt; int ui = 0;
    if (!S.next(0, cur)) return;
    f32x4 acc[2][2][4][2];
#pragma unroll
    for (int a = 0; a < 2; ++a)
#pragma unroll
        for (int b = 0; b < 2; ++b)
#pragma unroll
            for (int m = 0; m < 4; ++m)
#pragma unroll
                for (int n = 0; n < 2; ++n) acc[a][b][m][n] = (f32x4){0.f, 0.f, 0.f, 0.f};
    bf16x8 At[4][2], B0[2][2], B1[2][2];
    const char* cA = (const char*)g.A + (size_t)cur.pm * tstep + (size_t)cur.kt0 * kstep; const char* cB = (const char*)g.Bt + (size_t)cur.pn * tstep + (size_t)cur.kt0 * kstep;
    S.a_ready(cur);
#define PG8_KP(base, p, rot_, nt_) ((base) + (size_t)((p) + (rot_) < (nt_) ? (p) + (rot_) : (p) + (rot_) - (nt_)) * kstep)
    { const int rot0 = cur.krot, nt0 = cur.nkt; const char* sA0 = PG8_KP(cA, 0, rot0, nt0); const char* sA1 = PG8_KP(cA, 1, rot0, nt0); const char* sB0 = PG8_KP(cB, 0, rot0, nt0); const char* sB1 = PG8_KP(cB, 1, rot0, nt0);
    if constexpr (SP2) {
        PG8_STAGEB(PG8_SB(0, 0), sB0, voffB); PG8_STAGEB(PG8_SB(0, 1), sB0 + hstep, voffB); PG8_STAGE(PG8_SA(0, 0), sA0, voffA); PG8_STAGE(PG8_SA(0, 1), sA0 + hstep, voffA);
        if (wr == 1) PG8_BAR;
        PG8_WAIT_V(2); PG8_BAR;
        PG8_STAGEB(PG8_SB(1, 0), sB1, voffB); PG8_STAGE(PG8_SA(1, 0), sA1, voffA); PG8_STAGEB(PG8_SB(1, 1), sB1 + hstep, voffB);
        PG8_WAIT_V(6); PG8_BAR;
    } else {
        PG8_STAGEB(PG8_SB(0, 0), sB0, voffB); PG8_STAGE(PG8_SA(0, 0), sA0, voffA); PG8_STAGEB(PG8_SB(0, 1), sB0 + hstep, voffB); PG8_STAGE(PG8_SA(0, 1), sA0 + hstep, voffA);
        if (wr == 1) PG8_BAR;
        PG8_WAIT_V(4); PG8_BAR;
        PG8_STAGEB(PG8_SB(1, 0), sB1, voffB); PG8_STAGE(PG8_SA(1, 0), sA1, voffA); PG8_STAGEB(PG8_SB(1, 1), sB1 + hstep, voffB);
        PG8_WAIT_V(6); PG8_BAR;
    }
    }
    for (;;) {
        const bool has_next = S.next(ui + 1, nxt);
        const char* nA = has_next ? (const char*)g.A + (size_t)nxt.pm * tstep + (size_t)nxt.kt0 * kstep : cA; const char* nB = has_next ? (const char*)g.Bt + (size_t)nxt.pn * tstep + (size_t)nxt.kt0 * kstep : cB;
        const int nt = cur.nkt, rot = cur.krot;
        const char* nAr = has_next ? nA + (size_t)nxt.krot * kstep : PG8_KP(cA, 0, rot, nt); const char* nBr = has_next ? nB + (size_t)nxt.krot * kstep : PG8_KP(cB, 0, rot, nt);
        for (int t = 0; t < nt; t += 2) {
            const bool last = (t == nt - 2);
            const char* a1 = PG8_KP(cA, t + 1, rot, nt);
            const char* a2 = last ? nAr : PG8_KP(cA, t + 2, rot, nt); const char* b2 = last ? nBr : PG8_KP(cB, t + 2, rot, nt);
            const char* a3 = a2 + kstep; const char* b3 = b2 + kstep;
            if (last && has_next) S.a_ready(nxt);
            if constexpr (SP2) {
            PG8_LDB(B0, 0, 0); PG8_LDB(B1, 0, 1); PG8_SCHED; PG8_LDA(At, 0, 0); PG8_STAGE(PG8_SA(1, 1), a1 + hstep, voffA);
            PG8_WAIT_V(8); PG8_WAIT_L(0); PG8_BAR; PG8_MMA(0, 0, At, B0); PG8_MMA(0, 1, At, B1); PG8_BAR; PG8_SCHED;
            PG8_LDA(At, 0, 1); PG8_STAGEB(PG8_SB(0, 0), b2, voffB); PG8_STAGEB(PG8_SB(0, 1), b2 + hstep, voffB); PG8_STAGE(PG8_SA(0, 0), a2, voffA);
            PG8_WAIT_V(8); PG8_WAIT_L(0); PG8_BAR; PG8_MMA(1, 0, At, B0); PG8_MMA(1, 1, At, B1); PG8_BAR; PG8_SCHED;
            PG8_LDB(B0, 1, 0); PG8_LDB(B1, 1, 1); PG8_SCHED; PG8_LDA(At, 1, 0); PG8_STAGE(PG8_SA(0, 1), a2 + hstep, voffA);
            PG8_WAIT_V(8); PG8_WAIT_L(0); PG8_BAR; PG8_MMA(0, 0, At, B0); PG8_MMA(0, 1, At, B1); PG8_BAR; PG8_SCHED;
            PG8_LDA(At, 1, 1); PG8_STAGEB(PG8_SB(1, 0), b3, voffB); PG8_STAGEB(PG8_SB(1, 1), b3 + hstep, voffB); PG8_STAGE(PG8_SA(1, 0), a3, voffA);
            PG8_WAIT_V(8); PG8_WAIT_L(0); PG8_BAR; PG8_MMA(1, 0, At, B0); PG8_MMA(1, 1, At, B1); PG8_BAR; PG8_SCHED;
            } else {
            PG8_LDB(B0, 0, 0); PG8_SCHED; PG8_LDA(At, 0, 0); PG8_STAGE(PG8_SA(1, 1), a1 + hstep, voffA);
            PG8_WAIT_L(8); PG8_BAR; PG8_WAIT_L(0); PG8_MMA(0, 0, At, B0); PG8_BAR; PG8_SCHED;
            PG8_LDB(B1, 0, 1); PG8_STAGEB(PG8_SB(0, 0), b2, voffB);
            PG8_BAR; PG8_WAIT_L(0); PG8_MMA(0, 1, At, B1); PG8_BAR;
            PG8_LDA(At, 0, 1); PG8_STAGE(PG8_SA(0, 0), a2, voffA);
            PG8_BAR; PG8_WAIT_L(0); PG8_MMA(1, 0, At, B0); PG8_BAR; PG8_SCHED;
            PG8_STAGEB(PG8_SB(0, 1), b2 + hstep, voffB);
            PG8_WAIT_V(6); PG8_BAR; PG8_MMA(1, 1, At, B1); PG8_BAR;
            PG8_LDB(B0, 1, 0); PG8_SCHED; PG8_LDA(At, 1, 0); PG8_STAGE(PG8_SA(0, 1), a2 + hstep, voffA);
            PG8_WAIT_L(8); PG8_BAR; PG8_WAIT_L(0); PG8_MMA(0, 0, At, B0); PG8_BAR; PG8_SCHED;
            PG8_LDB(B1, 1, 1); PG8_STAGEB(PG8_SB(1, 0), b3, voffB);
            PG8_BAR; PG8_WAIT_L(0); PG8_MMA(0, 1, At, B1); PG8_BAR;
            PG8_LDA(At, 1, 1); PG8_STAGE(PG8_SA(1, 0), a3, voffA);
            PG8_BAR; PG8_WAIT_L(0); PG8_MMA(1, 0, At, B0); PG8_BAR; PG8_SCHED;
            PG8_STAGEB(PG8_SB(1, 1), b3 + hstep, voffB);
            PG8_WAIT_V(6); PG8_BAR; PG8_MMA(1, 1, At, B1); PG8_BAR;
            }
        }
        if constexpr (ALIGN_EPI) { if (wr == 0) PG8_BAR; }
#ifndef PROBE_EPI
#define PROBE_EPI 0
#endif
        if constexpr (!Epi::AFTER_DRAIN) { E(acc, cur, wr, wc, fr, fq); if (PROBE_EPI && Epi::IDEMPOTENT) { asm volatile("" ::: "memory"); E(acc, cur, wr, wc, fr, fq); } S.done(cur); }
        if (!has_next) break;
#pragma unroll
        for (int a = 0; a < 2; ++a)
#pragma unroll
            for (int b = 0; b < 2; ++b)
#pragma unroll
                for (int m = 0; m < 4; ++m)
#pragma unroll
                    for (int n = 0; n < 2; ++n) acc[a][b][m][n] = (f32x4){0.f, 0.f, 0.f, 0.f};
        cur = nxt; cA = nA; cB = nB; ++ui;
        if constexpr (ALIGN_EPI) { if (wr == 1) PG8_BAR; }
    }
    PG8_WAIT_V(0);
    if constexpr (!ALIGN_EPI) { if (wr == 0) PG8_BAR; }
    PG8_BAR;
    if constexpr (Epi::AFTER_DRAIN) { E.fused(acc, cur, wr, wc, fr, fq, lds, wid, lane); S.done(cur); }
#undef PG8_KP
#undef PG8_SA
#undef PG8_SB
#undef PG8_STAGE
#undef PG8_STAGEB
#undef PG8_LDA
#undef PG8_LDB
#undef PG8_MMA
#undef PG8_WAIT_V
#undef PG8_WAIT_L
#undef PG8_BAR
#undef PG8_SCHED
}
}

#ifndef PG8_SP2
#define PG8_SP2 true
#endif
#ifndef PG8_ALIGN
#define PG8_ALIGN true
#endif
#ifndef BACKFILL
#define BACKFILL 1
#endif
#ifndef BF_G1_R0
#define BF_G1_R0 0
#define BF_G1_R1 7168
#endif
#ifndef BF_FU_R0
#define BF_FU_R0 16896
#define BF_FU_R1 28160
#endif
#ifndef MK_ONE_LAUNCH
#define MK_ONE_LAUNCH 1
#endif

constexpr int NWAVES = 8;
constexpr int DM = 2048, NTOK = 9216, TPR = 8192, NL = 4, NCB = 20, MODW = 12288, DFF = 5632, NPJ = pg8::NPJ;
constexpr int NPHASE = 2 + 10 * NL;
constexpr size_t O_Y = 0, O_PK = 18874368, O_PV = O_PK + 524288, O_PSR = O_PV + 524288, O_PSI = O_PSR + 65536, O_SK = O_PSI + 65536, O_SV = O_SK + 2097152, O_SSR = O_SV + 2097152, O_SSI = O_SSR + 262144, O_END = O_SSI + 262144;
static_assert(O_END == 24772608, "output map");
constexpr size_t MiB = 1u << 20;
constexpr size_t WS_CTL = 0, CTL_ZERO_BYTES = 64 * 1024;
constexpr size_t WS_MOD = 1 * MiB;
constexpr size_t WS_LAM = 5 * MiB;
constexpr size_t WS_BBAR = 6 * MiB;
constexpr size_t WS_CM = 7 * MiB;
constexpr size_t WS_ROPE = 8 * MiB;
constexpr size_t WS_W1 = 16 * MiB;
constexpr size_t SZ_W1 = (size_t)6656 * 2048 * 2;
constexpr size_t WS_WGLU = WS_W1 + NL * SZ_W1;
constexpr size_t SZ_WGLU = (size_t)1024 * 1024 * 2;
constexpr size_t WS_WPS = WS_WGLU + NL * SZ_WGLU;
constexpr size_t SZ_WP = (size_t)2048 * 1024 * 2;
constexpr size_t WS_WPA = WS_WPS + NL * SZ_WP;
constexpr size_t WS_WOUT = WS_WPA + NL * SZ_WP;
constexpr size_t SZ_WOUT = (size_t)2048 * 2048 * 2;
constexpr size_t WS_WGU = WS_WOUT + NL * SZ_WOUT;
constexpr size_t SZ_WGU = (size_t)11264 * 2048 * 2;
constexpr size_t WS_WDN = WS_WGU + NL * SZ_WGU;
constexpr size_t SZ_WDN = (size_t)2048 * 5632 * 2;
constexpr size_t WS_H = WS_WDN + NL * SZ_WDN;
constexpr size_t WS_P = WS_H + (size_t)NTOK * 2048 * 2;
constexpr size_t WS_QN = WS_P + (size_t)NTOK * NPJ * 2;
constexpr size_t WS_KN = WS_QN + (size_t)NTOK * 1024 * 2;
constexpr size_t WS_Z = WS_KN + (size_t)NTOK * 256 * 2;
constexpr size_t WS_SO = WS_Z + (size_t)NTOK * 1024 * 2;
constexpr size_t WS_AO = WS_SO + (size_t)NTOK * 1024 * 2;
constexpr size_t WS_T1 = WS_AO + (size_t)NTOK * 1024 * 2;
constexpr size_t WS_MX = WS_T1 + (size_t)NTOK * 2048 * 2;
constexpr size_t WS_ACT = WS_MX + (size_t)NTOK * 2048 * 2;
constexpr size_t WS_SL = WS_ACT + (size_t)NTOK * DFF * 2;
constexpr size_t WS_XB = WS_SL + (size_t)8 * 1024 * 2048 * 4;
constexpr size_t WS_END = WS_XB + (size_t)NTOK * 2048 * 2;
static_assert(WS_ROPE + 2112 * 16 * 4 <= WS_W1 && (WS_W1 % 256) == 0 && (WS_H % 256) == 0, "d_ws map");
constexpr int CW_BAR = 4096;

constexpr int RING_OFF = 0, RING_BYTES = 131072;
constexpr int LDSCTL_OFF = RING_BYTES, MISC_OFF = LDSCTL_OFF + 320;
constexpr int LDS_BYTES = 147456;
static_assert(MISC_OFF + 128 <= LDS_BYTES, "LDS map");

#define GAS __attribute__((address_space(1)))
#define LAS __attribute__((address_space(3)))
typedef unsigned short bf16;
typedef unsigned v4u __attribute__((ext_vector_type(4)));
typedef unsigned v2u __attribute__((ext_vector_type(2)));
typedef float f32x4 __attribute__((ext_vector_type(4)));
typedef float f32x2 __attribute__((ext_vector_type(2)));
typedef float f32x16 __attribute__((ext_vector_type(16)));
typedef short bf16x8 __attribute__((ext_vector_type(8)));
typedef GAS unsigned gu32;
#define RLX_AGENT __ATOMIC_RELAXED, __HIP_MEMORY_SCOPE_AGENT
#define LDS_WAIT() asm volatile("s_waitcnt lgkmcnt(0)" ::: "memory")
#define VM_WAIT() asm volatile("s_waitcnt vmcnt(0)" ::: "memory")
using pg8::cvt_pk_bf16; using pg8::bflo; using pg8::bfhi;
__device__ __forceinline__ unsigned f2bf(float f) { unsigned u = __builtin_bit_cast(unsigned, f); return (u + 0x7fffu + ((u >> 16) & 1u)) >> 16; }
__device__ __forceinline__ float bf2f(unsigned short b) { return __uint_as_float((unsigned)b << 16); }
__device__ __forceinline__ float wave_sum(float v) {
#pragma unroll
    for (int o = 1; o < 64; o <<= 1) v += __shfl_xor(v, o);
    return v;
}
#define XB_TMO      128
#define XB_XCNT(j)  (256  + 64 * (j))
#define XB_XSUB(j)  (1280 + 64 * (j))
#define XB_XGEN(j)  (2304 + 64 * (j))
#define XB_TOP      3328
#define XB_TOPGEN   3392
#define XCD_BAR_WORDS 3456
#define XB_SPIN_CAP (1u << 18)

__device__ __forceinline__ unsigned xb_ld(unsigned* p)              { return __hip_atomic_load(p, __ATOMIC_RELAXED, __HIP_MEMORY_SCOPE_AGENT); }
__device__ __forceinline__ unsigned xb_add(unsigned* p, unsigned v) { return __hip_atomic_fetch_add(p, v, __ATOMIC_RELAXED, __HIP_MEMORY_SCOPE_AGENT); }
__device__ __forceinline__ unsigned xb_xcc_id() { return (unsigned)__builtin_amdgcn_s_getreg((3 << 11) | 20) & 0xFu; }
#define XB_SPIN(cond, bar) do { unsigned _sp = 0; while (cond) { __builtin_amdgcn_s_sleep(1); \
    if ((++_sp & 255u) == 0u) { if (xb_ld(&(bar)[XB_TMO])) break; if (_sp > XB_SPIN_CAP) { atomicAdd(&(bar)[XB_TMO], 1u); break; } } } } while (0)

struct XcdBarrier {
    unsigned* bar; unsigned x;
    volatile LAS unsigned* st;
};

__device__ __forceinline__ XcdBarrier xcd_barrier_post(unsigned* bar, volatile LAS unsigned* st) {
    XcdBarrier b; b.bar = bar; b.x = xb_xcc_id(); b.st = st;
    if (threadIdx.x == 0) (void)xb_add(&bar[XB_XCNT(b.x)], 1u);
    return b;
}
__device__ __forceinline__ void xcd_barrier_complete(unsigned* bar, unsigned x, unsigned& nloc, unsigned& nx) {
    const unsigned G = gridDim.x * gridDim.y * gridDim.z;
    unsigned sum, cnt, mine, sp = 0u;
    for (;;) {
        sum = 0u; cnt = 0u; mine = 0u;
#pragma unroll
        for (unsigned j = 0; j < 16; ++j) { const unsigned c = xb_ld(&bar[XB_XCNT(j)]); sum += c; cnt += (c > 0u) ? 1u : 0u; mine = (j == x) ? c : mine; }
        if (sum == G) break;
        __builtin_amdgcn_s_sleep(1);
        if ((++sp & 255u) == 0u) { if (xb_ld(&bar[XB_TMO])) break; if (sp > XB_SPIN_CAP) { atomicAdd(&bar[XB_TMO], 1u); break; } }
    }
    nloc = mine > 0u ? mine : 1u; nx = cnt > 0u ? cnt : 1u;
}

__device__ __forceinline__ void xcd_barrier(const XcdBarrier& b) {
    asm volatile("s_waitcnt vmcnt(0)" ::: "memory");
    __syncthreads();
    if (threadIdx.x == 0) {
        unsigned* bar = b.bar;
        __builtin_amdgcn_s_waitcnt(0);
        unsigned nloc = b.st[0], nx = b.st[1];
        if (nloc == 0u) { xcd_barrier_complete(bar, b.x, nloc, nx); b.st[0] = nloc; b.st[1] = nx; }
        const unsigned old = xb_add(&bar[XB_XSUB(b.x)], 1u);
        const unsigned gen = old / nloc;
        if (old + 1u == (gen + 1u) * nloc) {
            __builtin_amdgcn_fence(__ATOMIC_RELEASE, "agent");
            asm volatile("s_waitcnt vmcnt(0)" ::: "memory");
            const unsigned og = xb_add(&bar[XB_TOP], 1u);
            const unsigned tg = og / nx;
            if (og + 1u == (tg + 1u) * nx) xb_add(&bar[XB_TOPGEN], 1u);
            else XB_SPIN(xb_ld(&bar[XB_TOPGEN]) == tg, bar);
            __builtin_amdgcn_fence(__ATOMIC_ACQUIRE, "agent");
            xb_add(&bar[XB_XGEN(b.x)], 1u);
            asm volatile("s_waitcnt vmcnt(0)" ::: "memory");
        } else {
            XB_SPIN(xb_ld(&bar[XB_XGEN(b.x)]) == gen, bar);
            __builtin_amdgcn_fence(__ATOMIC_ACQUIRE, "agent");
            asm volatile("s_waitcnt vmcnt(0)" ::: "memory");
        }
    }
    __syncthreads();
}

#ifndef NT_STREAM
#define NT_STREAM 1
#endif
__device__ __forceinline__ unsigned pk2(float lo, float hi) { return cvt_pk_bf16(lo, hi); }
struct ConvDesc { const float* src; bf16* dst; int N, K; };
__device__ __forceinline__ void conv_load(const ConvDesc& d, f32x4 (&v)[8]) {
#pragma unroll
    for (int i = 0; i < 8; ++i) v[i] = NT_STREAM ? __builtin_nontemporal_load((const GAS f32x4*)(d.src + (size_t)(8 * i) * d.N)) : *(const GAS f32x4*)(d.src + (size_t)(8 * i) * d.N);
}
__device__ __forceinline__ void conv_store(const ConvDesc& d, const f32x4 (&v)[8], LAS float* scr, int lane) {
    { const int kr = lane >> 3, n4 = lane & 7;
#pragma unroll
      for (int i = 0; i < 8; ++i) { LAS float* p = scr + (8 * i + kr) * 33 + 4 * n4; p[0] = v[i].x; p[1] = v[i].y; p[2] = v[i].z; p[3] = v[i].w; } }
    LDS_WAIT(); asm volatile("" ::: "memory");
    const int c = lane & 7;
#pragma unroll
    for (int j = 0; j < 4; ++j) { const int n = (lane >> 3) + 8 * j; const LAS float* s = scr + (8 * c) * 33 + n;
        v4u o; o.x = pk2(s[0 * 33], s[1 * 33]); o.y = pk2(s[2 * 33], s[3 * 33]); o.z = pk2(s[4 * 33], s[5 * 33]); o.w = pk2(s[6 * 33], s[7 * 33]);
        if (NT_STREAM) __builtin_nontemporal_store(o, (GAS v4u*)(d.dst + (size_t)n * d.K + 8 * c)); else *(GAS v4u*)(d.dst + (size_t)n * d.K + 8 * c) = o; }
    LDS_WAIT(); asm volatile("" ::: "memory");
}
__device__ __forceinline__ void sincos_d(double x, double& s, double& c) {
    const double k = rint(x * 0.63661977236758134308);
    double y = fma(-k, 1.57079632679489655800e+00, x); y = fma(-k, 6.12323399573676603587e-17, y);
    const double y2 = y * y;
    const double sp = y * (1.0 + y2 * (-1.0 / 6.0 + y2 * (1.0 / 120.0 + y2 * (-1.0 / 5040.0 + y2 * (1.0 / 362880.0 + y2 * (-1.0 / 39916800.0 + y2 * (1.0 / 6227020800.0)))))));
    const double cp = 1.0 + y2 * (-0.5 + y2 * (1.0 / 24.0 + y2 * (-1.0 / 720.0 + y2 * (1.0 / 40320.0 + y2 * (-1.0 / 3628800.0 + y2 * (1.0 / 479001600.0 + y2 * (-1.0 / 87178291200.0)))))));
    const int qd = ((int)k) & 3;
    s = (qd == 0) ? sp : (qd == 1) ? cp : (qd == 2) ? -sp : -cp;
    c = (qd == 0) ? cp : (qd == 1) ? -sp : (qd == 2) ? -cp : sp;
}
__device__ __forceinline__ int crow(int r, int hi) { return (r & 3) + 8 * (r >> 2) + 4 * hi; }
__device__ __forceinline__ bf16x8 mk_bf16x8(unsigned a, unsigned b, unsigned c, unsigned d) { v4u w; w.x = a; w.y = b; w.z = c; w.w = d; return __builtin_bit_cast(bf16x8, w); }

struct Args { const float* in[34]; float* out; unsigned char* ws; int ph_lo, ph_hi; };

__device__ __forceinline__ void p0_mod(LAS unsigned char* lds, int tid, int wid, int lane, int t_first, int t_end, int t_stride, const float* cp, const float* cs, const float* wmod, const float* bmod, float* MOD) {
    LAS float* red = (LAS float*)lds;
    const int q = lane & 31, hi = lane >> 5;
    LAS float* scr = (LAS float*)(lds + 32768 + wid * 8448);
    const int kr = lane >> 3, n4 = lane & 7;
    for (int task = t_first; task < t_end; task += t_stride) {
        const int l = task / 384, nb = task % 384;
        const float* wt = wmod + (size_t)l * 2048 * MODW + 32 * nb + 4 * n4;
        const float* csrc = q < 4 ? cp + q * 2048 : cs + (q < 20 ? (q - 4) : 0) * 2048;
        f32x16 acc;
#pragma unroll
        for (int r = 0; r < 16; ++r) acc[r] = 0.f;
        f32x4 vn[8];
#pragma unroll
        for (int i = 0; i < 8; ++i) vn[i] = __builtin_nontemporal_load((const f32x4*)(wt + (size_t)(256 * wid + 8 * i + kr) * MODW));
#pragma unroll 1
        for (int tt = 0; tt < 4; ++tt) {
            f32x4 vc[8];
#pragma unroll
            for (int i = 0; i < 8; ++i) vc[i] = vn[i];
            if (tt < 3) {
#pragma unroll
                for (int i = 0; i < 8; ++i) vn[i] = __builtin_nontemporal_load((const f32x4*)(wt + (size_t)(256 * wid + 64 * (tt + 1) + 8 * i + kr) * MODW)); }
#pragma unroll
            for (int i = 0; i < 8; ++i) { LAS float* p = scr + (8 * i + kr) * 33 + 4 * n4; p[0] = vc[i].x; p[1] = vc[i].y; p[2] = vc[i].z; p[3] = vc[i].w; }
            LDS_WAIT(); asm volatile("" ::: "memory");
#pragma unroll
            for (int ks = 0; ks < 4; ++ks) {
                const int k0 = 256 * wid + 64 * tt + 16 * ks + 8 * hi;
                f32x4 a0 = *(const f32x4*)(csrc + k0), a1 = *(const f32x4*)(csrc + k0 + 4);
                if (q >= 20) { a0 = (f32x4){0.f, 0.f, 0.f, 0.f}; a1 = a0; }
                float b[8];
#pragma unroll
                for (int jj = 0; jj < 8; ++jj) b[jj] = scr[(16 * ks + 8 * hi + jj) * 33 + q];
                const unsigned ah0 = cvt_pk_bf16(a0[0], a0[1]), ah1 = cvt_pk_bf16(a0[2], a0[3]), ah2 = cvt_pk_bf16(a1[0], a1[1]), ah3 = cvt_pk_bf16(a1[2], a1[3]);
                const unsigned al0 = cvt_pk_bf16(a0[0] - bflo(ah0), a0[1] - bfhi(ah0)), al1 = cvt_pk_bf16(a0[2] - bflo(ah1), a0[3] - bfhi(ah1)), al2 = cvt_pk_bf16(a1[0] - bflo(ah2), a1[1] - bfhi(ah2)), al3 = cvt_pk_bf16(a1[2] - bflo(ah3), a1[3] - bfhi(ah3));
                const unsigned bh0 = cvt_pk_bf16(b[0], b[1]), bh1 = cvt_pk_bf16(b[2], b[3]), bh2 = cvt_pk_bf16(b[4], b[5]), bh3 = cvt_pk_bf16(b[6], b[7]);
                const unsigned bl0 = cvt_pk_bf16(b[0] - bflo(bh0), b[1] - bfhi(bh0)), bl1 = cvt_pk_bf16(b[2] - bflo(bh1), b[3] - bfhi(bh1)), bl2 = cvt_pk_bf16(b[4] - bflo(bh2), b[5] - bfhi(bh2)), bl3 = cvt_pk_bf16(b[6] - bflo(bh3), b[7] - bfhi(bh3));
                const bf16x8 ah = mk_bf16x8(ah0, ah1, ah2, ah3), al = mk_bf16x8(al0, al1, al2, al3), bh = mk_bf16x8(bh0, bh1, bh2, bh3), bl = mk_bf16x8(bl0, bl1, bl2, bl3);
                acc = __builtin_amdgcn_mfma_f32_32x32x16_bf16(ah, bh, acc, 0, 0, 0);
                acc = __builtin_amdgcn_mfma_f32_32x32x16_bf16(ah, bl, acc, 0, 0, 0);
                acc = __builtin_amdgcn_mfma_f32_32x32x16_bf16(al, bh, acc, 0, 0, 0);
            }
            LDS_WAIT(); asm volatile("" ::: "memory");
        }
#pragma unroll
        for (int r = 0; r < 16; ++r) red[(wid * 32 + crow(r, hi)) * 32 + q] = acc[r];
        __syncthreads();
        for (int o = tid; o < 640; o += 512) { const int cb = o >> 5, n = o & 31; float s = bmod[l * MODW + 32 * nb + n];
#pragma unroll
            for (int w8 = 0; w8 < 8; ++w8) s += red[(w8 * 32 + cb) * 32 + n];
            ((GAS float*)MOD)[((size_t)l * NCB + cb) * MODW + 32 * nb + n] = s; }
        __syncthreads();
    }
}

constexpr int CONV_PER_L = 28160;
__device__ __forceinline__ ConvDesc conv_desc(const Args& A, unsigned char* ws, int l, int it, int lane) {
    int r = it;
    const float* W; int K, N; bf16* WT; int mode = 0;
    int rb0 = 0;
    if (r < 2560) { W = A.in[12] + (size_t)l * 2048 * 2560; K = 2048; N = 2560; WT = (bf16*)(ws + WS_W1 + l * SZ_W1); mode = 3; }
    else if ((r -= 2560) < 4096) { W = A.in[26] + (size_t)l * 2048 * 4096; K = 2048; N = 4096; WT = (bf16*)(ws + WS_W1 + l * SZ_W1); rb0 = 2560; }
    else if ((r -= 4096) < 512) { W = A.in[21] + (size_t)l * 1024 * 1024; K = 1024; N = 1024; WT = (bf16*)(ws + WS_WGLU + l * SZ_WGLU); }
    else if ((r -= 512) < 1024) { W = A.in[28] + (size_t)l * 1024 * 2048; K = 1024; N = 2048; WT = (bf16*)(ws + WS_WPS + l * SZ_WP); }
    else if ((r -= 1024) < 1024) { W = A.in[29] + (size_t)l * 1024 * 2048; K = 1024; N = 2048; WT = (bf16*)(ws + WS_WPA + l * SZ_WP); }
    else if ((r -= 1024) < 2048) { W = A.in[30] + (size_t)l * 2048 * 2048; K = 2048; N = 2048; WT = (bf16*)(ws + WS_WOUT + l * SZ_WOUT); }
    else if ((r -= 2048) < 5632) { W = A.in[31] + (size_t)l * 2048 * 5632; K = 2048; N = 5632; WT = (bf16*)(ws + WS_WGU + l * SZ_WGU); mode = 1; }
    else if ((r -= 5632) < 5632) { W = A.in[32] + (size_t)l * 2048 * 5632; K = 2048; N = 5632; WT = (bf16*)(ws + WS_WGU + l * SZ_WGU); mode = 2; }
    else { r -= 5632; W = A.in[33] + (size_t)l * 5632 * 2048; K = 5632; N = 2048; WT = (bf16*)(ws + WS_WDN + l * SZ_WDN); }
    const int nblk = N / 32, kb = r / nblk, nb = r % nblk, k0 = 64 * kb, n0 = 32 * nb;
    const int rowbase = mode == 0 ? rb0 + n0 : mode == 3 ? ((n0 >= 1024 && n0 < 2304) ? (n0 & ~255) + 128 * ((n0 >> 5) & 1) + 32 * ((n0 >> 6) & 3) : n0)
                                  : 256 * (n0 >> 7) + (n0 & 127) + (mode == 2 ? 128 : 0);
    ConvDesc d; d.src = W + (size_t)(k0 + (lane >> 3)) * N + n0 + 4 * (lane & 7); d.dst = WT + (size_t)rowbase * K + k0; d.N = N; d.K = K; return d;
}
__device__ __forceinline__ void conv_items(const Args& A, unsigned char* ws, LAS unsigned char* lds, int wid, int lane, int l, int r0, int r1, int pw, int npw) {
    LAS float* scr = (LAS float*)(lds + RING_OFF + wid * 16384);
    int it = r0 + pw; if (it >= r1) return;
    ConvDesc dn = conv_desc(A, ws, l, it, lane); f32x4 vn[8]; conv_load(dn, vn);
    for (;;) {
        const ConvDesc dc = dn; f32x4 vc[8];
#pragma unroll
        for (int i = 0; i < 8; ++i) vc[i] = vn[i];
        it += npw; const bool more = it < r1;
        if (more) { dn = conv_desc(A, ws, l, it, lane); conv_load(dn, vn); }
        conv_store(dc, vc, scr, lane);
        if (!more) break;
    }
}
__device__ __forceinline__ void backfill(const Args& A, unsigned char* ws, LAS unsigned char* lds, int tid, int wid, int lane, int G, int bx, int c0, int lm, int t0, int t1, int lc, int r0, int r1) {
    if (!BACKFILL) return;
    if (c0 >= G) c0 = 0;
    if (bx < c0) return;
    const int pc = bx - c0, npc = G - c0;
    if (lm < NL) p0_mod(lds, tid, wid, lane, lm * 384 + t0 + pc, lm * 384 + t1, npc, A.in[6], A.in[7], A.in[8], A.in[9], (float*)(ws + WS_MOD));
    if (lc < NL) conv_items(A, ws, lds, wid, lane, lc, r0, r1, pc * NWAVES + wid, npc * NWAVES);
    __syncthreads();
}
__device__ __forceinline__ void p0_prologue(const Args& A, LAS unsigned char* lds, int tid, int wid, int lane, int G, int bx) {
    unsigned char* ws = A.ws;
    const int gw = bx * NWAVES + wid, NGW = G * NWAVES;
    { const int N4 = NL * 16 * 64 * 256 / 4;
      for (int i = bx * 512 + tid; i < 2 * N4; i += G * 512) { const int kv = i >= N4, j = kv ? i - N4 : i; const int lb = j / 4096, w = j % 4096;
          const f32x4 v = *((const f32x4*)A.in[2 + kv] + (size_t)lb * 8192 + 4096 + w); *((f32x4*)(A.out + (kv ? O_SV : O_SK)) + (size_t)lb * 8192 + w) = v; } }
    { float* LAM = (float*)(ws + WS_LAM); bf16* BB = (bf16*)(ws + WS_BBAR); bf16* CM = (bf16*)(ws + WS_CM);
      for (int idx = bx * 512 + tid; idx < NL * 4096; idx += G * 512) {
          const int lg = idx >> 6, p = idx & 63;
          const double dt = exp((double)A.in[15][lg]);
          const double are = (double)A.in[13][idx], aim = (double)A.in[14][idx];
          const double zre = are * dt, zim = aim * dt, mag = exp(zre);
          double s, c; sincos_d(zim, s, c);
          const double lre = mag * c, lim = mag * s;
          const double mag64 = exp(64.0 * zre); double s64, c64; sincos_d(64.0 * zim, s64, c64);
          *(f32x4*)(LAM + (size_t)idx * 4) = (f32x4){(float)lre, (float)lim, (float)(mag64 * c64), (float)(mag64 * s64)};
          const double den = are * are + aim * aim, nre = lre - 1.0;
          const double fre = (nre * are + lim * aim) / den, fim = (lim * are - nre * aim) / den;
          const float* bre = A.in[16] + (size_t)idx * 16; const float* bim = A.in[17] + (size_t)idx * 16;
          bf16* b0 = BB + ((size_t)lg * 128 + 2 * p) * 16;
#pragma unroll
          for (int ch = 0; ch < 16; ++ch) { const double br = (double)bre[ch], bi = (double)bim[ch];
              b0[ch] = (bf16)f2bf((float)(fre * br - fim * bi)); b0[16 + ch] = (bf16)f2bf((float)(fre * bi + fim * br)); }
#pragma unroll
          for (int ch = 0; ch < 16; ++ch) { const size_t ci = ((size_t)lg * 16 + ch) * 64 + p; bf16* cd = CM + ((size_t)lg * 16 + ch) * 128 + 2 * p;
              cd[0] = (bf16)f2bf(A.in[18][ci]); cd[1] = (bf16)f2bf(-A.in[19][ci]); }
      } }
    { float* RT = (float*)(ws + WS_ROPE);
      for (int e = bx * 512 + tid; e < 2112 * 8; e += G * 512) { const int pos = e >> 3, i = e & 7;
          const double inv = exp(-((double)i / 8.0) * 13.122363377404328  ); double s, c; sincos_d((double)pos * inv, s, c);
          RT[pos * 16 + i] = (float)c; RT[pos * 16 + 8 + i] = (float)s; } }
    p0_mod(lds, tid, wid, lane, bx, (BACKFILL ? 1 : NL) * 384, G, A.in[6], A.in[7], A.in[8], A.in[9], (float*)(ws + WS_MOD));
    if (BACKFILL) { conv_items(A, ws, lds, wid, lane, 0, 0, 6656, gw, NGW); conv_items(A, ws, lds, wid, lane, 0, 11264, 15360, gw, NGW); }
    else for (int l = 0; l < NL; ++l) conv_items(A, ws, lds, wid, lane, l, 0, CONV_PER_L, gw, NGW);
}

__device__ __forceinline__ void norm_row(int row, int lane, bf16* XB, const float* xin_p, const float* xin_s, const bf16* SL, const float* gn, const float* modl, int sh_off, int sc_off, bf16* H) {
    const int cb = row < TPR ? (row >> 11) : 4 + ((row - TPR) >> 6);
    GAS v4u* xr = (GAS v4u*)(XB + (size_t)row * DM) + lane;
    f32x4 v[8]; float s = 0.f;
    bool wb = false;
    if (xin_p != nullptr) {
        const GAS f32x4* xi = (const GAS f32x4*)(row < TPR ? xin_p + (size_t)row * DM : xin_s + (size_t)(row - TPR) * DM) + 2 * lane;
#pragma unroll
        for (int j = 0; j < 4; ++j) { v[2 * j] = xi[128 * j]; v[2 * j + 1] = xi[128 * j + 1]; }
        wb = true;
    } else {
#pragma unroll
        for (int j = 0; j < 4; ++j) pg8::unpack8(xr[64 * j], v[2 * j], v[2 * j + 1]);
    }
    if (SL != nullptr && row >= TPR) {
        const GAS v4u* sp = (const GAS v4u*)(SL + (size_t)(row - TPR) * DM) + lane;
        v4u sr[8][4];
#pragma unroll
        for (int sl = 0; sl < 8; ++sl)
#pragma unroll
            for (int j = 0; j < 4; ++j) sr[sl][j] = sp[(size_t)sl * (1024 * DM / 8) + 64 * j];
#pragma unroll
        for (int sl = 0; sl < 8; ++sl)
#pragma unroll
            for (int j = 0; j < 4; ++j) { f32x4 a0, a1; pg8::unpack8(sr[sl][j], a0, a1); v[2 * j] = v[2 * j] + a0; v[2 * j + 1] = v[2 * j + 1] + a1; }
        wb = true;
    }
    if (wb) {
#pragma unroll
        for (int j = 0; j < 4; ++j) { const v4u w = pg8::pack8(v[2 * j], v[2 * j + 1]); xr[64 * j] = w; pg8::unpack8(w, v[2 * j], v[2 * j + 1]); }
    }
#pragma unroll
    for (int j = 0; j < 8; ++j) s += (v[j].x * v[j].x + v[j].y * v[j].y) + (v[j].z * v[j].z + v[j].w * v[j].w);
    const float rstd = 1.0f / sqrtf(wave_sum(s) * (1.0f / DM) + 1e-6f);
    const float* mrow = modl + (size_t)cb * MODW;
    GAS v4u* o16 = (GAS v4u*)(H + (size_t)row * DM) + lane;
#pragma unroll
    for (int j = 0; j < 4; ++j) { const int col = 8 * lane + 512 * j; f32x4 o[2];
#pragma unroll
        for (int h2 = 0; h2 < 2; ++h2) { const f32x4 g = *(const GAS f32x4*)(gn + col + 4 * h2), sc = *(const GAS f32x4*)(mrow + sc_off + col + 4 * h2), sh = *(const GAS f32x4*)(mrow + sh_off + col + 4 * h2);
            o[h2] = v[2 * j + h2] * rstd * g * (1.0f + sc) + sh; }
        o16[64 * j] = pg8::pack8(o[0], o[1]); }
}
__device__ __forceinline__ void norm_phase(int gw, int NGW, int lane, bf16* XB, const float* xin_p, const float* xin_s, const bf16* SL, const float* gn, const float* modl, int sh_off, int sc_off, bf16* H) {
    const bool xcd_deal = (NGW == 2048);
    const int bxw = gw >> 3, widw = gw & 7, xq = bxw & 7, jq = bxw >> 3;
    if (xcd_deal && xin_p == nullptr) {
        const int row0 = 1024 * xq + 32 * jq + 4 * widw, cb = row0 >> 11;
        v4u raw[4][4];
#pragma unroll
        for (int ri = 0; ri < 4; ++ri)
#pragma unroll
            for (int j = 0; j < 4; ++j) raw[ri][j] = ((const GAS v4u*)(XB + (size_t)(row0 + ri) * DM) + lane)[64 * j];
        const float* mrow = modl + (size_t)cb * MODW;
        f32x4 Am[8], Sh[8];
#pragma unroll
        for (int j = 0; j < 4; ++j)
#pragma unroll
            for (int h2 = 0; h2 < 2; ++h2) { const int col = 8 * lane + 512 * j + 4 * h2; const f32x4 g = *(const GAS f32x4*)(gn + col), sc = *(const GAS f32x4*)(mrow + sc_off + col); Sh[2 * j + h2] = *(const GAS f32x4*)(mrow + sh_off + col);
                Am[2 * j + h2] = g * (1.0f + sc); }
#pragma unroll
        for (int ri = 0; ri < 4; ++ri) {
            f32x4 v[8]; float s = 0.f;
#pragma unroll
            for (int j = 0; j < 4; ++j) pg8::unpack8(raw[ri][j], v[2 * j], v[2 * j + 1]);
#pragma unroll
            for (int j = 0; j < 8; ++j) s += (v[j].x * v[j].x + v[j].y * v[j].y) + (v[j].z * v[j].z + v[j].w * v[j].w);
            const float rstd = 1.0f / sqrtf(wave_sum(s) * (1.0f / DM) + 1e-6f);
            GAS v4u* o16 = (GAS v4u*)(H + (size_t)(row0 + ri) * DM) + lane;
#pragma unroll
            for (int j = 0; j < 4; ++j) o16[64 * j] = pg8::pack8(v[2 * j] * rstd * Am[2 * j] + Sh[2 * j], v[2 * j + 1] * rstd * Am[2 * j + 1] + Sh[2 * j + 1]);
        }
        if (widw < 4) norm_row(TPR + 4 * bxw + widw, lane, XB, xin_p, xin_s, SL, gn, modl, sh_off, sc_off, H);
        return;
    }
    const int nrows = xcd_deal ? (widw < 4 ? 5 : 4) : (NTOK - gw + NGW - 1) / NGW;
    for (int ri = 0; ri < nrows; ++ri) {
        const int row = xcd_deal ? (ri < 4 ? 1024 * xq + 32 * jq + 4 * widw + ri : TPR + 4 * bxw + widw) : gw + ri * NGW;
        norm_row(row, lane, XB, xin_p, xin_s, SL, gn, modl, sh_off, sc_off, H);
    }
}
__device__ __forceinline__ void final_phase(int gw, int NGW, int lane, float* X, const bf16* XB, const bf16* SL) {
    for (int row = TPR + gw; row < NTOK; row += NGW) {
        GAS f32x4* xo = (GAS f32x4*)(X + (size_t)row * DM) + 2 * lane; const GAS v4u* xr = (const GAS v4u*)(XB + (size_t)row * DM) + lane; const GAS v4u* sp = (const GAS v4u*)(SL + (size_t)(row - TPR) * DM) + lane;
        f32x4 v[8];
#pragma unroll
        for (int j = 0; j < 4; ++j) pg8::unpack8(xr[64 * j], v[2 * j], v[2 * j + 1]);
        v4u sr[8][4];
#pragma unroll
        for (int sl = 0; sl < 8; ++sl)
#pragma unroll
            for (int j = 0; j < 4; ++j) sr[sl][j] = sp[(size_t)sl * (1024 * DM / 8) + 64 * j];
#pragma unroll
        for (int sl = 0; sl < 8; ++sl)
#pragma unroll
            for (int j = 0; j < 4; ++j) { f32x4 a0, a1; pg8::unpack8(sr[sl][j], a0, a1); v[2 * j] = v[2 * j] + a0; v[2 * j + 1] = v[2 * j + 1] + a1; }
#pragma unroll
        for (int j = 0; j < 4; ++j) { xo[128 * j] = v[2 * j]; xo[128 * j + 1] = v[2 * j + 1]; }
    }
}

constexpr int SSM_ROWB = 528;
constexpr int SSM_WSCR = 16 * SSM_ROWB;
template <bool FULL>
__device__ __forceinline__ void ssm_subblock(LAS unsigned char* sb, int lane, bf16x8 uf, const bf16x8 (&af)[8], const bf16x8 (&cf)[4], float lre, float lim, float& hre, float& him,
                                             f32x4 dsk, v2u uraw, bf16* zdst, bool dost = true) {
    const int tok = lane & 15, q = lane >> 4;
#pragma unroll
    for (int nt = 0; nt < 8; ++nt) { const f32x4 d = __builtin_amdgcn_mfma_f32_16x16x32_bf16(af[nt], uf, (f32x4){0.f, 0.f, 0.f, 0.f}, 0, 0, 0);
        *(LAS f32x4*)(sb + tok * SSM_ROWB + nt * 64 + q * 16) = d; }
    f32x2 bu[16]; unsigned hp[16];
#pragma unroll
    for (int t = 0; t < 16; ++t) bu[t] = *(const LAS f32x2*)(sb + t * SSM_ROWB + 8 * lane);
    f32x2 hv = (f32x2){hre, him}; const f32x2 Lp = (f32x2){lre, lim};
#pragma unroll
    for (int t = 0; t < 16; ++t) {
        f32x2 tt;
        asm("v_pk_fma_f32 %0, %1, %2, %3 op_sel:[1,1,0] op_sel_hi:[1,0,1] neg_lo:[1,0,0]" : "=v"(tt) : "v"(Lp), "v"(hv), "v"(bu[t]));
        asm("v_pk_fma_f32 %0, %1, %2, %3 op_sel:[0,0,0] op_sel_hi:[0,1,1]" : "=v"(hv) : "v"(Lp), "v"(hv), "v"(tt));
        if (FULL) hp[t] = cvt_pk_bf16(hv.x, hv.y); }
    hre = hv.x; him = hv.y;
    if (FULL) {
#pragma unroll
        for (int t = 0; t < 16; ++t) *(LAS unsigned*)(sb + t * SSM_ROWB + 4 * lane) = hp[t]; }
    if (FULL) {
        f32x4 y = (f32x4){0.f, 0.f, 0.f, 0.f};
#pragma unroll
        for (int ks = 0; ks < 4; ++ks) { const bf16x8 hf = *(const LAS bf16x8*)(sb + tok * SSM_ROWB + ks * 64 + q * 16); y = __builtin_amdgcn_mfma_f32_16x16x32_bf16(cf[ks], hf, y, 0, 0, 0); }
        const f32x4 uv = (f32x4){bflo(uraw.x), bfhi(uraw.x), bflo(uraw.y), bfhi(uraw.y)};
        y = y + dsk * uv;
        f32x4 z;
#pragma unroll
        for (int i = 0; i < 4; i += 2) {
            const f32x2 v = (f32x2){y[i], y[i + 1]};
            const f32x2 k2 = (v * v * 0.044715f + 1.0f) * v * (-1.5957691216057308f * 1.4426950408889634f);
            f32x2 e; e.x = __builtin_amdgcn_exp2f(k2.x); e.y = __builtin_amdgcn_exp2f(k2.y);
            const f32x2 d = e + 1.0f; f32x2 r; r.x = __builtin_amdgcn_rcpf(d.x); r.y = __builtin_amdgcn_rcpf(d.y);
            const f32x2 zz = v * r; z[i] = zz.x; z[i + 1] = zz.y; }
        v2u w; w.x = cvt_pk_bf16(z[0], z[1]); w.y = cvt_pk_bf16(z[2], z[3]); if (dost) *(GAS v2u*)zdst = w;
    }
}
template <bool FULL>
__device__ __forceinline__ void ssm_chunk(LAS unsigned char* sb, int lane, const bf16x8 (&uc)[4], const v2u (&ur)[4], const bf16x8 (&af)[8], const bf16x8 (&cf)[4], float lre, float lim, float& hre, float& him,
                                          f32x4 dsk, bf16* Z, size_t row0, int g, bool dost = true) {
    const int tok = lane & 15, q = lane >> 4;
#pragma unroll
    for (int s = 0; s < 4; ++s) ssm_subblock<FULL>(sb, lane, uc[s], af, cf, lre, lim, hre, him, dsk, ur[s], Z + (row0 + 16 * s + tok) * 1024 + 16 * g + 4 * q, dost);
}
__device__ __forceinline__ void ssm_load_u(const bf16* P, size_t row0, int g, int lane, bf16x8 (&u)[4], v2u (&ur)[4], bool full) {
    const int tok = lane & 15, q = lane >> 4;
#pragma unroll
    for (int s = 0; s < 4; ++s) { const bf16* rp = P + (row0 + 16 * s + tok) * NPJ + 16 * g;
        u[s] = q < 2 ? *(const GAS bf16x8*)(rp + 8 * q) : mk_bf16x8(0u, 0u, 0u, 0u);
        ur[s] = full ? *(const GAS v2u*)(rp + 4 * q) : (v2u){0u, 0u}; }
}
__device__ __forceinline__ void ssm_phase(LAS unsigned char* lds, int tid, int wid, int lane, int G, int bx, int l, const Args& A, const bf16* P, bf16* Z) {
    LAS unsigned char* sb = lds + wid * SSM_WSCR;
    LAS f32x2* Sloc = (LAS f32x2*)(lds + 8 * SSM_WSCR);
    const unsigned char* ws = A.ws;
    const int i16 = lane & 15, kb = lane >> 4;
    const int vcu = (G == 256) ? ((bx & 7) >> 1) * 64 + (bx & 1) * 32 + (bx >> 3) : bx;
    for (int unit = vcu; unit < 256; unit += G) {
        const int b = unit >> 6, g = unit & 63, lg = l * 64 + g;
        bf16x8 af[8], cf[4];
        { const bf16* BB = (const bf16*)(ws + WS_BBAR) + (size_t)lg * 128 * 16; const bf16* CM = (const bf16*)(ws + WS_CM) + (size_t)lg * 16 * 128;
#pragma unroll
          for (int nt = 0; nt < 8; ++nt) af[nt] = kb < 2 ? *(const bf16x8*)(BB + (16 * nt + i16) * 16 + 8 * kb) : mk_bf16x8(0u, 0u, 0u, 0u);
#pragma unroll
          for (int ks = 0; ks < 4; ++ks) cf[ks] = *(const bf16x8*)(CM + i16 * 128 + 32 * ks + 8 * kb); }
        const f32x4 lam = *(const f32x4*)((const float*)(ws + WS_LAM) + ((size_t)lg * 64 + lane) * 4);
        const f32x4 dsk = *(const f32x4*)(A.in[20] + (size_t)l * 1024 + 16 * g + 4 * kb);
        const size_t rowb = (size_t)b * 2048 + (size_t)wid * 256;
#ifndef PROBE_SSM
#define PROBE_SSM 0
#endif
        for (int rp1 = 0; rp1 < (PROBE_SSM == 3 ? 2 : 1); ++rp1)
        { bf16x8 un[4]; v2u rn[4]; ssm_load_u(P, rowb, g, lane, un, rn, false);
#pragma unroll 1
          for (int ci = 0; ci < 4; ++ci) { bf16x8 uc[4]; v2u rc[4];
#pragma unroll
              for (int s = 0; s < 4; ++s) { uc[s] = un[s]; rc[s] = rn[s]; }
              if (ci < 3) ssm_load_u(P, rowb + 64 * (ci + 1), g, lane, un, rn, false);
              float hre = 0.f, him = 0.f;
              for (int rp2 = 0; rp2 < (PROBE_SSM == 4 ? 2 : 1); ++rp2) { hre = 0.f; him = 0.f; asm volatile("" : "+v"(hre), "+v"(him));
              ssm_chunk<false>(sb, lane, uc, rc, af, cf, lam.x, lam.y, hre, him, dsk, Z, rowb + 64 * ci, g); }
              Sloc[(4 * wid + ci) * 64 + lane] = (f32x2){hre, him}; } }
        bf16x8 un[4]; v2u rn[4]; ssm_load_u(P, rowb, g, lane, un, rn, true);
        const int sbt = 4 * b + (wid & 3); const size_t so = ((size_t)(l * 16 + sbt) * 64 + g) * 64 + lane; const size_t srow0 = (size_t)TPR + (size_t)sbt * 64;
        bf16x8 us[4]; v2u rs[4]; float sre = 0.f, sim = 0.f;
        if (wid < 4) { ssm_load_u(P, srow0, g, lane, us, rs, true); sre = *(const GAS float*)(A.in[4] + so); sim = *(const GAS float*)(A.in[5] + so); }
        else {
#pragma unroll
            for (int s = 0; s < 4; ++s) { us[s] = mk_bf16x8(0u, 0u, 0u, 0u); rs[s] = (v2u){0u, 0u}; } }
        __syncthreads();
        float hre = 0.f, him = 0.f;
#pragma unroll 4
        for (int c = 0; c < 4 * wid; ++c) { const f32x2 s = Sloc[c * 64 + lane]; const float nre = lam.z * hre - lam.w * him + s.x, nim = lam.z * him + lam.w * hre + s.y; hre = nre; him = nim; }
        {
#pragma unroll 1
          for (int ci = 0; ci < 4; ++ci) { bf16x8 uc[4]; v2u rc[4];
#pragma unroll
              for (int s = 0; s < 4; ++s) { uc[s] = un[s]; rc[s] = rn[s]; }
              if (ci < 3) ssm_load_u(P, rowb + 64 * (ci + 1), g, lane, un, rn, true);
              ssm_chunk<true>(sb, lane, uc, rc, af, cf, lam.x, lam.y, hre, him, dsk, Z, rowb + 64 * ci, g); } }
        if (wid == 7) { const size_t o = ((size_t)(l * 4 + b) * 64 + g) * 64 + lane; A.out[O_PSR + o] = hre; A.out[O_PSI + o] = him; }
        if (wid < 4) {
            ssm_chunk<true>(sb, lane, us, rs, af, cf, lam.x, lam.y, sre, sim, dsk, Z, srow0, g);
            A.out[O_SSR + so] = sre; A.out[O_SSI + so] = sim; }
        __syncthreads();
    }
}

constexpr int AT_KROW = 144, AT_VROW = 392, AT_K = 0, AT_V = 27648, AT_O = 53248, AT_OW = 4608;
__device__ __forceinline__ void attn_unit(LAS unsigned char* lds, int tid, int wid, int lane, int cbk, int hk, const bf16* P, const bf16* QN, const bf16* KN, const float* ck_l, const float* cv_l, const float* sink_l, bf16* AO) {
    LAS unsigned char* Kl = lds + AT_K; LAS unsigned char* Vt = lds + AT_V; LAS unsigned char* Os = lds + AT_O + wid * AT_OW;
    const bool smp = cbk >= 128; const int c = cbk & 31;
    const int kt0 = smp ? 0 : (c >= 2 ? 0 : (c == 1 ? 2 : 4));
    const int q = lane & 31, hi = lane >> 5, rr = wid >> 1, tok0 = 32 * (wid & 1), h = 4 * hk + rr;
    const size_t qrow = (size_t)cbk * 64 + tok0 + q;
    bf16x8 qr[4];
#pragma unroll
    for (int d0 = 0; d0 < 4; ++d0) qr[d0] = *(const GAS bf16x8*)(QN + qrow * 1024 + h * 64 + 16 * d0 + 8 * hi);
    const float sink_h = *(const GAS float*)(sink_l + h);
#pragma unroll
    for (int j = 0; j < 3; ++j) { const int ci = tid + 512 * j, kk = ci >> 3, c8 = ci & 7; v4u kw, vw;
        if (kk < 32 * kt0) { kw = (v4u){0u, 0u, 0u, 0u}; vw = kw; }
        else if (smp && kk < 128) { const size_t so = (((size_t)(cbk - 128) * 128 + kk) * 4 + hk) * 64 + 8 * c8;
            kw = pg8::pack8(*(const f32x4*)(ck_l + so), *(const f32x4*)(ck_l + so + 4)); vw = pg8::pack8(*(const f32x4*)(cv_l + so), *(const f32x4*)(cv_l + so + 4)); }
        else { const size_t grow = (size_t)((cbk - 2) * 64 + kk); kw = *(const GAS v4u*)(KN + grow * 256 + hk * 64 + 8 * c8); vw = *(const GAS v4u*)(P + grow * NPJ + 2304 + hk * 64 + 8 * c8); }
        *(LAS v4u*)(Kl + kk * AT_KROW + 16 * c8) = kw;
        LAS unsigned char* vp = Vt + (8 * c8) * AT_VROW + 2 * kk;
        *(LAS unsigned short*)(vp + 0 * AT_VROW) = (unsigned short)(vw.x & 0xffffu); *(LAS unsigned short*)(vp + 1 * AT_VROW) = (unsigned short)(vw.x >> 16);
        *(LAS unsigned short*)(vp + 2 * AT_VROW) = (unsigned short)(vw.y & 0xffffu); *(LAS unsigned short*)(vp + 3 * AT_VROW) = (unsigned short)(vw.y >> 16);
        *(LAS unsigned short*)(vp + 4 * AT_VROW) = (unsigned short)(vw.z & 0xffffu); *(LAS unsigned short*)(vp + 5 * AT_VROW) = (unsigned short)(vw.z >> 16);
        *(LAS unsigned short*)(vp + 6 * AT_VROW) = (unsigned short)(vw.w & 0xffffu); *(LAS unsigned short*)(vp + 7 * AT_VROW) = (unsigned short)(vw.w >> 16); }
    __syncthreads();
    f32x16 p[6];
#pragma unroll
    for (int T = 0; T < 6; ++T) {
#pragma unroll
        for (int r = 0; r < 16; ++r) p[T][r] = 0.f;
#pragma unroll
        for (int d0 = 0; d0 < 4; ++d0) { const bf16x8 kf = *(const LAS bf16x8*)(Kl + (32 * T + q) * AT_KROW + (16 * d0 + 8 * hi) * 2); p[T] = __builtin_amdgcn_mfma_f32_32x32x16_bf16(kf, qr[d0], p[T], 0, 0, 0); } }
    const float SC = 0.125f * 1.4426950408889634f, sk2 = sink_h * 1.4426950408889634f;
    float mr = -3.0e38f;
#pragma unroll
    for (int T = 0; T < 6; ++T) if (T >= kt0) {
#pragma unroll
        for (int r = 0; r < 16; r += 2) mr = __builtin_fmaxf(__builtin_fmaxf(mr, p[T][r]), p[T][r + 1]); }
    mr = fmaxf(mr, __shfl_xor(mr, 32));
    const float m = fmaxf(mr * SC, sk2), nm = -m;
    float sum = 0.f;
#pragma unroll
    for (int T = 0; T < 6; ++T) {
        if (T >= kt0) {
#pragma unroll
            for (int r = 0; r < 16; ++r) { const float e = __builtin_amdgcn_exp2f(__builtin_fmaf(p[T][r], SC, nm)); p[T][r] = e; sum += e; }
        } else {
#pragma unroll
            for (int r = 0; r < 16; ++r) p[T][r] = 0.f;
        } }
    sum += __shfl_xor(sum, 32);
    const float inv = 1.0f / (sum + __builtin_amdgcn_exp2f(sk2 - m));
    f32x16 o[2];
#pragma unroll
    for (int r = 0; r < 16; ++r) { o[0][r] = 0.f; o[1][r] = 0.f; }
#pragma unroll
    for (int T = 0; T < 6; ++T)
#pragma unroll
        for (int s = 0; s < 2; ++s) {
            const bf16x8 pa = mk_bf16x8(cvt_pk_bf16(p[T][8 * s + 0], p[T][8 * s + 1]), cvt_pk_bf16(p[T][8 * s + 2], p[T][8 * s + 3]), cvt_pk_bf16(p[T][8 * s + 4], p[T][8 * s + 5]), cvt_pk_bf16(p[T][8 * s + 6], p[T][8 * s + 7]));
#pragma unroll
            for (int dt = 0; dt < 2; ++dt) { const LAS unsigned char* vp = Vt + (32 * dt + q) * AT_VROW + 2 * (32 * T + 16 * s + 4 * hi);
                const v2u lo = *(const LAS v2u*)vp, hh = *(const LAS v2u*)(vp + 16);
                o[dt] = __builtin_amdgcn_mfma_f32_32x32x16_bf16(pa, mk_bf16x8(lo.x, lo.y, hh.x, hh.y), o[dt], 0, 0, 0); } }
#pragma unroll
    for (int r = 0; r < 16; ++r) { const int qq = crow(r, hi); const float iv = __shfl(inv, qq);
        *(LAS unsigned short*)(Os + qq * 144 + 2 * q) = (unsigned short)f2bf(o[0][r] * iv);
        *(LAS unsigned short*)(Os + qq * 144 + 2 * (32 + q)) = (unsigned short)f2bf(o[1][r] * iv); }
#pragma unroll
    for (int j = 0; j < 4; ++j) { const int qq = (lane >> 3) + 8 * j, c8 = lane & 7;
        const v4u w = *(const LAS v4u*)(Os + qq * 144 + 16 * c8);
        *(GAS v4u*)(AO + ((size_t)cbk * 64 + tok0 + qq) * 1024 + h * 64 + 8 * c8) = w; }
    __syncthreads();
}

__global__ void __launch_bounds__(NWAVES * 64, 2) enc_fwd(Args args) {
    extern __shared__ __attribute__((aligned(16))) unsigned char lds_raw[];
    LAS unsigned char* lds = (LAS unsigned char*)lds_raw;
    volatile LAS unsigned* MISC = (volatile LAS unsigned*)(lds + MISC_OFF);
    const int wid = __builtin_amdgcn_readfirstlane((int)threadIdx.x >> 6);
    const int G = gridDim.x, bx = blockIdx.x;
    const int gw = bx * NWAVES + wid, NGW = G * NWAVES;
#define MODL ((const float*)(ws + WS_MOD) + (size_t)l * NCB * MODW)
#define FRESH_LANE() int tid_f = threadIdx.x; asm volatile("" : "+v"(tid_f)); const int tid = tid_f, lane = tid & 63; (void)tid; (void)lane
    unsigned char* ws0 = args.ws;
    for (int u = threadIdx.x; u < (LDS_BYTES - LDSCTL_OFF) / 4; u += NWAVES * 64) ((LAS unsigned*)(lds + LDSCTL_OFF))[u] = 0u;
    __syncthreads();
    XcdBarrier bar; bar.bar = (unsigned*)(ws0 + WS_CTL) + CW_BAR; bar.x = 0; bar.st = nullptr;
    if (MK_ONE_LAUNCH) bar = xcd_barrier_post((unsigned*)(ws0 + WS_CTL) + CW_BAR, MISC + 8);
    const int lo = args.ph_lo, hi = args.ph_hi;
#ifndef DISABLE
#define DISABLE 0
#endif
#define IN(k) (lo <= (k) && (k) < hi)
#define EN(i) (((DISABLE >> (i)) & 1) == 0)
#ifndef PROBE_REP
#define PROBE_REP 0
#endif
#ifndef PROBE_L
#define PROBE_L -1
#endif
#define NREP(i) ((((PROBE_REP >> (i)) & 1) && ((i) == 0 || PROBE_L < 0 || l == PROBE_L)) ? 2 : 1)
#ifndef PROBE_BAR
#define PROBE_BAR 1
#endif
#define SEAM(k) do { if (IN((k) + 1)) { for (int nb_ = 0; nb_ < PROBE_BAR; ++nb_) xcd_barrier(bar); } } while (0)
#define H   ((bf16*)(ws + WS_H))
#define P   ((bf16*)(ws + WS_P))
#define QN  ((bf16*)(ws + WS_QN))
#define KN  ((bf16*)(ws + WS_KN))
#define Z   ((bf16*)(ws + WS_Z))
#define SO  ((bf16*)(ws + WS_SO))
#define AO  ((bf16*)(ws + WS_AO))
#define T1  ((bf16*)(ws + WS_T1))
#define MX  ((bf16*)(ws + WS_MX))
#define ACT ((bf16*)(ws + WS_ACT))
#define X   (args.out + O_Y)
#define XB  ((bf16*)(ws + WS_XB))
#define SL  ((bf16*)(ws + WS_SL))
#define FRESH_WS() unsigned char* ws = args.ws; asm volatile("" : "+s"(ws))

#ifndef MOD_SPLIT
#define MOD_SPLIT 112
#endif
#ifndef PROBE_ALL
#define PROBE_ALL 1
#endif
#pragma unroll 1
    for (int pass_ = 0; pass_ < PROBE_ALL; ++pass_) {
    if (EN(0) && IN(0)) { const int l = 0; (void)l; for (int rep = 0; rep < NREP(0); ++rep) { FRESH_LANE(); p0_prologue(args, lds, tid, wid, lane, G, bx); } SEAM(0); }

#pragma unroll 1
    for (int l = 0; l < NL; ++l) {
        const int pb = 1 + 10 * l;
        if (EN(1) && IN(pb + 0)) { for (int rep = 0; rep < NREP(1); ++rep) { FRESH_WS(); FRESH_LANE(); norm_phase(gw, NGW, lane, XB, l == 0 ? args.in[0] : nullptr, args.in[1], l > 0 ? SL : nullptr, args.in[10] + (size_t)l * DM, MODL, 0, 2048, H); } SEAM(pb + 0); }
        if (EN(2) && IN(pb + 1)) { for (int rep = 0; rep < NREP(2); ++rep) { FRESH_WS(); pg8::Gemm g{H, (const bf16*)(ws + WS_W1 + l * SZ_W1), NTOK, 6656, 2048}; pg8::StaticOrder S; S.init(NTOK, 6656, 2048, G, bx);
            pg8::EpiG1 E{P, args.in[27] + (size_t)l * 4096, QN, KN, args.in[23] + l * 64, args.in[24] + l * 64, (const float*)(ws + WS_ROPE), args.out, l, O_PK, O_PV, O_SK, O_SV};
            pg8::gemm_phase<pg8::EpiG1, pg8::StaticOrder, PG8_ALIGN, PG8_SP2>(lds + RING_OFF, g, S, E);
            { FRESH_LANE(); backfill(args, ws, lds, tid, wid, lane, G, bx, 936 - ((936 - 1) / G) * G, l + 1, MOD_SPLIT, 192, l, 6656, 11264); backfill(args, ws, lds, tid, wid, lane, G, bx, 936 - ((936 - 1) / G) * G, NL, 0, 0, l, 15360, 16896); } } SEAM(pb + 1); }
        if (EN(4) && IN(pb + 3)) { for (int rep = 0; rep < NREP(4); ++rep) { FRESH_WS();
#ifndef ATT_IN_GLU
#define ATT_IN_GLU 1
#endif
#ifndef PROBE_SA
#define PROBE_SA 0
#endif
            for (int r2 = 0; r2 < (PROBE_SA == 1 ? 2 : 1); ++r2) { FRESH_LANE(); ssm_phase(lds, tid, wid, lane, G, bx, l, args, P, Z); }
            if (!(ATT_IN_GLU && G == 256)) { FRESH_LANE();
            for (int ai_ = 0; ai_ < 3; ++ai_) { int a = bx + ai_ * G; if (a >= 576) break;
                attn_unit(lds, tid, wid, lane, a >> 2, a & 3, P, QN, KN, args.in[2] + (size_t)l * 16 * 128 * 256, args.in[3] + (size_t)l * 16 * 128 * 256, args.in[25] + l * 16, AO); } }
            } SEAM(pb + 3); }
        if (EN(5) && IN(pb + 4)) { for (int rep = 0; rep < NREP(5); ++rep) { FRESH_WS(); pg8::Gemm g{Z, (const bf16*)(ws + WS_WGLU + l * SZ_WGLU), NTOK, 1024, 1024}; pg8::PanelOrder S; S.init(NTOK, 1024, 1024, G, bx);
            pg8::EpiGLU E{Z, SO, args.in[22] + (size_t)l * 1024};
            pg8::gemm_phase<pg8::EpiGLU, pg8::PanelOrder, PG8_ALIGN, PG8_SP2>(lds + RING_OFF, g, S, E);
            if (ATT_IN_GLU && G == 256) { FRESH_LANE();
                const int j_ = bx >> 3;
                for (int r2 = 0; r2 < (PROBE_SA == 2 ? 2 : 1); ++r2)
                for (int id_ = j_ < 18 ? j_ : 18 + (j_ - 18); id_ < (j_ < 18 ? j_ + 1 : 72); id_ += 14) { const int x_ = bx & 7; const int a = id_ < 64 ? 64 * x_ + id_ : 512 + 8 * x_ + (id_ - 64);
                    attn_unit(lds, tid, wid, lane, a >> 2, a & 3, P, QN, KN, args.in[2] + (size_t)l * 16 * 128 * 256, args.in[3] + (size_t)l * 16 * 128 * 256, args.in[25] + l * 16, AO); } }
            { FRESH_LANE(); backfill(args, ws, lds, tid, wid, lane, G, bx, 144 - ((144 - 1) / G) * G, l + 1, 0, MOD_SPLIT, NL, 0, 0); } } SEAM(pb + 4); }
        if (EN(6) && IN(pb + 5)) { for (int rep = 0; rep < NREP(6); ++rep) { FRESH_WS();
            { pg8::Gemm g{SO, (const bf16*)(ws + WS_WPS + l * SZ_WP), NTOK, 2048, 1024}; pg8::PROrder S; S.init(NTOK, 2048, 1024, G, bx, 0);
              pg8::EpiPR<0> E{P, nullptr, T1, (unsigned*)(ws + WS_CTL + 32768) + (size_t)l * 32 * 64};
              pg8::gemm_phase<pg8::EpiPR<0>, pg8::PROrder, PG8_ALIGN, PG8_SP2>(lds + RING_OFF, g, S, E); }
            VM_WAIT(); __syncthreads();
            { pg8::Gemm g{AO, (const bf16*)(ws + WS_WPA + l * SZ_WP), NTOK, 2048, 1024}; pg8::PROrder S; S.init(NTOK, 2048, 1024, G, bx, 4);
              pg8::EpiPR<1> E{P, T1, MX, (unsigned*)(ws + WS_CTL + 32768) + (size_t)l * 32 * 64};
              pg8::gemm_phase<pg8::EpiPR<1>, pg8::PROrder, PG8_ALIGN, PG8_SP2>(lds + RING_OFF, g, S, E); }
            { FRESH_LANE(); backfill(args, ws, lds, tid, wid, lane, G, bx, G == 256 ? 64 : 288 - ((288 - 1) / G) * G, l + 1, 192, 384, l, 16896, 22528); }
            } SEAM(pb + 5); }
        if (EN(7) && IN(pb + 6)) { for (int rep = 0; rep < NREP(7); ++rep) { FRESH_WS(); pg8::Gemm g{MX, (const bf16*)(ws + WS_WOUT + l * SZ_WOUT), NTOK, 2048, 2048}; pg8::SplitOrder S; S.init(2048, G, bx);
            pg8::EpiRes E{(NREP(7) == 2 && rep == 0) ? (bf16*)(ws + WS_ACT) : XB, nullptr, MODL + 4096, SL};
            pg8::gemm_phase<pg8::EpiRes, pg8::SplitOrder, PG8_ALIGN, PG8_SP2>(lds + RING_OFF, g, S, E); } SEAM(pb + 6); }
        if (EN(8) && IN(pb + 7)) { for (int rep = 0; rep < NREP(8); ++rep) { FRESH_WS(); FRESH_LANE(); norm_phase(gw, NGW, lane, XB, nullptr, nullptr, SL, args.in[11] + (size_t)l * DM, MODL, 6144, 8192, H); } SEAM(pb + 7); }
        if (EN(9) && IN(pb + 8)) { for (int rep = 0; rep < NREP(9); ++rep) { FRESH_WS(); pg8::Gemm g{H, (const bf16*)(ws + WS_WGU + l * SZ_WGU), NTOK, 11264, 2048}; pg8::StaticOrder S; S.init(NTOK, 11264, 2048, G, bx);
            pg8::EpiFU E{ACT};
            pg8::gemm_phase<pg8::EpiFU, pg8::StaticOrder, PG8_ALIGN, PG8_SP2>(lds + RING_OFF, g, S, E);
            { FRESH_LANE(); backfill(args, ws, lds, tid, wid, lane, G, bx, 1584 - ((1584 - 1) / G) * G, NL, 0, 0, l, 22528, CONV_PER_L); backfill(args, ws, lds, tid, wid, lane, G, bx, 1584 - ((1584 - 1) / G) * G, NL, 0, 0, l + 1, 0, 6656); backfill(args, ws, lds, tid, wid, lane, G, bx, 1584 - ((1584 - 1) / G) * G, NL, 0, 0, l + 1, 11264, 15360); } } SEAM(pb + 8); }
        if (EN(10) && IN(pb + 9)) { for (int rep = 0; rep < NREP(10); ++rep) { FRESH_WS(); pg8::Gemm g{ACT, (const bf16*)(ws + WS_WDN + l * SZ_WDN), NTOK, 2048, 5632}; pg8::SplitOrder S; S.init(5632, G, bx);
            pg8::EpiRes E{(NREP(10) == 2 && rep == 0) ? (bf16*)(ws + WS_P) : XB, l == NL - 1 ? X : nullptr, MODL + 10240, SL};
            pg8::gemm_phase<pg8::EpiRes, pg8::SplitOrder, PG8_ALIGN, PG8_SP2>(lds + RING_OFF, g, S, E); } SEAM(pb + 9); }
    }
    if (IN(NPHASE - 1)) { FRESH_WS(); FRESH_LANE(); final_phase(gw, NGW, lane, X, XB, SL); }
    if (pass_ + 1 < PROBE_ALL) xcd_barrier(bar);
    }
#undef IN
#undef SEAM
#undef H
#undef P
#undef QN
#undef KN
#undef Z
#undef SO
#undef AO
#undef T1
#undef MX
#undef ACT
#undef X
#undef XB
#undef SL
}

extern "C" void kernel_launch(void* const* d_in, const int* in_sizes, int n_in, void* d_out, int out_size, void* d_ws, size_t ws_size, hipStream_t stream) {
    static int grid = 0;
    if (grid == 0) {
        if (n_in != 34 || out_size != (int)O_END || ws_size < WS_END) { fprintf(stderr, "kernel_launch: built for 34 inputs, %zu outputs, >= %zu bytes of workspace; got n_in %d, out %d, ws %zu; nothing launched\n", (size_t)O_END, (size_t)WS_END, n_in, out_size, ws_size); grid = -1; return; }
        int dev = 0, cus = 0, per_cu = 0;
        if (hipGetDevice(&dev) != hipSuccess || hipDeviceGetAttribute(&cus, hipDeviceAttributeMultiprocessorCount, dev) != hipSuccess) { fprintf(stderr, "kernel_launch: device query failed\n"); grid = -1; return; }
        if (hipFuncSetAttribute((const void*)enc_fwd, hipFuncAttributeMaxDynamicSharedMemorySize, LDS_BYTES) != hipSuccess) { fprintf(stderr, "kernel_launch: hipFuncSetAttribute failed\n"); grid = -1; return; }
        if (hipOccupancyMaxActiveBlocksPerMultiprocessor(&per_cu, (const void*)enc_fwd, NWAVES * 64, LDS_BYTES) != hipSuccess || per_cu < 1)
            fprintf(stderr, "kernel_launch: note: occupancy query reports %d workgroups per CU\n", per_cu);
        (void)hipGetLastError();
        grid = cus;
    }
    if (grid < 0) return;
    if (hipMemsetAsync((char*)d_ws + WS_CTL, 0, CTL_ZERO_BYTES, stream) != hipSuccess) { fprintf(stderr, "kernel_launch: memset failed\n"); return; }
    Args a{};
    for (int i = 0; i < 34; ++i) a.in[i] = (const float*)d_in[i];
    a.out = (float*)d_out; a.ws = (unsigned char*)d_ws;
#if MK_ONE_LAUNCH
    a.ph_lo = 0; a.ph_hi = NPHASE;
    hipLaunchKernelGGL(enc_fwd, dim3(grid), dim3(NWAVES * 64), LDS_BYTES, stream, a);
#else
    for (int ph = 0; ph < NPHASE; ++ph) { a.ph_lo = ph; a.ph_hi = ph + 1; hipLaunchKernelGGL(enc_fwd, dim3(grid), dim3(NWAVES * 64), LDS_BYTES, stream, a); }
#endif
    const hipError_t le = hipPeekAtLastError();
    if (le != hipSuccess) fprintf(stderr, "kernel_launch: launch failed: %s\n", hipGetErrorName(le));
}
```

```cpp
#include <hip/hip_runtime.h>
#include <cstdio>
#include <cstdint>
#define GAS __attribute__((address_space(1)))
namespace pg8 {
#define PG8_LAS __attribute__((address_space(3)))
typedef unsigned short bf16_t;
typedef short bf16x8 __attribute__((ext_vector_type(8)));
typedef float f32x4 __attribute__((ext_vector_type(4)));
typedef unsigned u32x4 __attribute__((ext_vector_type(4)));
constexpr int BM = 256, BK = 64, HALF = 128, HTB = HALF * BK * 2  , STAGE_BYTES = 8 * HTB, NXCD = 8, WGM = 6;

__host__ __device__ __forceinline__ int lds_byte(int r, int c) { const int st = (r >> 4) * 2 + (c >> 5), rr = r & 15, cc = c & 31, ob = rr * 64 + cc * 2; return st * 1024 + (ob ^ (((ob >> 9) & 1) << 5)); }
__host__ __device__ __forceinline__ void stage_rc(int b, int& R, int& C) { const int st = b / 1024, sb = b % 1024, swz = sb ^ (((sb >> 9) & 1) << 5); R = (st >> 1) * 16 + swz / 64; C = (st & 1) * 32 + (swz % 64) / 2; }
__host__ __device__ __forceinline__ int perm32(int rho) { const int n = rho >> 4, i = rho & 15; return 8 * (i >> 2) + 4 * n + (i & 3); }

#ifndef SPLIT_SWAP
#define SPLIT_SWAP 0
#endif
#ifndef ORD_TR
#define ORD_TR 0
#endif
#ifndef KROT
#define KROT 0
#endif
struct Unit { int pm, pn, kt0, nkt, slab, krot; };
struct Gemm { const bf16_t* A; const bf16_t* Bt; int M, N, K; };

struct StaticOrder {
    int nM, nN, nwg, G, c, nkt;
    __host__ __device__ void init(int M, int N, int K, int G_, int c_) { nM = M / BM; nN = N / BM; nwg = nM * nN; G = G_; c = c_; nkt = K / BK; }
    __host__ __device__ bool next(int i, Unit& u) const {
        const long L = (long)i * G + c; if (L >= nwg) return false;
        int wgid = (int)L; { const int q = nwg / NXCD, r = nwg % NXCD, xcd = wgid % NXCD, off = wgid / NXCD; wgid = (xcd < r ? xcd * (q + 1) : r * (q + 1) + (xcd - r) * q) + off; }
        if (ORD_TR > 0) {
            const int nig = ORD_TR * nM, gid = wgid / nig, fn = gid * ORD_TR, gsz = (nN - fn) < ORD_TR ? (nN - fn) : ORD_TR;
            u.pn = fn + ((wgid % nig) % gsz); u.pm = (wgid % nig) / gsz; u.kt0 = 0; u.nkt = nkt; u.slab = -1; u.krot = 0; return true; }
        const int nig = WGM * nN, gid = wgid / nig, fm = gid * WGM, gsz = (nM - fm) < WGM ? (nM - fm) : WGM;
        u.pm = fm + ((wgid % nig) % gsz); u.pn = (wgid % nig) / gsz; u.kt0 = 0; u.nkt = nkt; u.slab = -1; u.krot = KROT ? 2 * (((c & 7) * (nkt >> 1)) >> 3) : 0; return true;
    }
    __device__ __forceinline__ void a_ready(const Unit&) const {}
    __device__ __forceinline__ void done(const Unit&) const {}
};
struct PanelOrder {
    StaticOrder so; int nN, nkt, G, c;
    __host__ __device__ void init(int M, int N, int K, int G_, int c_) { so.init(M, N, K, G_, c_); nN = N / BM; nkt = K / BK; G = G_; c = c_; }
    __host__ __device__ bool next(int i, Unit& u) const {
        if (G != 256 || so.nM != 36) return so.next(i, u);
        const int x = c & 7, j = c >> 3, id = 32 * i + j, np = 4 * nN, ns = np >> 3;
        if (id >= np + ns) return false;
        if (id < np) { u.pm = 4 * x + (id & 3); int pn = (id >> 2) + (x * nN) / 8; u.pn = pn >= nN ? pn - nN : pn; }
        else { const int s = x * ns + (id - np); u.pm = 32 + (s & 3); u.pn = s >> 2; }
        u.kt0 = 0; u.nkt = nkt; u.slab = -1; u.krot = 0; return true;
    }
    __device__ __forceinline__ void a_ready(const Unit&) const {}
    __device__ __forceinline__ void done(const Unit&) const {}
};
struct PROrder {
    StaticOrder so; int G, c, nkt, sj0;
    __host__ __device__ void init(int M, int N, int K, int G_, int c_, int sj0_) { so.init(M, N, K, G_, c_); G = G_; c = c_; nkt = K / BK; sj0 = sj0_; }
    __host__ __device__ bool next(int i, Unit& u) const {
        if (G != 256) return so.next(i, u);
        const int x = c & 7, j = c >> 3;
        if (i == 0) { u.pm = 4 * x + (j & 3); const int pn = (j >> 2) + x; u.pn = pn & 7; }
        else if (i == 1) { const int jj = j - sj0; if (jj < 0 || jj >= 4) return false; const int s = 4 * x + jj; u.pm = 32 + (s & 3); u.pn = s >> 2; }
        else return false;
        u.kt0 = 0; u.nkt = nkt; u.slab = -1; u.krot = 0; return true;
    }
    __device__ __forceinline__ void a_ready(const Unit&) const {}
    __device__ __forceinline__ void done(const Unit&) const {}
};
struct BlockOrder {
    StaticOrder so; int nN, nkt, G, c;
    __host__ __device__ void init(int M, int N, int K, int G_, int c_) { so.init(M, N, K, G_, c_); nN = N / BM; nkt = K / BK; G = G_; c = c_; }
    __host__ __device__ bool next(int i, Unit& u) const {
        if (G != 256 || so.nM != 36 || (nN & 1)) return so.next(i, u);
        const int x = c & 7, j = c >> 3, id = 32 * i + j, hn = nN >> 1;
        if (id >= 9 * hn) return false;
        u.pm = 9 * (x >> 1) + id % 9; u.pn = (x & 1) * hn + id / 9; u.kt0 = 0; u.nkt = nkt; u.slab = -1; u.krot = 0; return true;
    }
    __device__ __forceinline__ void a_ready(const Unit&) const {}
    __device__ __forceinline__ void done(const Unit&) const {}
};
struct SplitOrder {
    int G, c, nkt;
    __host__ __device__ void init(int K, int G_, int c_) { G = G_; c = c_; nkt = K / BK; }
    __host__ __device__ bool next(int i, Unit& u) const {
        int e = i * G + c; if (e >= 512) return false;
        if (SPLIT_SWAP && G == 256 && (c & 1)) e ^= 256;
        const int f = e & 255, x = f & 7, j = f >> 3;
        if (e < 256) { u.pm = 4 * x + (j >> 3); u.pn = j & 7; u.kt0 = 0; u.nkt = nkt; u.slab = -1; u.krot = KROT ? 2 * ((x * (nkt >> 1)) >> 3) : 0; }
        else { const int np = nkt >> 1, base = np >> 3, rem = np & 7, pairs = base + (x < rem ? 1 : 0), start = x * base + (x < rem ? x : rem);
            u.pm = 32 + (j >> 3); u.pn = j & 7; u.kt0 = 2 * start; u.nkt = 2 * pairs; u.slab = x; u.krot = 0; }
        return true;
    }
    __device__ __forceinline__ void a_ready(const Unit&) const {}
    __device__ __forceinline__ void done(const Unit&) const {}
};

__device__ __forceinline__ unsigned cvt_pk_bf16(float lo, float hi) { unsigned r; asm volatile("v_cvt_pk_bf16_f32 %0, %1, %2" : "=v"(r) : "v"(lo), "v"(hi)); return r; }
typedef float f32x2 __attribute__((ext_vector_type(2)));
typedef unsigned u32x2 __attribute__((ext_vector_type(2)));
__device__ __forceinline__ float bflo(unsigned w) { return __uint_as_float(w << 16); }
__device__ __forceinline__ float bfhi(unsigned w) { return __uint_as_float(w & 0xffff0000u); }
__device__ __forceinline__ float sigmoidf_(float x) { return __builtin_amdgcn_rcpf(1.0f + __builtin_amdgcn_exp2f(-1.4426950408889634f * x)); }
__device__ __forceinline__ f32x4 sigmoid4(f32x4 v) {
    const f32x2 t0 = (f32x2){v[0], v[1]} * -1.4426950408889634f, t1 = (f32x2){v[2], v[3]} * -1.4426950408889634f;
    const f32x2 d0 = (f32x2){__builtin_amdgcn_exp2f(t0.x), __builtin_amdgcn_exp2f(t0.y)} + 1.0f, d1 = (f32x2){__builtin_amdgcn_exp2f(t1.x), __builtin_amdgcn_exp2f(t1.y)} + 1.0f;
    return (f32x4){__builtin_amdgcn_rcpf(d0.x), __builtin_amdgcn_rcpf(d0.y), __builtin_amdgcn_rcpf(d1.x), __builtin_amdgcn_rcpf(d1.y)}; }
__device__ __forceinline__ u32x4 pack8(f32x4 v0, f32x4 v1) { u32x4 w; w.x = cvt_pk_bf16(v0[0], v0[1]); w.y = cvt_pk_bf16(v0[2], v0[3]); w.z = cvt_pk_bf16(v1[0], v1[1]); w.w = cvt_pk_bf16(v1[2], v1[3]); return w; }
#ifndef WT_STORES
#define WT_STORES 0
#endif
__device__ __forceinline__ void store16_wt(void* p, u32x4 w) {
    if (WT_STORES) asm volatile("global_store_dwordx4 %0, %1, off sc1\n\ts_nop 1" :: "v"(p), "v"(w) : "memory");
    else *(GAS u32x4*)p = w;
}
__device__ __forceinline__ void unpack8(u32x4 w, f32x4& v0, f32x4& v1) { v0 = (f32x4){bflo(w.x), bfhi(w.x), bflo(w.y), bfhi(w.y)}; v1 = (f32x4){bflo(w.z), bfhi(w.z), bflo(w.w), bfhi(w.w)}; }

constexpr int NPJ = 6656;
struct EpiG1 {
    static constexpr bool PERM = true, AFTER_DRAIN = false, IDEMPOTENT = true;
    bf16_t* P; const float* bgate; bf16_t* QN; bf16_t* KN; const float* qg; const float* kg; const float* rope; float* out; int l;
    size_t o_pk, o_pv, o_sk, o_sv;
    __device__ __forceinline__ void operator()(const f32x4 (&acc)[2][2][4][2], const Unit& u, int wr, int wc, int fr_in, int fq_in) const {
        int fr = fr_in, fq = fq_in; asm volatile("" : "+v"(fr), "+v"(fq));
        const int row0 = u.pm * BM + wr * 64 + fr;
        if (u.pn >= 4 && u.pn <= 8) {
            const bool isk = u.pn == 8;
            const float* g = isk ? kg : qg;
            f32x4 gv[2][2];
#pragma unroll
            for (int bj = 0; bj < 2; ++bj)
#pragma unroll
                for (int n = 0; n < 2; ++n) gv[bj][n] = *(const f32x4*)(g + 32 * bj + 8 * fq + 4 * n);
#pragma unroll
            for (int ai = 0; ai < 2; ++ai)
#pragma unroll
                for (int m = 0; m < 4; ++m) {
                    const int row = row0 + ai * HALF + m * 16;
                    const bool smp = row >= 8192; const int t = smp ? ((row - 8192) & 63) : (row & 2047); const int bb = smp ? ((row - 8192) >> 6) : (row >> 11);
                    const float* rt = rope + (smp ? 2048 + t : t) * 16;
                    const f32x4 c0 = *(const GAS f32x4*)(rt), c1 = *(const GAS f32x4*)(rt + 4), s0 = *(const GAS f32x4*)(rt + 8), s1 = *(const GAS f32x4*)(rt + 12);
                    f32x4 y[2][2]; float ss = 0.f;
#pragma unroll
                    for (int bj = 0; bj < 2; ++bj)
#pragma unroll
                        for (int n = 0; n < 2; ++n) { y[bj][n] = acc[ai][bj][m][n]; ss += (y[bj][n][0] * y[bj][n][0] + y[bj][n][1] * y[bj][n][1]) + (y[bj][n][2] * y[bj][n][2] + y[bj][n][3] * y[bj][n][3]); }
                    ss += __shfl_xor(ss, 16); ss += __shfl_xor(ss, 32);
                    const float rstd = 1.0f / sqrtf(ss * (1.0f / 64.0f) + 1e-6f);
#pragma unroll
                    for (int bj = 0; bj < 2; ++bj)
#pragma unroll
                        for (int n = 0; n < 2; ++n) y[bj][n] = y[bj][n] * rstd * gv[bj][n];
                    f32x4 p0, p1;
#pragma unroll
                    for (int i = 0; i < 4; ++i) { p0[i] = __shfl_xor(y[0][0][i], 16); p1[i] = __shfl_xor(y[0][1][i], 16); }
                    if (fq == 0) { y[0][0] = y[0][0] * c0 - p0 * s0; y[0][1] = y[0][1] * c1 - p1 * s1; }
                    else if (fq == 1) { y[0][0] = y[0][0] * c0 + p0 * s0; y[0][1] = y[0][1] * c1 + p1 * s1; }
                    if (!isk) { bf16_t* qp = QN + (size_t)row * 1024 + (4 * (u.pn - 4) + wc) * 64 + 8 * fq;
                        *(GAS u32x4*)(qp) = pack8(y[0][0], y[0][1]); *(GAS u32x4*)(qp + 32) = pack8(y[1][0], y[1][1]); }
                    else { const int co = wc * 64 + 8 * fq; bf16_t* kp = KN + (size_t)row * 256 + co;
                        *(GAS u32x4*)(kp) = pack8(y[0][0], y[0][1]); *(GAS u32x4*)(kp + 32) = pack8(y[1][0], y[1][1]);
                        if (smp || t >= 1920) { float* d = out + (smp ? o_sk + ((size_t)(l * 16 + bb) * 128 + 64 + t) * 256 : o_pk + ((size_t)(l * 4 + bb) * 128 + (t - 1920)) * 256) + co;
                            *(f32x4*)(d) = y[0][0]; *(f32x4*)(d + 4) = y[0][1]; *(f32x4*)(d + 32) = y[1][0]; *(f32x4*)(d + 36) = y[1][1]; } }
                }
            return;
        }
        const int col0 = u.pn * BM + wc * 32 + 8 * fq;
        const bool isg = u.pn >= 10, isv = u.pn == 9;
        f32x4 bv[2][2];
#pragma unroll
        for (int bj = 0; bj < 2; ++bj)
#pragma unroll
            for (int n = 0; n < 2; ++n) bv[bj][n] = isg ? *(const f32x4*)(bgate + (col0 - 2560) + bj * HALF + 4 * n) : (f32x4){0.f, 0.f, 0.f, 0.f};
#pragma unroll
        for (int ai = 0; ai < 2; ++ai)
#pragma unroll
            for (int m = 0; m < 4; ++m) { const int row = row0 + ai * HALF + m * 16; bf16_t* rowp = P + (size_t)row * NPJ + col0;
#pragma unroll
                for (int bj = 0; bj < 2; ++bj) { f32x4 v0 = acc[ai][bj][m][0] + bv[bj][0], v1 = acc[ai][bj][m][1] + bv[bj][1];
                    if (isg) { v0 = sigmoid4(v0); v1 = sigmoid4(v1); }
                    const u32x4 w = pack8(v0, v1); store16_wt(rowp + bj * HALF, w);
                    if (isv) { const bool smp = row >= 8192; const int t = smp ? ((row - 8192) & 63) : (row & 2047); const int bb = smp ? ((row - 8192) >> 6) : (row >> 11);
                        if (smp || t >= 1920) { float* d = out + (smp ? o_sv + ((size_t)(l * 16 + bb) * 128 + 64 + t) * 256 : o_pv + ((size_t)(l * 4 + bb) * 128 + (t - 1920)) * 256) + (col0 - 2304) + bj * HALF;
                            f32x4 r0, r1; unpack8(w, r0, r1); *(f32x4*)(d) = r0; *(f32x4*)(d + 4) = r1; } } } }
    }
};
struct EpiGLU {
    static constexpr bool PERM = true, AFTER_DRAIN = false, IDEMPOTENT = true;
    const bf16_t* Z; bf16_t* SO; const float* bglu;
    __device__ __forceinline__ void operator()(const f32x4 (&acc)[2][2][4][2], const Unit& u, int wr, int wc, int fr, int fq) const {
        const int row0 = u.pm * BM + wr * 64 + fr, col0 = u.pn * BM + wc * 32 + 8 * fq;
        f32x4 bv[2][2];
#pragma unroll
        for (int bj = 0; bj < 2; ++bj)
#pragma unroll
            for (int n = 0; n < 2; ++n) bv[bj][n] = *(const f32x4*)(bglu + col0 + bj * HALF + 4 * n);
#pragma unroll
        for (int ai = 0; ai < 2; ++ai)
#pragma unroll
            for (int m = 0; m < 4; ++m) { const size_t off = (size_t)(row0 + ai * HALF + m * 16) * 1024 + col0;
#pragma unroll
                for (int bj = 0; bj < 2; ++bj) { f32x4 z0, z1; unpack8(*(const GAS u32x4*)(Z + off + bj * HALF), z0, z1);
                    const f32x4 v0 = z0 * sigmoid4(acc[ai][bj][m][0] + bv[bj][0]), v1 = z1 * sigmoid4(acc[ai][bj][m][1] + bv[bj][1]);
                    *(GAS u32x4*)(SO + off + bj * HALF) = pack8(v0, v1); } }
    }
};
template <int MODE> struct EpiPR {
    static constexpr bool PERM = true, AFTER_DRAIN = false, IDEMPOTENT = true;
    const bf16_t* P; const bf16_t* T1; bf16_t* O; unsigned* flags;
    __device__ __forceinline__ void operator()(const f32x4 (&acc)[2][2][4][2], const Unit& u, int wr, int wc, int fr, int fq) const {
        const int row0 = u.pm * BM + wr * 64 + fr, col0 = u.pn * BM + wc * 32 + 8 * fq;
        const bool samp = u.pm >= 32;
        GAS unsigned* flag = (GAS unsigned*)(flags + 64 * (u.pn * 4 + (u.pm & 3)));
        if (MODE == 1 && samp) {
            unsigned spins = 0u;
            while (__hip_atomic_load(flag, __ATOMIC_RELAXED, __HIP_MEMORY_SCOPE_AGENT) < 8u) { __builtin_amdgcn_s_sleep(2); if (++spins > (1u << 18)) break; }
            __builtin_amdgcn_fence(__ATOMIC_ACQUIRE, "agent"); asm volatile("s_waitcnt vmcnt(0)" ::: "memory");
        }
#pragma unroll
        for (int ai = 0; ai < 2; ++ai)
#pragma unroll
            for (int m = 0; m < 4; ++m) { const size_t r = (size_t)(row0 + ai * HALF + m * 16); const size_t off = r * 2048 + col0; const bf16_t* gp = P + r * NPJ + 2560 + MODE * 2048 + col0;
#pragma unroll
                for (int bj = 0; bj < 2; ++bj) { f32x4 g0, g1; unpack8(*(const GAS u32x4*)(gp + bj * HALF), g0, g1);
                    f32x4 v0 = g0 * acc[ai][bj][m][0], v1 = g1 * acc[ai][bj][m][1];
                    if (MODE == 1) { f32x4 t0, t1; unpack8(*(const GAS u32x4*)(T1 + off + bj * HALF), t0, t1); v0 += t0; v1 += t1; }
                    const u32x4 w = pack8(v0, v1);
                    if (MODE == 0 && samp) asm volatile("global_store_dwordx4 %0, %1, off sc1\n\ts_nop 1" :: "v"(O + off + bj * HALF), "v"(w) : "memory");
                    else *(GAS u32x4*)(O + off + bj * HALF) = w; } }
        if (MODE == 0 && samp) {
            asm volatile("s_waitcnt vmcnt(0)" ::: "memory");
            if (fr == 0 && fq == 0) __hip_atomic_fetch_add(flag, 1u, __ATOMIC_RELAXED, __HIP_MEMORY_SCOPE_AGENT);
        }
    }
};
struct EpiRes {
    static constexpr bool PERM = true, AFTER_DRAIN = false, IDEMPOTENT = false;
    bf16_t* XB; float* OUTF; const float* gmod; bf16_t* SL;
    __device__ __forceinline__ void operator()(const f32x4 (&acc)[2][2][4][2], const Unit& u, int wr, int wc, int fr, int fq) const {
        const int col0 = u.pn * BM + wc * 32 + 8 * fq;
        const bool part = u.slab >= 0;
#pragma unroll
        for (int ai = 0; ai < 2; ++ai) {
            const int rb = u.pm * BM + ai * HALF + wr * 64;
            const int cb = rb < 8192 ? (rb >> 11) : 4 + ((rb - 8192) >> 6);
            const float* g = gmod + (size_t)cb * 12288 + col0;
            f32x4 gv[2][2];
#pragma unroll
            for (int bj = 0; bj < 2; ++bj)
#pragma unroll
                for (int n = 0; n < 2; ++n) gv[bj][n] = *(const GAS f32x4*)(g + bj * HALF + 4 * n);
            if (part) { bf16_t* base = SL + ((size_t)u.slab * 1024 + (size_t)(rb - 8192 + fr)) * 2048 + col0;
#pragma unroll
                for (int m = 0; m < 4; ++m)
#pragma unroll
                    for (int bj = 0; bj < 2; ++bj) *(GAS u32x4*)(base + (size_t)(m * 16) * 2048 + bj * HALF) = pack8(gv[bj][0] * acc[ai][bj][m][0], gv[bj][1] * acc[ai][bj][m][1]);
            } else { const size_t o0 = (size_t)(rb + fr) * 2048 + col0;
#pragma unroll
                for (int m = 0; m < 4; ++m)
#pragma unroll
                    for (int bj = 0; bj < 2; ++bj) { const size_t o = o0 + (size_t)(m * 16) * 2048 + bj * HALF; f32x4 x0, x1; unpack8(*(const GAS u32x4*)(XB + o), x0, x1);
                        const f32x4 v0 = x0 + gv[bj][0] * acc[ai][bj][m][0], v1 = x1 + gv[bj][1] * acc[ai][bj][m][1];
                        if (OUTF != nullptr) { *(GAS f32x4*)(OUTF + o) = v0; *(GAS f32x4*)(OUTF + o + 4) = v1; } else *(GAS u32x4*)(XB + o) = pack8(v0, v1); }
            }
        }
    }
};
struct EpiFU {
    static constexpr bool PERM = true, AFTER_DRAIN = false, IDEMPOTENT = true;
    bf16_t* ACT;
    __device__ __forceinline__ void operator()(const f32x4 (&acc)[2][2][4][2], const Unit& u, int wr, int wc, int fr, int fq) const {
        const int row0 = u.pm * BM + wr * 64 + fr, col0 = u.pn * HALF + wc * 32 + 8 * fq;
#pragma unroll
        for (int ai = 0; ai < 2; ++ai)
#pragma unroll
            for (int m = 0; m < 4; ++m) {
                const f32x4 g0 = acc[ai][0][m][0], g1 = acc[ai][0][m][1];
                const f32x4 v0 = g0 * sigmoid4(g0) * acc[ai][1][m][0], v1 = g1 * sigmoid4(g1) * acc[ai][1][m][1];
                store16_wt(ACT + (size_t)(row0 + ai * HALF + m * 16) * 5632 + col0, pack8(v0, v1)); }
    }
};

template <class Epi, class Sched, bool ALIGN_EPI = false, bool SP2 = false>
__device__ __forceinline__ void gemm_phase(PG8_LAS unsigned char* lds, const Gemm g, const Sched& S, const Epi& E) {
    int tid_l = threadIdx.x; asm volatile("" : "+v"(tid_l));
    const int tid = tid_l, wid = __builtin_amdgcn_readfirstlane(tid >> 6), lane = tid & 63, wr = wid >> 2, wc = wid & 3, fr = lane & 15, fq = lane >> 4;
    const int K = g.K;
    unsigned voffA[2], voffB[2];
#pragma unroll
    for (int i = 0; i < 2; ++i) { int R, C; stage_rc(tid * 16 + i * 8192, R, C); const int Rb = Epi::PERM ? ((R & ~31) + perm32(R & 31)) : R;
        voffA[i] = (unsigned)(R * K + C) * 2u; voffB[i] = (unsigned)(Rb * K + C) * 2u; }
    const size_t kstep = (size_t)(BK * 2);
    const size_t hstep = (size_t)HALF * K * 2;
    const size_t tstep = 2 * hstep;
    const unsigned ldsw = (unsigned)wid * 1024u;
    const int aoff = lds_byte(wr * 64 + fr, fq * 8), boff = lds_byte(wc * 32 + fr, fq * 8);
#define PG8_SA(b, h) (((b) * 2 + (h)) * HTB)
#define PG8_SB(b, h) ((4 + (b) * 2 + (h)) * HTB)
#ifndef AUX_A
#define AUX_A 0
#endif
#ifndef AUX_B
#define AUX_B 0
#endif
#define PG8_STAGE(bufoff, gbase, voff) do { _Pragma("unroll") for (int _i = 0; _i < 2; ++_i) \
        __builtin_amdgcn_global_load_lds((const unsigned*)((const char*)(gbase) + (voff)[_i]), (PG8_LAS unsigned*)(lds + (bufoff) + ldsw + _i * 8192), 16, 0, AUX_A); } while (0)
#define PG8_STAGEB(bufoff, gbase, voff) do { _Pragma("unroll") for (int _i = 0; _i < 2; ++_i) \
        __builtin_amdgcn_global_load_lds((const unsigned*)((const char*)(gbase) + (voff)[_i]), (PG8_LAS unsigned*)(lds + (bufoff) + ldsw + _i * 8192), 16, 0, AUX_B); } while (0)
#define PG8_LDA(dst, b, h) do { _Pragma("unroll") for (int m = 0; m < 4; ++m) _Pragma("unroll") for (int k = 0; k < 2; ++k) dst[m][k] = *(const PG8_LAS bf16x8*)(lds + PG8_SA(b, h) + aoff + m * 2048 + k * 1024); } while (0)
#define PG8_LDB(dst, b, h) do { _Pragma("unroll") for (int n = 0; n < 2; ++n) _Pragma("unroll") for (int k = 0; k < 2; ++k) dst[n][k] = *(const PG8_LAS bf16x8*)(lds + PG8_SB(b, h) + boff + n * 2048 + k * 1024); } while (0)
#define PG8_MMA(ai, bj, At, Bt) do { __builtin_amdgcn_s_setprio(1); _Pragma("unroll") for (int m = 0; m < 4; ++m) _Pragma("unroll") for (int n = 0; n < 2; ++n) _Pragma("unroll") for (int k = 0; k < 2; ++k) \
        acc[ai][bj][m][n] = __builtin_amdgcn_mfma_f32_16x16x32_bf16(Bt[n][k], At[m][k], acc[ai][bj][m][n], 0, 0, 0); __builtin_amdgcn_s_setprio(0); } while (0)
#define PG8_WAIT_V(n) asm volatile("s_waitcnt vmcnt(" #n ")" ::: "memory")
#define PG8_WAIT_L(n) asm volatile("s_waitcnt lgkmcnt(" #n ")" ::: "memory")
#define PG8_BAR __builtin_amdgcn_s_barrier()
#define PG8_SCHED __builtin_amdgcn_sched_barrier(0)
    Unit cur, nxt; int ui = 0;
    if (!S.next(0, cur)) return;
    f32x4 acc[2][2][4][2];
#pragma unroll
    for (int a = 0; a < 2; ++a)
#pragma unroll
        for (int b = 0; b < 2; ++b)
#pragma unroll
            for (int m = 0; m < 4; ++m)
#pragma unroll
                for (int n = 0; n < 2; ++n) acc[a][b][m][n] = (f32x4){0.f, 0.f, 0.f, 0.f};
    bf16x8 At[4][2], B0[2][2], B1[2][2];
    const char* cA = (const char*)g.A + (size_t)cur.pm * tstep + (size_t)cur.kt0 * kstep; const char* cB = (const char*)g.Bt + (size_t)cur.pn * tstep + (size_t)cur.kt0 * kstep;
    S.a_ready(cur);
#define PG8_KP(base, p, rot_, nt_) ((base) + (size_t)((p) + (rot_) < (nt_) ? (p) + (rot_) : (p) + (rot_) - (nt_)) * kstep)
    { const int rot0 = cur.krot, nt0 = cur.nkt; const char* sA0 = PG8_KP(cA, 0, rot0, nt0); const char* sA1 = PG8_KP(cA, 1, rot0, nt0); const char* sB0 = PG8_KP(cB, 0, rot0, nt0); const char* sB1 = PG8_KP(cB, 1, rot0, nt0);
    if constexpr (SP2) {
        PG8_STAGEB(PG8_SB(0, 0), sB0, voffB); PG8_STAGEB(PG8_SB(0, 1), sB0 + hstep, voffB); PG8_STAGE(PG8_SA(0, 0), sA0, voffA); PG8_STAGE(PG8_SA(0, 1), sA0 + hstep, voffA);
        if (wr == 1) PG8_BAR;
        PG8_WAIT_V(2); PG8_BAR;
        PG8_STAGEB(PG8_SB(1, 0), sB1, voffB); PG8_STAGE(PG8_SA(1, 0), sA1, voffA); PG8_STAGEB(PG8_SB(1, 1), sB1 + hstep, voffB);
        PG8_WAIT_V(6); PG8_BAR;
    } else {
        PG8_STAGEB(PG8_SB(0, 0), sB0, voffB); PG8_STAGE(PG8_SA(0, 0), sA0, voffA); PG8_STAGEB(PG8_SB(0, 1), sB0 + hstep, voffB); PG8_STAGE(PG8_SA(0, 1), sA0 + hstep, voffA);
        if (wr == 1) PG8_BAR;
        PG8_WAIT_V(4); PG8_BAR;
        PG8_STAGEB(PG8_SB(1, 0), sB1, voffB); PG8_STAGE(PG8_SA(1, 0), sA1, voffA); PG8_STAGEB(PG8_SB(1, 1), sB1 + hstep, voffB);
        PG8_WAIT_V(6); PG8_BAR;
    }
    }
    for (;;) {
        const bool has_next = S.next(ui + 1, nxt);
        const char* nA = has_next ? (const char*)g.A + (size_t)nxt.pm * tstep + (size_t)nxt.kt0 * kstep : cA; const char* nB = has_next ? (const char*)g.Bt + (size_t)nxt.pn * tstep + (size_t)nxt.kt0 * kstep : cB;
        const int nt = cur.nkt, rot = cur.krot;
        const char* nAr = has_next ? nA + (size_t)nxt.krot * kstep : PG8_KP(cA, 0, rot, nt); const char* nBr = has_next ? nB + (size_t)nxt.krot * kstep : PG8_KP(cB, 0, rot, nt);
        for (int t = 0; t < nt; t += 2) {
            const bool last = (t == nt - 2);
            const char* a1 = PG8_KP(cA, t + 1, rot, nt);
            const char* a2 = last ? nAr : PG8_KP(cA, t + 2, rot, nt); const char* b2 = last ? nBr : PG8_KP(cB, t + 2, rot, nt);
            const char* a3 = a2 + kstep; const char* b3 = b2 + kstep;
            if (last && has_next) S.a_ready(nxt);
            if constexpr (SP2) {
            PG8_LDB(B0, 0, 0); PG8_LDB(B1, 0, 1); PG8_SCHED; PG8_LDA(At, 0, 0); PG8_STAGE(PG8_SA(1, 1), a1 + hstep, voffA);
            PG8_WAIT_V(8); PG8_WAIT_L(0); PG8_BAR; PG8_MMA(0, 0, At, B0); PG8_MMA(0, 1, At, B1); PG8_BAR; PG8_SCHED;
            PG8_LDA(At, 0, 1); PG8_STAGEB(PG8_SB(0, 0), b2, voffB); PG8_STAGEB(PG8_SB(0, 1), b2 + hstep, voffB); PG8_STAGE(PG8_SA(0, 0), a2, voffA);
            PG8_WAIT_V(8); PG8_WAIT_L(0); PG8_BAR; PG8_MMA(1, 0, At, B0); PG8_MMA(1, 1, At, B1); PG8_BAR; PG8_SCHED;
            PG8_LDB(B0, 1, 0); PG8_LDB(B1, 1, 1); PG8_SCHED; PG8_LDA(At, 1, 0); PG8_STAGE(PG8_SA(0, 1), a2 + hstep, voffA);
            PG8_WAIT_V(8); PG8_WAIT_L(0); PG8_BAR; PG8_MMA(0, 0, At, B0); PG8_MMA(0, 1, At, B1); PG8_BAR; PG8_SCHED;
            PG8_LDA(At, 1, 1); PG8_STAGEB(PG8_SB(1, 0), b3, voffB); PG8_STAGEB(PG8_SB(1, 1), b3 + hstep, voffB); PG8_STAGE(PG8_SA(1, 0), a3, voffA);
            PG8_WAIT_V(8); PG8_WAIT_L(0); PG8_BAR; PG8_MMA(1, 0, At, B0); PG8_MMA(1, 1, At, B1); PG8_BAR; PG8_SCHED;
            } else {
            PG8_LDB(B0, 0, 0); PG8_SCHED; PG8_LDA(At, 0, 0); PG8_STAGE(PG8_SA(1, 1), a1 + hstep, voffA);
            PG8_WAIT_L(8); PG8_BAR; PG8_WAIT_L(0); PG8_MMA(0, 0, At, B0); PG8_BAR; PG8_SCHED;
            PG8_LDB(B1, 0, 1); PG8_STAGEB(PG8_SB(0, 0), b2, voffB);
            PG8_BAR; PG8_WAIT_L(0); PG8_MMA(0, 1, At, B1); PG8_BAR;
            PG8_LDA(At, 0, 1); PG8_STAGE(PG8_SA(0, 0), a2, voffA);
            PG8_BAR; PG8_WAIT_L(0); PG8_MMA(1, 0, At, B0); PG8_BAR; PG8_SCHED;
            PG8_STAGEB(PG8_SB(0, 1), b2 + hstep, voffB);
            PG8_WAIT_V(6); PG8_BAR; PG8_MMA(1, 1, At, B1); PG8_BAR;
            PG8_LDB(B0, 1, 0); PG8_SCHED; PG8_LDA(At, 1, 0); PG8_STAGE(PG8_SA(0, 1), a2 + hstep, voffA);
            PG8_WAIT_L(8); PG8_BAR; PG8_WAIT_L(0); PG8_MMA(0, 0, At, B0); PG8_BAR; PG8_SCHED;
            PG8_LDB(B1, 1, 1); PG8_STAGEB(PG8_SB(1, 0), b3, voffB);
            PG8_BAR; PG8_WAIT_L(0); PG8_MMA(0, 1, At, B1); PG8_BAR;
            PG8_LDA(At, 1, 1); PG8_STAGE(PG8_SA(1, 0), a3, voffA);
            PG8_BAR; PG8_WAIT_L(0); PG8_MMA(1, 0, At, B0); PG8_BAR; PG8_SCHED;
            PG8_STAGEB(PG8_SB(1, 1), b3 + hstep, voffB);
            PG8_WAIT_V(6); PG8_BAR; PG8_MMA(1, 1, At, B1); PG8_BAR;
            }
        }
        if constexpr (ALIGN_EPI) { if (wr == 0) PG8_BAR; }
#ifndef PROBE_EPI
#define PROBE_EPI 0
#endif
        if constexpr (!Epi::AFTER_DRAIN) { E(acc, cur, wr, wc, fr, fq); if (PROBE_EPI && Epi::IDEMPOTENT) { asm volatile("" ::: "memory"); E(acc, cur, wr, wc, fr, fq); } S.done(cur); }
        if (!has_next) break;
#pragma unroll
        for (int a = 0; a < 2; ++a)
#pragma unroll
            for (int b = 0; b < 2; ++b)
#pragma unroll
                for (int m = 0; m < 4; ++m)
#pragma unroll
                    for (int n = 0; n < 2; ++n) acc[a][b][m][n] = (f32x4){0.f, 0.f, 0.f, 0.f};
        cur = nxt; cA = nA; cB = nB; ++ui;
        if constexpr (ALIGN_EPI) { if (wr == 1) PG8_BAR; }
    }
    PG8_WAIT_V(0);
    if constexpr (!ALIGN_EPI) { if (wr == 0) PG8_BAR; }
    PG8_BAR;
    if constexpr (Epi::AFTER_DRAIN) { E.fused(acc, cur, wr, wc, fr, fq, lds, wid, lane); S.done(cur); }
#undef PG8_KP
#undef PG8_SA
#undef PG8_SB
#undef PG8_STAGE
#undef PG8_STAGEB
#undef PG8_LDA
#undef PG8_LDB
#undef PG8_MMA
#undef PG8_WAIT_V
#undef PG8_WAIT_L
#undef PG8_BAR
#undef PG8_SCHED
}
}

#ifndef PG8_SP2
#define PG8_SP2 true
#endif
#ifndef PG8_ALIGN
#define PG8_ALIGN true
#endif
#ifndef BACKFILL
#define BACKFILL 1
#endif
#ifndef BF_G1_R0
#define BF_G1_R0 0
#define BF_G1_R1 7168
#endif
#ifndef BF_FU_R0
#define BF_FU_R0 16896
#define BF_FU_R1 28160
#endif
#ifndef MK_ONE_LAUNCH
#define MK_ONE_LAUNCH 1
#endif

constexpr int NWAVES = 8;
constexpr int DM = 2048, NTOK = 9216, TPR = 8192, NL = 4, NCB = 20, MODW = 12288, DFF = 5632, NPJ = pg8::NPJ;
constexpr int NPHASE = 2 + 10 * NL;
constexpr size_t O_Y = 0, O_PK = 18874368, O_PV = O_PK + 524288, O_PSR = O_PV + 524288, O_PSI = O_PSR + 65536, O_SK = O_PSI + 65536, O_SV = O_SK + 2097152, O_SSR = O_SV + 2097152, O_SSI = O_SSR + 262144, O_END = O_SSI + 262144;
static_assert(O_END == 24772608, "output map");
constexpr size_t MiB = 1u << 20;
constexpr size_t WS_CTL = 0, CTL_ZERO_BYTES = 64 * 1024;
constexpr size_t WS_MOD = 1 * MiB;
constexpr size_t WS_LAM = 5 * MiB;
constexpr size_t WS_BBAR = 6 * MiB;
constexpr size_t WS_CM = 7 * MiB;
constexpr size_t WS_ROPE = 8 * MiB;
constexpr size_t WS_W1 = 16 * MiB;
constexpr size_t SZ_W1 = (size_t)6656 * 2048 * 2;
constexpr size_t WS_WGLU = WS_W1 + NL * SZ_W1;
constexpr size_t SZ_WGLU = (size_t)1024 * 1024 * 2;
constexpr size_t WS_WPS = WS_WGLU + NL * SZ_WGLU;
constexpr size_t SZ_WP = (size_t)2048 * 1024 * 2;
constexpr size_t WS_WPA = WS_WPS + NL * SZ_WP;
constexpr size_t WS_WOUT = WS_WPA + NL * SZ_WP;
constexpr size_t SZ_WOUT = (size_t)2048 * 2048 * 2;
constexpr size_t WS_WGU = WS_WOUT + NL * SZ_WOUT;
constexpr size_t SZ_WGU = (size_t)11264 * 2048 * 2;
constexpr size_t WS_WDN = WS_WGU + NL * SZ_WGU;
constexpr size_t SZ_WDN = (size_t)2048 * 5632 * 2;
constexpr size_t WS_H = WS_WDN + NL * SZ_WDN;
constexpr size_t WS_P = WS_H + (size_t)NTOK * 2048 * 2;
constexpr size_t WS_QN = WS_P + (size_t)NTOK * NPJ * 2;
constexpr size_t WS_KN = WS_QN + (size_t)NTOK * 1024 * 2;
constexpr size_t WS_Z = WS_KN + (size_t)NTOK * 256 * 2;
constexpr size_t WS_SO = WS_Z + (size_t)NTOK * 1024 * 2;
constexpr size_t WS_AO = WS_SO + (size_t)NTOK * 1024 * 2;
constexpr size_t WS_T1 = WS_AO + (size_t)NTOK * 1024 * 2;
constexpr size_t WS_MX = WS_T1 + (size_t)NTOK * 2048 * 2;
constexpr size_t WS_ACT = WS_MX + (size_t)NTOK * 2048 * 2;
constexpr size_t WS_SL = WS_ACT + (size_t)NTOK * DFF * 2;
constexpr size_t WS_XB = WS_SL + (size_t)8 * 1024 * 2048 * 4;
constexpr size_t WS_END = WS_XB + (size_t)NTOK * 2048 * 2;
static_assert(WS_ROPE + 2112 * 16 * 4 <= WS_W1 && (WS_W1 % 256) == 0 && (WS_H % 256) == 0, "d_ws map");
constexpr int CW_BAR = 4096;

constexpr int RING_OFF = 0, RING_BYTES = 131072;
constexpr int LDSCTL_OFF = RING_BYTES, MISC_OFF = LDSCTL_OFF + 320;
constexpr int LDS_BYTES = 147456;
static_assert(MISC_OFF + 128 <= LDS_BYTES, "LDS map");

#define GAS __attribute__((address_space(1)))
#define LAS __attribute__((address_space(3)))
typedef unsigned short bf16;
typedef unsigned v4u __attribute__((ext_vector_type(4)));
typedef unsigned v2u __attribute__((ext_vector_type(2)));
typedef float f32x4 __attribute__((ext_vector_type(4)));
typedef float f32x2 __attribute__((ext_vector_type(2)));
typedef float f32x16 __attribute__((ext_vector_type(16)));
typedef short bf16x8 __attribute__((ext_vector_type(8)));
typedef GAS unsigned gu32;
#define RLX_AGENT __ATOMIC_RELAXED, __HIP_MEMORY_SCOPE_AGENT
#define LDS_WAIT() asm volatile("s_waitcnt lgkmcnt(0)" ::: "memory")
#define VM_WAIT() asm volatile("s_waitcnt vmcnt(0)" ::: "memory")
using pg8::cvt_pk_bf16; using pg8::bflo; using pg8::bfhi;
__device__ __forceinline__ unsigned f2bf(float f) { unsigned u = __builtin_bit_cast(unsigned, f); return (u + 0x7fffu + ((u >> 16) & 1u)) >> 16; }
__device__ __forceinline__ float bf2f(unsigned short b) { return __uint_as_float((unsigned)b << 16); }
__device__ __forceinline__ float wave_sum(float v) {
#pragma unroll
    for (int o = 1; o < 64; o <<= 1) v += __shfl_xor(v, o);
    return v;
}
#define XB_TMO      128
#define XB_XCNT(j)  (256  + 64 * (j))
#define XB_XSUB(j)  (1280 + 64 * (j))
#define XB_XGEN(j)  (2304 + 64 * (j))
#define XB_TOP      3328
#define XB_TOPGEN   3392
#define XCD_BAR_WORDS 3456
#define XB_SPIN_CAP (1u << 18)

__device__ __forceinline__ unsigned xb_ld(unsigned* p)              { return __hip_atomic_load(p, __ATOMIC_RELAXED, __HIP_MEMORY_SCOPE_AGENT); }
__device__ __forceinline__ unsigned xb_add(unsigned* p, unsigned v) { return __hip_atomic_fetch_add(p, v, __ATOMIC_RELAXED, __HIP_MEMORY_SCOPE_AGENT); }
__device__ __forceinline__ unsigned xb_xcc_id() { return (unsigned)__builtin_amdgcn_s_getreg((3 << 11) | 20) & 0xFu; }
#define XB_SPIN(cond, bar) do { unsigned _sp = 0; while (cond) { __builtin_amdgcn_s_sleep(1); \
    if ((++_sp & 255u) == 0u) { if (xb_ld(&(bar)[XB_TMO])) break; if (_sp > XB_SPIN_CAP) { atomicAdd(&(bar)[XB_TMO], 1u); break; } } } } while (0)

struct XcdBarrier {
    unsigned* bar; unsigned x;
    volatile LAS unsigned* st;
};

__device__ __forceinline__ XcdBarrier xcd_barrier_post(unsigned* bar, volatile LAS unsigned* st) {
    XcdBarrier b; b.bar = bar; b.x = xb_xcc_id(); b.st = st;
    if (threadIdx.x == 0) (void)xb_add(&bar[XB_XCNT(b.x)], 1u);
    return b;
}
__device__ __forceinline__ void xcd_barrier_complete(unsigned* bar, unsigned x, unsigned& nloc, unsigned& nx) {
    const unsigned G = gridDim.x * gridDim.y * gridDim.z;
    unsigned sum, cnt, mine, sp = 0u;
    for (;;) {
        sum = 0u; cnt = 0u; mine = 0u;
#pragma unroll
        for (unsigned j = 0; j < 16; ++j) { const unsigned c = xb_ld(&bar[XB_XCNT(j)]); sum += c; cnt += (c > 0u) ? 1u : 0u; mine = (j == x) ? c : mine; }
        if (sum == G) break;
        __builtin_amdgcn_s_sleep(1);
        if ((++sp & 255u) == 0u) { if (xb_ld(&bar[XB_TMO])) break; if (sp > XB_SPIN_CAP) { atomicAdd(&bar[XB_TMO], 1u); break; } }
    }
    nloc = mine > 0u ? mine : 1u; nx = cnt > 0u ? cnt : 1u;
}

__device__ __forceinline__ void xcd_barrier(const XcdBarrier& b) {
    asm volatile("s_waitcnt vmcnt(0)" ::: "memory");
    __syncthreads();
    if (threadIdx.x == 0) {
        unsigned* bar = b.bar;
        __builtin_amdgcn_s_waitcnt(0);
        unsigned nloc = b.st[0], nx = b.st[1];
        if (nloc == 0u) { xcd_barrier_complete(bar, b.x, nloc, nx); b.st[0] = nloc; b.st[1] = nx; }
        const unsigned old = xb_add(&bar[XB_XSUB(b.x)], 1u);
        const unsigned gen = old / nloc;
        if (old + 1u == (gen + 1u) * nloc) {
            __builtin_amdgcn_fence(__ATOMIC_RELEASE, "agent");
            asm volatile("s_waitcnt vmcnt(0)" ::: "memory");
            const unsigned og = xb_add(&bar[XB_TOP], 1u);
            const unsigned tg = og / nx;
            if (og + 1u == (tg + 1u) * nx) xb_add(&bar[XB_TOPGEN], 1u);
            else XB_SPIN(xb_ld(&bar[XB_TOPGEN]) == tg, bar);
            __builtin_amdgcn_fence(__ATOMIC_ACQUIRE, "agent");
            xb_add(&bar[XB_XGEN(b.x)], 1u);
            asm volatile("s_waitcnt vmcnt(0)" ::: "memory");
        } else {
            XB_SPIN(xb_ld(&bar[XB_XGEN(b.x)]) == gen, bar);
            __builtin_amdgcn_fence(__ATOMIC_ACQUIRE, "agent");
            asm volatile("s_waitcnt vmcnt(0)" ::: "memory");
        }
    }
    __syncthreads();
}

#ifndef NT_STREAM
#define NT_STREAM 1
#endif
__device__ __forceinline__ unsigned pk2(float lo, float hi) { return cvt_pk_bf16(lo, hi); }
struct ConvDesc { const float* src; bf16* dst; int N, K; };
__device__ __forceinline__ void conv_load(const ConvDesc& d, f32x4 (&v)[8]) {
#pragma unroll
    for (int i = 0; i < 8; ++i) v[i] = NT_STREAM ? __builtin_nontemporal_load((const GAS f32x4*)(d.src + (size_t)(8 * i) * d.N)) : *(const GAS f32x4*)(d.src + (size_t)(8 * i) * d.N);
}
__device__ __forceinline__ void conv_store(const ConvDesc& d, const f32x4 (&v)[8], LAS float* scr, int lane) {
    { const int kr = lane >> 3, n4 = lane & 7;
#pragma unroll
      for (int i = 0; i < 8; ++i) { LAS float* p = scr + (8 * i + kr) * 33 + 4 * n4; p[0] = v[i].x; p[1] = v[i].y; p[2] = v[i].z; p[3] = v[i].w; } }
    LDS_WAIT(); asm volatile("" ::: "memory");
    const int c = lane & 7;
#pragma unroll
    for (int j = 0; j < 4; ++j) { const int n = (lane >> 3) + 8 * j; const LAS float* s = scr + (8 * c) * 33 + n;
        v4u o; o.x = pk2(s[0 * 33], s[1 * 33]); o.y = pk2(s[2 * 33], s[3 * 33]); o.z = pk2(s[4 * 33], s[5 * 33]); o.w = pk2(s[6 * 33], s[7 * 33]);
        if (NT_STREAM) __builtin_nontemporal_store(o, (GAS v4u*)(d.dst + (size_t)n * d.K + 8 * c)); else *(GAS v4u*)(d.dst + (size_t)n * d.K + 8 * c) = o; }
    LDS_WAIT(); asm volatile("" ::: "memory");
}
__device__ __forceinline__ void sincos_d(double x, double& s, double& c) {
    const double k = rint(x * 0.63661977236758134308);
    double y = fma(-k, 1.57079632679489655800e+00, x); y = fma(-k, 6.12323399573676603587e-17, y);
    const double y2 = y * y;
    const double sp = y * (1.0 + y2 * (-1.0 / 6.0 + y2 * (1.0 / 120.0 + y2 * (-1.0 / 5040.0 + y2 * (1.0 / 362880.0 + y2 * (-1.0 / 39916800.0 + y2 * (1.0 / 6227020800.0)))))));
    const double cp = 1.0 + y2 * (-0.5 + y2 * (1.0 / 24.0 + y2 * (-1.0 / 720.0 + y2 * (1.0 / 40320.0 + y2 * (-1.0 / 3628800.0 + y2 * (1.0 / 479001600.0 + y2 * (-1.0 / 87178291200.0)))))));
    const int qd = ((int)k) & 3;
    s = (qd == 0) ? sp : (qd == 1) ? cp : (qd == 2) ? -sp : -cp;
    c = (qd == 0) ? cp : (qd == 1) ? -sp : (qd == 2) ? -cp : sp;
}
__device__ __forceinline__ int crow(int r, int hi) { return (r & 3) + 8 * (r >> 2) + 4 * hi; }
__device__ __forceinline__ bf16x8 mk_bf16x8(unsigned a, unsigned b, unsigned c, unsigned d) { v4u w; w.x = a; w.y = b; w.z = c; w.w = d; return __builtin_bit_cast(bf16x8, w); }

struct Args { const float* in[34]; float* out; unsigned char* ws; int ph_lo, ph_hi; };

__device__ __forceinline__ void p0_mod(LAS unsigned char* lds, int tid, int wid, int lane, int t_first, int t_end, int t_stride, const float* cp, const float* cs, const float* wmod, const float* bmod, float* MOD) {
    LAS float* red = (LAS float*)lds;
    const int q = lane & 31, hi = lane >> 5;
    LAS float* scr = (LAS float*)(lds + 32768 + wid * 8448);
    const int kr = lane >> 3, n4 = lane & 7;
    for (int task = t_first; task < t_end; task += t_stride) {
        const int l = task / 384, nb = task % 384;
        const float* wt = wmod + (size_t)l * 2048 * MODW + 32 * nb + 4 * n4;
        const float* csrc = q < 4 ? cp + q * 2048 : cs + (q < 20 ? (q - 4) : 0) * 2048;
        f32x16 acc;
#pragma unroll
        for (int r = 0; r < 16; ++r) acc[r] = 0.f;
        f32x4 vn[8];
#pragma unroll
        for (int i = 0; i < 8; ++i) vn[i] = __builtin_nontemporal_load((const f32x4*)(wt + (size_t)(256 * wid + 8 * i + kr) * MODW));
#pragma unroll 1
        for (int tt = 0; tt < 4; ++tt) {
            f32x4 vc[8];
#pragma unroll
            for (int i = 0; i < 8; ++i) vc[i] = vn[i];
            if (tt < 3) {
#pragma unroll
                for (int i = 0; i < 8; ++i) vn[i] = __builtin_nontemporal_load((const f32x4*)(wt + (size_t)(256 * wid + 64 * (tt + 1) + 8 * i + kr) * MODW)); }
#pragma unroll
            for (int i = 0; i < 8; ++i) { LAS float* p = scr + (8 * i + kr) * 33 + 4 * n4; p[0] = vc[i].x; p[1] = vc[i].y; p[2] = vc[i].z; p[3] = vc[i].w; }
            LDS_WAIT(); asm volatile("" ::: "memory");
#pragma unroll
            for (int ks = 0; ks < 4; ++ks) {
                const int k0 = 256 * wid + 64 * tt + 16 * ks + 8 * hi;
                f32x4 a0 = *(const f32x4*)(csrc + k0), a1 = *(const f32x4*)(csrc + k0 + 4);
                if (q >= 20) { a0 = (f32x4){0.f, 0.f, 0.f, 0.f}; a1 = a0; }
                float b[8];
#pragma unroll
                for (int jj = 0; jj < 8; ++jj) b[jj] = scr[(16 * ks + 8 * hi + jj) * 33 + q];
                const unsigned ah0 = cvt_pk_bf16(a0[0], a0[1]), ah1 = cvt_pk_bf16(a0[2], a0[3]), ah2 = cvt_pk_bf16(a1[0], a1[1]), ah3 = cvt_pk_bf16(a1[2], a1[3]);
                const unsigned al0 = cvt_pk_bf16(a0[0] - bflo(ah0), a0[1] - bfhi(ah0)), al1 = cvt_pk_bf16(a0[2] - bflo(ah1), a0[3] - bfhi(ah1)), al2 = cvt_pk_bf16(a1[0] - bflo(ah2), a1[1] - bfhi(ah2)), al3 = cvt_pk_bf16(a1[2] - bflo(ah3), a1[3] - bfhi(ah3));
                const unsigned bh0 = cvt_pk_bf16(b[0], b[1]), bh1 = cvt_pk_bf16(b[2], b[3]), bh2 = cvt_pk_bf16(b[4], b[5]), bh3 = cvt_pk_bf16(b[6], b[7]);
                const unsigned bl0 = cvt_pk_bf16(b[0] - bflo(bh0), b[1] - bfhi(bh0)), bl1 = cvt_pk_bf16(b[2] - bflo(bh1), b[3] - bfhi(bh1)), bl2 = cvt_pk_bf16(b[4] - bflo(bh2), b[5] - bfhi(bh2)), bl3 = cvt_pk_bf16(b[6] - bflo(bh3), b[7] - bfhi(bh3));
                const bf16x8 ah = mk_bf16x8(ah0, ah1, ah2, ah3), al = mk_bf16x8(al0, al1, al2, al3), bh = mk_bf16x8(bh0, bh1, bh2, bh3), bl = mk_bf16x8(bl0, bl1, bl2, bl3);
                acc = __builtin_amdgcn_mfma_f32_32x32x16_bf16(ah, bh, acc, 0, 0, 0);
                acc = __builtin_amdgcn_mfma_f32_32x32x16_bf16(ah, bl, acc, 0, 0, 0);
                acc = __builtin_amdgcn_mfma_f32_32x32x16_bf16(al, bh, acc, 0, 0, 0);
            }
            LDS_WAIT(); asm volatile("" ::: "memory");
        }
#pragma unroll
        for (int r = 0; r < 16; ++r) red[(wid * 32 + crow(r, hi)) * 32 + q] = acc[r];
        __syncthreads();
        for (int o = tid; o < 640; o += 512) { const int cb = o >> 5, n = o & 31; float s = bmod[l * MODW + 32 * nb + n];
#pragma unroll
            for (int w8 = 0; w8 < 8; ++w8) s += red[(w8 * 32 + cb) * 32 + n];
            ((GAS float*)MOD)[((size_t)l * NCB + cb) * MODW + 32 * nb + n] = s; }
        __syncthreads();
    }
}

constexpr int CONV_PER_L = 28160;
__device__ __forceinline__ ConvDesc conv_desc(const Args& A, unsigned char* ws, int l, int it, int lane) {
    int r = it;
    const float* W; int K, N; bf16* WT; int mode = 0;
    int rb0 = 0;
    if (r < 2560) { W = A.in[12] + (size_t)l * 2048 * 2560; K = 2048; N = 2560; WT = (bf16*)(ws + WS_W1 + l * SZ_W1); mode = 3; }
    else if ((r -= 2560) < 4096) { W = A.in[26] + (size_t)l * 2048 * 4096; K = 2048; N = 4096; WT = (bf16*)(ws + WS_W1 + l * SZ_W1); rb0 = 2560; }
    else if ((r -= 4096) < 512) { W = A.in[21] + (size_t)l * 1024 * 1024; K = 1024; N = 1024; WT = (bf16*)(ws + WS_WGLU + l * SZ_WGLU); }
    else if ((r -= 512) < 1024) { W = A.in[28] + (size_t)l * 1024 * 2048; K = 1024; N = 2048; WT = (bf16*)(ws + WS_WPS + l * SZ_WP); }
    else if ((r -= 1024) < 1024) { W = A.in[29] + (size_t)l * 1024 * 2048; K = 1024; N = 2048; WT = (bf16*)(ws + WS_WPA + l * SZ_WP); }
    else if ((r -= 1024) < 2048) { W = A.in[30] + (size_t)l * 2048 * 2048; K = 2048; N = 2048; WT = (bf16*)(ws + WS_WOUT + l * SZ_WOUT); }
    else if ((r -= 2048) < 5632) { W = A.in[31] + (size_t)l * 2048 * 5632; K = 2048; N = 5632; WT = (bf16*)(ws + WS_WGU + l * SZ_WGU); mode = 1; }
    else if ((r -= 5632) < 5632) { W = A.in[32] + (size_t)l * 2048 * 5632; K = 2048; N = 5632; WT = (bf16*)(ws + WS_WGU + l * SZ_WGU); mode = 2; }
    else { r -= 5632; W = A.in[33] + (size_t)l * 5632 * 2048; K = 5632; N = 2048; WT = (bf16*)(ws + WS_WDN + l * SZ_WDN); }
    const int nblk = N / 32, kb = r / nblk, nb = r % nblk, k0 = 64 * kb, n0 = 32 * nb;
    const int rowbase = mode == 0 ? rb0 + n0 : mode == 3 ? ((n0 >= 1024 && n0 < 2304) ? (n0 & ~255) + 128 * ((n0 >> 5) & 1) + 32 * ((n0 >> 6) & 3) : n0)
                                  : 256 * (n0 >> 7) + (n0 & 127) + (mode == 2 ? 128 : 0);
    ConvDesc d; d.src = W + (size_t)(k0 + (lane >> 3)) * N + n0 + 4 * (lane & 7); d.dst = WT + (size_t)rowbase * K + k0; d.N = N; d.K = K; return d;
}
__device__ __forceinline__ void conv_items(const Args& A, unsigned char* ws, LAS unsigned char* lds, int wid, int lane, int l, int r0, int r1, int pw, int npw) {
    LAS float* scr = (LAS float*)(lds + RING_OFF + wid * 16384);
    int it = r0 + pw; if (it >= r1) return;
    ConvDesc dn = conv_desc(A, ws, l, it, lane); f32x4 vn[8]; conv_load(dn, vn);
    for (;;) {
        const ConvDesc dc = dn; f32x4 vc[8];
#pragma unroll
        for (int i = 0; i < 8; ++i) vc[i] = vn[i];
        it += npw; const bool more = it < r1;
        if (more) { dn = conv_desc(A, ws, l, it, lane); conv_load(dn, vn); }
        conv_store(dc, vc, scr, lane);
        if (!more) break;
    }
}
__device__ __forceinline__ void backfill(const Args& A, unsigned char* ws, LAS unsigned char* lds, int tid, int wid, int lane, int G, int bx, int c0, int lm, int t0, int t1, int lc, int r0, int r1) {
    if (!BACKFILL) return;
    if (c0 >= G) c0 = 0;
    if (bx < c0) return;
    const int pc = bx - c0, npc = G - c0;
    if (lm < NL) p0_mod(lds, tid, wid, lane, lm * 384 + t0 + pc, lm * 384 + t1, npc, A.in[6], A.in[7], A.in[8], A.in[9], (float*)(ws + WS_MOD));
    if (lc < NL) conv_items(A, ws, lds, wid, lane, lc, r0, r1, pc * NWAVES + wid, npc * NWAVES);
    __syncthreads();
}
__device__ __forceinline__ void p0_prologue(const Args& A, LAS unsigned char* lds, int tid, int wid, int lane, int G, int bx) {
    unsigned char* ws = A.ws;
    const int gw = bx * NWAVES + wid, NGW = G * NWAVES;
    { const int N4 = NL * 16 * 64 * 256 / 4;
      for (int i = bx * 512 + tid; i < 2 * N4; i += G * 512) { const int kv = i >= N4, j = kv ? i - N4 : i; const int lb = j / 4096, w = j % 4096;
          const f32x4 v = *((const f32x4*)A.in[2 + kv] + (size_t)lb * 8192 + 4096 + w); *((f32x4*)(A.out + (kv ? O_SV : O_SK)) + (size_t)lb * 8192 + w) = v; } }
    { float* LAM = (float*)(ws + WS_LAM); bf16* BB = (bf16*)(ws + WS_BBAR); bf16* CM = (bf16*)(ws + WS_CM);
      for (int idx = bx * 512 + tid; idx < NL * 4096; idx += G * 512) {
          const int lg = idx >> 6, p = idx & 63;
          const double dt = exp((double)A.in[15][lg]);
          const double are = (double)A.in[13][idx], aim = (double)A.in[14][idx];
          const double zre = are * dt, zim = aim * dt, mag = exp(zre);
          double s, c; sincos_d(zim, s, c);
          const double lre = mag * c, lim = mag * s;
          const double mag64 = exp(64.0 * zre); double s64, c64; sincos_d(64.0 * zim, s64, c64);
          *(f32x4*)(LAM + (size_t)idx * 4) = (f32x4){(float)lre, (float)lim, (float)(mag64 * c64), (float)(mag64 * s64)};
          const double den = are * are + aim * aim, nre = lre - 1.0;
          const double fre = (nre * are + lim * aim) / den, fim = (lim * are - nre * aim) / den;
          const float* bre = A.in[16] + (size_t)idx * 16; const float* bim = A.in[17] + (size_t)idx * 16;
          bf16* b0 = BB + ((size_t)lg * 128 + 2 * p) * 16;
#pragma unroll
          for (int ch = 0; ch < 16; ++ch) { const double br = (double)bre[ch], bi = (double)bim[ch];
              b0[ch] = (bf16)f2bf((float)(fre * br - fim * bi)); b0[16 + ch] = (bf16)f2bf((float)(fre * bi + fim * br)); }
#pragma unroll
          for (int ch = 0; ch < 16; ++ch) { const size_t ci = ((size_t)lg * 16 + ch) * 64 + p; bf16* cd = CM + ((size_t)lg * 16 + ch) * 128 + 2 * p;
              cd[0] = (bf16)f2bf(A.in[18][ci]); cd[1] = (bf16)f2bf(-A.in[19][ci]); }
      } }
    { float* RT = (float*)(ws + WS_ROPE);
      for (int e = bx * 512 + tid; e < 2112 * 8; e += G * 512) { const int pos = e >> 3, i = e & 7;
          const double inv = exp(-((double)i / 8.0) * 13.122363377404328  ); double s, c; sincos_d((double)pos * inv, s, c);
          RT[pos * 16 + i] = (float)c; RT[pos * 16 + 8 + i] = (float)s; } }
    p0_mod(lds, tid, wid, lane, bx, (BACKFILL ? 1 : NL) * 384, G, A.in[6], A.in[7], A.in[8], A.in[9], (float*)(ws + WS_MOD));
    if (BACKFILL) { conv_items(A, ws, lds, wid, lane, 0, 0, 6656, gw, NGW); conv_items(A, ws, lds, wid, lane, 0, 11264, 15360, gw, NGW); }
    else for (int l = 0; l < NL; ++l) conv_items(A, ws, lds, wid, lane, l, 0, CONV_PER_L, gw, NGW);
}

__device__ __forceinline__ void norm_row(int row, int lane, bf16* XB, const float* xin_p, const float* xin_s, const bf16* SL, const float* gn, const float* modl, int sh_off, int sc_off, bf16* H) {
    const int cb = row < TPR ? (row >> 11) : 4 + ((row - TPR) >> 6);
    GAS v4u* xr = (GAS v4u*)(XB + (size_t)row * DM) + lane;
    f32x4 v[8]; float s = 0.f;
    bool wb = false;
    if (xin_p != nullptr) {
        const GAS f32x4* xi = (const GAS f32x4*)(row < TPR ? xin_p + (size_t)row * DM : xin_s + (size_t)(row - TPR) * DM) + 2 * lane;
#pragma unroll
        for (int j = 0; j < 4; ++j) { v[2 * j] = xi[128 * j]; v[2 * j + 1] = xi[128 * j + 1]; }
        wb = true;
    } else {
#pragma unroll
        for (int j = 0; j < 4; ++j) pg8::unpack8(xr[64 * j], v[2 * j], v[2 * j + 1]);
    }
    if (SL != nullptr && row >= TPR) {
        const GAS v4u* sp = (const GAS v4u*)(SL + (size_t)(row - TPR) * DM) + lane;
        v4u sr[8][4];
#pragma unroll
        for (int sl = 0; sl < 8; ++sl)
#pragma unroll
            for (int j = 0; j < 4; ++j) sr[sl][j] = sp[(size_t)sl * (1024 * DM / 8) + 64 * j];
#pragma unroll
        for (int sl = 0; sl < 8; ++sl)
#pragma unroll
            for (int j = 0; j < 4; ++j) { f32x4 a0, a1; pg8::unpack8(sr[sl][j], a0, a1); v[2 * j] = v[2 * j] + a0; v[2 * j + 1] = v[2 * j + 1] + a1; }
        wb = true;
    }
    if (wb) {
#pragma unroll
        for (int j = 0; j < 4; ++j) { const v4u w = pg8::pack8(v[2 * j], v[2 * j + 1]); xr[64 * j] = w; pg8::unpack8(w, v[2 * j], v[2 * j + 1]); }
    }
#pragma unroll
    for (int j = 0; j < 8; ++j) s += (v[j].x * v[j].x + v[j].y * v[j].y) + (v[j].z * v[j].z + v[j].w * v[j].w);
    const float rstd = 1.0f / sqrtf(wave_sum(s) * (1.0f / DM) + 1e-6f);
    const float* mrow = modl + (size_t)cb * MODW;
    GAS v4u* o16 = (GAS v4u*)(H + (size_t)row * DM) + lane;
#pragma unroll
    for (int j = 0; j < 4; ++j) { const int col = 8 * lane + 512 * j; f32x4 o[2];
#pragma unroll
        for (int h2 = 0; h2 < 2; ++h2) { const f32x4 g = *(const GAS f32x4*)(gn + col + 4 * h2), sc = *(const GAS f32x4*)(mrow + sc_off + col + 4 * h2), sh = *(const GAS f32x4*)(mrow + sh_off + col + 4 * h2);
            o[h2] = v[2 * j + h2] * rstd * g * (1.0f + sc) + sh; }
        o16[64 * j] = pg8::pack8(o[0], o[1]); }
}
__device__ __forceinline__ void norm_phase(int gw, int NGW, int lane, bf16* XB, const float* xin_p, const float* xin_s, const bf16* SL, const float* gn, const float* modl, int sh_off, int sc_off, bf16* H) {
    const bool xcd_deal = (NGW == 2048);
    const int bxw = gw >> 3, widw = gw & 7, xq = bxw & 7, jq = bxw >> 3;
    if (xcd_deal && xin_p == nullptr) {
        const int row0 = 1024 * xq + 32 * jq + 4 * widw, cb = row0 >> 11;
        v4u raw[4][4];
#pragma unroll
        for (int ri = 0; ri < 4; ++ri)
#pragma unroll
            for (int j = 0; j < 4; ++j) raw[ri][j] = ((const GAS v4u*)(XB + (size_t)(row0 + ri) * DM) + lane)[64 * j];
        const float* mrow = modl + (size_t)cb * MODW;
        f32x4 Am[8], Sh[8];
#pragma unroll
        for (int j = 0; j < 4; ++j)
#pragma unroll
            for (int h2 = 0; h2 < 2; ++h2) { const int col = 8 * lane + 512 * j + 4 * h2; const f32x4 g = *(const GAS f32x4*)(gn + col), sc = *(const GAS f32x4*)(mrow + sc_off + col); Sh[2 * j + h2] = *(const GAS f32x4*)(mrow + sh_off + col);
                Am[2 * j + h2] = g * (1.0f + sc); }
#pragma unroll
        for (int ri = 0; ri < 4; ++ri) {
            f32x4 v[8]; float s = 0.f;
#pragma unroll
            for (int j = 0; j < 4; ++j) pg8::unpack8(raw[ri][j], v[2 * j], v[2 * j + 1]);
#pragma unroll
            for (int j = 0; j < 8; ++j) s += (v[j].x * v[j].x + v[j].y * v[j].y) + (v[j].z * v[j].z + v[j].w * v[j].w);
            const float rstd = 1.0f / sqrtf(wave_sum(s) * (1.0f / DM) + 1e-6f);
            GAS v4u* o16 = (GAS v4u*)(H + (size_t)(row0 + ri) * DM) + lane;
#pragma unroll
            for (int j = 0; j < 4; ++j) o16[64 * j] = pg8::pack8(v[2 * j] * rstd * Am[2 * j] + Sh[2 * j], v[2 * j + 1] * rstd * Am[2 * j + 1] + Sh[2 * j + 1]);
        }
        if (widw < 4) norm_row(TPR + 4 * bxw + widw, lane, XB, xin_p, xin_s, SL, gn, modl, sh_off, sc_off, H);
        return;
    }
    const int nrows = xcd_deal ? (widw < 4 ? 5 : 4) : (NTOK - gw + NGW - 1) / NGW;
    for (int ri = 0; ri < nrows; ++ri) {
        const int row = xcd_deal ? (ri < 4 ? 1024 * xq + 32 * jq + 4 * widw + ri : TPR + 4 * bxw + widw) : gw + ri * NGW;
        norm_row(row, lane, XB, xin_p, xin_s, SL, gn, modl, sh_off, sc_off, H);
    }
}
__device__ __forceinline__ void final_phase(int gw, int NGW, int lane, float* X, const bf16* XB, const bf16* SL) {
    for (int row = TPR + gw; row < NTOK; row += NGW) {
        GAS f32x4* xo = (GAS f32x4*)(X + (size_t)row * DM) + 2 * lane; const GAS v4u* xr = (const GAS v4u*)(XB + (size_t)row * DM) + lane; const GAS v4u* sp = (const GAS v4u*)(SL + (size_t)(row - TPR) * DM) + lane;
        f32x4 v[8];
#pragma unroll
        for (int j = 0; j < 4; ++j) pg8::unpack8(xr[64 * j], v[2 * j], v[2 * j + 1]);
        v4u sr[8][4];
#pragma unroll
        for (int sl = 0; sl < 8; ++sl)
#pragma unroll
            for (int j = 0; j < 4; ++j) sr[sl][j] = sp[(size_t)sl * (1024 * DM / 8) + 64 * j];
#pragma unroll
        for (int sl = 0; sl < 8; ++sl)
#pragma unroll
            for (int j = 0; j < 4; ++j) { f32x4 a0, a1; pg8::unpack8(sr[sl][j], a0, a1); v[2 * j] = v[2 * j] + a0; v[2 * j + 1] = v[2 * j + 1] + a1; }
#pragma unroll
        for (int j = 0; j < 4; ++j) { xo[128 * j] = v[2 * j]; xo[128 * j + 1] = v[2 * j + 1]; }
    }
}

constexpr int SSM_ROWB = 528;
constexpr int SSM_WSCR = 16 * SSM_ROWB;
template <bool FULL>
__device__ __forceinline__ void ssm_subblock(LAS unsigned char* sb, int lane, bf16x8 uf, const bf16x8 (&af)[8], const bf16x8 (&cf)[4], float lre, float lim, float& hre, float& him,
                                             f32x4 dsk, v2u uraw, bf16* zdst, bool dost = true) {
    const int tok = lane & 15, q = lane >> 4;
#pragma unroll
    for (int nt = 0; nt < 8; ++nt) { const f32x4 d = __builtin_amdgcn_mfma_f32_16x16x32_bf16(af[nt], uf, (f32x4){0.f, 0.f, 0.f, 0.f}, 0, 0, 0);
        *(LAS f32x4*)(sb + tok * SSM_ROWB + nt * 64 + q * 16) = d; }
    f32x2 bu[16]; unsigned hp[16];
#pragma unroll
    for (int t = 0; t < 16; ++t) bu[t] = *(const LAS f32x2*)(sb + t * SSM_ROWB + 8 * lane);
    f32x2 hv = (f32x2){hre, him}; const f32x2 Lp = (f32x2){lre, lim};
#pragma unroll
    for (int t = 0; t < 16; ++t) {
        f32x2 tt;
        asm("v_pk_fma_f32 %0, %1, %2, %3 op_sel:[1,1,0] op_sel_hi:[1,0,1] neg_lo:[1,0,0]" : "=v"(tt) : "v"(Lp), "v"(hv), "v"(bu[t]));
        asm("v_pk_fma_f32 %0, %1, %2, %3 op_sel:[0,0,0] op_sel_hi:[0,1,1]" : "=v"(hv) : "v"(Lp), "v"(hv), "v"(tt));
        if (FULL) hp[t] = cvt_pk_bf16(hv.x, hv.y); }
    hre = hv.x; him = hv.y;
    if (FULL) {
#pragma unroll
        for (int t = 0; t < 16; ++t) *(LAS unsigned*)(sb + t * SSM_ROWB + 4 * lane) = hp[t]; }
    if (FULL) {
        f32x4 y = (f32x4){0.f, 0.f, 0.f, 0.f};
#pragma unroll
        for (int ks = 0; ks < 4; ++ks) { const bf16x8 hf = *(const LAS bf16x8*)(sb + tok * SSM_ROWB + ks * 64 + q * 16); y = __builtin_amdgcn_mfma_f32_16x16x32_bf16(cf[ks], hf, y, 0, 0, 0); }
        const f32x4 uv = (f32x4){bflo(uraw.x), bfhi(uraw.x), bflo(uraw.y), bfhi(uraw.y)};
        y = y + dsk * uv;
        f32x4 z;
#pragma unroll
        for (int i = 0; i < 4; i += 2) {
            const f32x2 v = (f32x2){y[i], y[i + 1]};
            const f32x2 k2 = (v * v * 0.044715f + 1.0f) * v * (-1.5957691216057308f * 1.4426950408889634f);
            f32x2 e; e.x = __builtin_amdgcn_exp2f(k2.x); e.y = __builtin_amdgcn_exp2f(k2.y);
            const f32x2 d = e + 1.0f; f32x2 r; r.x = __builtin_amdgcn_rcpf(d.x); r.y = __builtin_amdgcn_rcpf(d.y);
            const f32x2 zz = v * r; z[i] = zz.x; z[i + 1] = zz.y; }
        v2u w; w.x = cvt_pk_bf16(z[0], z[1]); w.y = cvt_pk_bf16(z[2], z[3]); if (dost) *(GAS v2u*)zdst = w;
    }
}
template <bool FULL>
__device__ __forceinline__ void ssm_chunk(LAS unsigned char* sb, int lane, const bf16x8 (&uc)[4], const v2u (&ur)[4], const bf16x8 (&af)[8], const bf16x8 (&cf)[4], float lre, float lim, float& hre, float& him,
                                          f32x4 dsk, bf16* Z, size_t row0, int g, bool dost = true) {
    const int tok = lane & 15, q = lane >> 4;
#pragma unroll
    for (int s = 0; s < 4; ++s) ssm_subblock<FULL>(sb, lane, uc[s], af, cf, lre, lim, hre, him, dsk, ur[s], Z + (row0 + 16 * s + tok) * 1024 + 16 * g + 4 * q, dost);
}
__device__ __forceinline__ void ssm_load_u(const bf16* P, size_t row0, int g, int lane, bf16x8 (&u)[4], v2u (&ur)[4], bool full) {
    const int tok = lane & 15, q = lane >> 4;
#pragma unroll
    for (int s = 0; s < 4; ++s) { const bf16* rp = P + (row0 + 16 * s + tok) * NPJ + 16 * g;
        u[s] = q < 2 ? *(const GAS bf16x8*)(rp + 8 * q) : mk_bf16x8(0u, 0u, 0u, 0u);
        ur[s] = full ? *(const GAS v2u*)(rp + 4 * q) : (v2u){0u, 0u}; }
}
__device__ __forceinline__ void ssm_phase(LAS unsigned char* lds, int tid, int wid, int lane, int G, int bx, int l, const Args& A, const bf16* P, bf16* Z) {
    LAS unsigned char* sb = lds + wid * SSM_WSCR;
    LAS f32x2* Sloc = (LAS f32x2*)(lds + 8 * SSM_WSCR);
    const unsigned char* ws = A.ws;
    const int i16 = lane & 15, kb = lane >> 4;
    const int vcu = (G == 256) ? ((bx & 7) >> 1) * 64 + (bx & 1) * 32 + (bx >> 3) : bx;
    for (int unit = vcu; unit < 256; unit += G) {
        const int b = unit >> 6, g = unit & 63, lg = l * 64 + g;
        bf16x8 af[8], cf[4];
        { const bf16* BB = (const bf16*)(ws + WS_BBAR) + (size_t)lg * 128 * 16; const bf16* CM = (const bf16*)(ws + WS_CM) + (size_t)lg * 16 * 128;
#pragma unroll
          for (int nt = 0; nt < 8; ++nt) af[nt] = kb < 2 ? *(const bf16x8*)(BB + (16 * nt + i16) * 16 + 8 * kb) : mk_bf16x8(0u, 0u, 0u, 0u);
#pragma unroll
          for (int ks = 0; ks < 4; ++ks) cf[ks] = *(const bf16x8*)(CM + i16 * 128 + 32 * ks + 8 * kb); }
        const f32x4 lam = *(const f32x4*)((const float*)(ws + WS_LAM) + ((size_t)lg * 64 + lane) * 4);
        const f32x4 dsk = *(const f32x4*)(A.in[20] + (size_t)l * 1024 + 16 * g + 4 * kb);
        const size_t rowb = (size_t)b * 2048 + (size_t)wid * 256;
#ifndef PROBE_SSM
#define PROBE_SSM 0
#endif
        for (int rp1 = 0; rp1 < (PROBE_SSM == 3 ? 2 : 1); ++rp1)
        { bf16x8 un[4]; v2u rn[4]; ssm_load_u(P, rowb, g, lane, un, rn, false);
#pragma unroll 1
          for (int ci = 0; ci < 4; ++ci) { bf16x8 uc[4]; v2u rc[4];
#pragma unroll
              for (int s = 0; s < 4; ++s) { uc[s] = un[s]; rc[s] = rn[s]; }
              if (ci < 3) ssm_load_u(P, rowb + 64 * (ci + 1), g, lane, un, rn, false);
              float hre = 0.f, him = 0.f;
              for (int rp2 = 0; rp2 < (PROBE_SSM == 4 ? 2 : 1); ++rp2) { hre = 0.f; him = 0.f; asm volatile("" : "+v"(hre), "+v"(him));
              ssm_chunk<false>(sb, lane, uc, rc, af, cf, lam.x, lam.y, hre, him, dsk, Z, rowb + 64 * ci, g); }
              Sloc[(4 * wid + ci) * 64 + lane] = (f32x2){hre, him}; } }
        bf16x8 un[4]; v2u rn[4]; ssm_load_u(P, rowb, g, lane, un, rn, true);
        const int sbt = 4 * b + (wid & 3); const size_t so = ((size_t)(l * 16 + sbt) * 64 + g) * 64 + lane; const size_t srow0 = (size_t)TPR + (size_t)sbt * 64;
        bf16x8 us[4]; v2u rs[4]; float sre = 0.f, sim = 0.f;
        if (wid < 4) { ssm_load_u(P, srow0, g, lane, us, rs, true); sre = *(const GAS float*)(A.in[4] + so); sim = *(const GAS float*)(A.in[5] + so); }
        else {
#pragma unroll
            for (int s = 0; s < 4; ++s) { us[s] = mk_bf16x8(0u, 0u, 0u, 0u); rs[s] = (v2u){0u, 0u}; } }
        __syncthreads();
        float hre = 0.f, him = 0.f;
#pragma unroll 4
        for (int c = 0; c < 4 * wid; ++c) { const f32x2 s = Sloc[c * 64 + lane]; const float nre = lam.z * hre - lam.w * him + s.x, nim = lam.z * him + lam.w * hre + s.y; hre = nre; him = nim; }
        {
#pragma unroll 1
          for (int ci = 0; ci < 4; ++ci) { bf16x8 uc[4]; v2u rc[4];
#pragma unroll
              for (int s = 0; s < 4; ++s) { uc[s] = un[s]; rc[s] = rn[s]; }
              if (ci < 3) ssm_load_u(P, rowb + 64 * (ci + 1), g, lane, un, rn, true);
              ssm_chunk<true>(sb, lane, uc, rc, af, cf, lam.x, lam.y, hre, him, dsk, Z, rowb + 64 * ci, g); } }
        if (wid == 7) { const size_t o = ((size_t)(l * 4 + b) * 64 + g) * 64 + lane; A.out[O_PSR + o] = hre; A.out[O_PSI + o] = him; }
        if (wid < 4) {
            ssm_chunk<true>(sb, lane, us, rs, af, cf, lam.x, lam.y, sre, sim, dsk, Z, srow0, g);
            A.out[O_SSR + so] = sre; A.out[O_SSI + so] = sim; }
        __syncthreads();
    }
}

constexpr int AT_KROW = 144, AT_VROW = 392, AT_K = 0, AT_V = 27648, AT_O = 53248, AT_OW = 4608;
__device__ __forceinline__ void attn_unit(LAS unsigned char* lds, int tid, int wid, int lane, int cbk, int hk, const bf16* P, const bf16* QN, const bf16* KN, const float* ck_l, const float* cv_l, const float* sink_l, bf16* AO) {
    LAS unsigned char* Kl = lds + AT_K; LAS unsigned char* Vt = lds + AT_V; LAS unsigned char* Os = lds + AT_O + wid * AT_OW;
    const bool smp = cbk >= 128; const int c = cbk & 31;
    const int kt0 = smp ? 0 : (c >= 2 ? 0 : (c == 1 ? 2 : 4));
    const int q = lane & 31, hi = lane >> 5, rr = wid >> 1, tok0 = 32 * (wid & 1), h = 4 * hk + rr;
    const size_t qrow = (size_t)cbk * 64 + tok0 + q;
    bf16x8 qr[4];
#pragma unroll
    for (int d0 = 0; d0 < 4; ++d0) qr[d0] = *(const GAS bf16x8*)(QN + qrow * 1024 + h * 64 + 16 * d0 + 8 * hi);
    const float sink_h = *(const GAS float*)(sink_l + h);
#pragma unroll
    for (int j = 0; j < 3; ++j) { const int ci = tid + 512 * j, kk = ci >> 3, c8 = ci & 7; v4u kw, vw;
        if (kk < 32 * kt0) { kw = (v4u){0u, 0u, 0u, 0u}; vw = kw; }
        else if (smp && kk < 128) { const size_t so = (((size_t)(cbk - 128) * 128 + kk) * 4 + hk) * 64 + 8 * c8;
            kw = pg8::pack8(*(const f32x4*)(ck_l + so), *(const f32x4*)(ck_l + so + 4)); vw = pg8::pack8(*(const f32x4*)(cv_l + so), *(const f32x4*)(cv_l + so + 4)); }
        else { const size_t grow = (size_t)((cbk - 2) * 64 + kk); kw = *(const GAS v4u*)(KN + grow * 256 + hk * 64 + 8 * c8); vw = *(const GAS v4u*)(P + grow * NPJ + 2304 + hk * 64 + 8 * c8); }
        *(LAS v4u*)(Kl + kk * AT_KROW + 16 * c8) = kw;
        LAS unsigned char* vp = Vt + (8 * c8) * AT_VROW + 2 * kk;
        *(LAS unsigned short*)(vp + 0 * AT_VROW) = (unsigned short)(vw.x & 0xffffu); *(LAS unsigned short*)(vp + 1 * AT_VROW) = (unsigned short)(vw.x >> 16);
        *(LAS unsigned short*)(vp + 2 * AT_VROW) = (unsigned short)(vw.y & 0xffffu); *(LAS unsigned short*)(vp + 3 * AT_VROW) = (unsigned short)(vw.y >> 16);
        *(LAS unsigned short*)(vp + 4 * AT_VROW) = (unsigned short)(vw.z & 0xffffu); *(LAS unsigned short*)(vp + 5 * AT_VROW) = (unsigned short)(vw.z >> 16);
        *(LAS unsigned short*)(vp + 6 * AT_VROW) = (unsigned short)(vw.w & 0xffffu); *(LAS unsigned short*)(vp + 7 * AT_VROW) = (unsigned short)(vw.w >> 16); }
    __syncthreads();
    f32x16 p[6];
#pragma unroll
    for (int T = 0; T < 6; ++T) {
#pragma unroll
        for (int r = 0; r < 16; ++r) p[T][r] = 0.f;
#pragma unroll
        for (int d0 = 0; d0 < 4; ++d0) { const bf16x8 kf = *(const LAS bf16x8*)(Kl + (32 * T + q) * AT_KROW + (16 * d0 + 8 * hi) * 2); p[T] = __builtin_amdgcn_mfma_f32_32x32x16_bf16(kf, qr[d0], p[T], 0, 0, 0); } }
    const float SC = 0.125f * 1.4426950408889634f, sk2 = sink_h * 1.4426950408889634f;
    float mr = -3.0e38f;
#pragma unroll
    for (int T = 0; T < 6; ++T) if (T >= kt0) {
#pragma unroll
        for (int r = 0; r < 16; r += 2) mr = __builtin_fmaxf(__builtin_fmaxf(mr, p[T][r]), p[T][r + 1]); }
    mr = fmaxf(mr, __shfl_xor(mr, 32));
    const float m = fmaxf(mr * SC, sk2), nm = -m;
    float sum = 0.f;
#pragma unroll
    for (int T = 0; T < 6; ++T) {
        if (T >= kt0) {
#pragma unroll
            for (int r = 0; r < 16; ++r) { const float e = __builtin_amdgcn_exp2f(__builtin_fmaf(p[T][r], SC, nm)); p[T][r] = e; sum += e; }
        } else {
#pragma unroll
            for (int r = 0; r < 16; ++r) p[T][r] = 0.f;
        } }
    sum += __shfl_xor(sum, 32);
    const float inv = 1.0f / (sum + __builtin_amdgcn_exp2f(sk2 - m));
    f32x16 o[2];
#pragma unroll
    for (int r = 0; r < 16; ++r) { o[0][r] = 0.f; o[1][r] = 0.f; }
#pragma unroll
    for (int T = 0; T < 6; ++T)
#pragma unroll
        for (int s = 0; s < 2; ++s) {
            const bf16x8 pa = mk_bf16x8(cvt_pk_bf16(p[T][8 * s + 0], p[T][8 * s + 1]), cvt_pk_bf16(p[T][8 * s + 2], p[T][8 * s + 3]), cvt_pk_bf16(p[T][8 * s + 4], p[T][8 * s + 5]), cvt_pk_bf16(p[T][8 * s + 6], p[T][8 * s + 7]));
#pragma unroll
            for (int dt = 0; dt < 2; ++dt) { const LAS unsigned char* vp = Vt + (32 * dt + q) * AT_VROW + 2 * (32 * T + 16 * s + 4 * hi);
                const v2u lo = *(const LAS v2u*)vp, hh = *(const LAS v2u*)(vp + 16);
                o[dt] = __builtin_amdgcn_mfma_f32_32x32x16_bf16(pa, mk_bf16x8(lo.x, lo.y, hh.x, hh.y), o[dt], 0, 0, 0); } }
#pragma unroll
    for (int r = 0; r < 16; ++r) { const int qq = crow(r, hi); const float iv = __shfl(inv, qq);
        *(LAS unsigned short*)(Os + qq * 144 + 2 * q) = (unsigned short)f2bf(o[0][r] * iv);
        *(LAS unsigned short*)(Os + qq * 144 + 2 * (32 + q)) = (unsigned short)f2bf(o[1][r] * iv); }
#pragma unroll
    for (int j = 0; j < 4; ++j) { const int qq = (lane >> 3) + 8 * j, c8 = lane & 7;
        const v4u w = *(const LAS v4u*)(Os + qq * 144 + 16 * c8);
        *(GAS v4u*)(AO + ((size_t)cbk * 64 + tok0 + qq) * 1024 + h * 64 + 8 * c8) = w; }
    __syncthreads();
}

__global__ void __launch_bounds__(NWAVES * 64, 2) enc_fwd(Args args) {
    extern __shared__ __attribute__((aligned(16))) unsigned char lds_raw[];
    LAS unsigned char* lds = (LAS unsigned char*)lds_raw;
    volatile LAS unsigned* MISC = (volatile LAS unsigned*)(lds + MISC_OFF);
    const int wid = __builtin_amdgcn_readfirstlane((int)threadIdx.x >> 6);
    const int G = gridDim.x, bx = blockIdx.x;
    const int gw = bx * NWAVES + wid, NGW = G * NWAVES;
#define MODL ((const float*)(ws + WS_MOD) + (size_t)l * NCB * MODW)
#define FRESH_LANE() int tid_f = threadIdx.x; asm volatile("" : "+v"(tid_f)); const int tid = tid_f, lane = tid & 63; (void)tid; (void)lane
    unsigned char* ws0 = args.ws;
    for (int u = threadIdx.x; u < (LDS_BYTES - LDSCTL_OFF) / 4; u += NWAVES * 64) ((LAS unsigned*)(lds + LDSCTL_OFF))[u] = 0u;
    __syncthreads();
    XcdBarrier bar; bar.bar = (unsigned*)(ws0 + WS_CTL) + CW_BAR; bar.x = 0; bar.st = nullptr;
    if (MK_ONE_LAUNCH) bar = xcd_barrier_post((unsigned*)(ws0 + WS_CTL) + CW_BAR, MISC + 8);
    const int lo = args.ph_lo, hi = args.ph_hi;
#ifndef DISABLE
#define DISABLE 0
#endif
#define IN(k) (lo <= (k) && (k) < hi)
#define EN(i) (((DISABLE >> (i)) & 1) == 0)
#ifndef PROBE_REP
#define PROBE_REP 0
#endif
#ifndef PROBE_L
#define PROBE_L -1
#endif
#define NREP(i) ((((PROBE_REP >> (i)) & 1) && ((i) == 0 || PROBE_L < 0 || l == PROBE_L)) ? 2 : 1)
#ifndef PROBE_BAR
#define PROBE_BAR 1
#endif
#define SEAM(k) do { if (IN((k) + 1)) { for (int nb_ = 0; nb_ < PROBE_BAR; ++nb_) xcd_barrier(bar); } } while (0)
#define H   ((bf16*)(ws + WS_H))
#define P   ((bf16*)(ws + WS_P))
#define QN  ((bf16*)(ws + WS_QN))
#define KN  ((bf16*)(ws + WS_KN))
#define Z   ((bf16*)(ws + WS_Z))
#define SO  ((bf16*)(ws + WS_SO))
#define AO  ((bf16*)(ws + WS_AO))
#define T1  ((bf16*)(ws + WS_T1))
#define MX  ((bf16*)(ws + WS_MX))
#define ACT ((bf16*)(ws + WS_ACT))
#define X   (args.out + O_Y)
#define XB  ((bf16*)(ws + WS_XB))
#define SL  ((bf16*)(ws + WS_SL))
#define FRESH_WS() unsigned char* ws = args.ws; asm volatile("" : "+s"(ws))

#ifndef MOD_SPLIT
#define MOD_SPLIT 112
#endif
#ifndef PROBE_ALL
#define PROBE_ALL 1
#endif
#pragma unroll 1
    for (int pass_ = 0; pass_ < PROBE_ALL; ++pass_) {
    if (EN(0) && IN(0)) { const int l = 0; (void)l; for (int rep = 0; rep < NREP(0); ++rep) { FRESH_LANE(); p0_prologue(args, lds, tid, wid, lane, G, bx); } SEAM(0); }

#pragma unroll 1
    for (int l = 0; l < NL; ++l) {
        const int pb = 1 + 10 * l;
        if (EN(1) && IN(pb + 0)) { for (int rep = 0; rep < NREP(1); ++rep) { FRESH_WS(); FRESH_LANE(); norm_phase(gw, NGW, lane, XB, l == 0 ? args.in[0] : nullptr, args.in[1], l > 0 ? SL : nullptr, args.in[10] + (size_t)l * DM, MODL, 0, 2048, H); } SEAM(pb + 0); }
        if (EN(2) && IN(pb + 1)) { for (int rep = 0; rep < NREP(2); ++rep) { FRESH_WS(); pg8::Gemm g{H, (const bf16*)(ws + WS_W1 + l * SZ_W1), NTOK, 6656, 2048}; pg8::StaticOrder S; S.init(NTOK, 6656, 2048, G, bx);
            pg8::EpiG1 E{P, args.in[27] + (size_t)l * 4096, QN, KN, args.in[23] + l * 64, args.in[24] + l * 64, (const float*)(ws + WS_ROPE), args.out, l, O_PK, O_PV, O_SK, O_SV};
            pg8::gemm_phase<pg8::EpiG1, pg8::StaticOrder, PG8_ALIGN, PG8_SP2>(lds + RING_OFF, g, S, E);
            { FRESH_LANE(); backfill(args, ws, lds, tid, wid, lane, G, bx, 936 - ((936 - 1) / G) * G, l + 1, MOD_SPLIT, 192, l, 6656, 11264); backfill(args, ws, lds, tid, wid, lane, G, bx, 936 - ((936 - 1) / G) * G, NL, 0, 0, l, 15360, 16896); } } SEAM(pb + 1); }
        if (EN(4) && IN(pb + 3)) { for (int rep = 0; rep < NREP(4); ++rep) { FRESH_WS();
#ifndef ATT_IN_GLU
#define ATT_IN_GLU 1
#endif
#ifndef PROBE_SA
#define PROBE_SA 0
#endif
            for (int r2 = 0; r2 < (PROBE_SA == 1 ? 2 : 1); ++r2) { FRESH_LANE(); ssm_phase(lds, tid, wid, lane, G, bx, l, args, P, Z); }
            if (!(ATT_IN_GLU && G == 256)) { FRESH_LANE();
            for (int ai_ = 0; ai_ < 3; ++ai_) { int a = bx + ai_ * G; if (a >= 576) break;
                attn_unit(lds, tid, wid, lane, a >> 2, a & 3, P, QN, KN, args.in[2] + (size_t)l * 16 * 128 * 256, args.in[3] + (size_t)l * 16 * 128 * 256, args.in[25] + l * 16, AO); } }
            } SEAM(pb + 3); }
        if (EN(5) && IN(pb + 4)) { for (int rep = 0; rep < NREP(5); ++rep) { FRESH_WS(); pg8::Gemm g{Z, (const bf16*)(ws + WS_WGLU + l * SZ_WGLU), NTOK, 1024, 1024}; pg8::PanelOrder S; S.init(NTOK, 1024, 1024, G, bx);
            pg8::EpiGLU E{Z, SO, args.in[22] + (size_t)l * 1024};
            pg8::gemm_phase<pg8::EpiGLU, pg8::PanelOrder, PG8_ALIGN, PG8_SP2>(lds + RING_OFF, g, S, E);
            if (ATT_IN_GLU && G == 256) { FRESH_LANE();
                const int j_ = bx >> 3;
                for (int r2 = 0; r2 < (PROBE_SA == 2 ? 2 : 1); ++r2)
                for (int id_ = j_ < 18 ? j_ : 18 + (j_ - 18); id_ < (j_ < 18 ? j_ + 1 : 72); id_ += 14) { const int x_ = bx & 7; const int a = id_ < 64 ? 64 * x_ + id_ : 512 + 8 * x_ + (id_ - 64);
                    attn_unit(lds, tid, wid, lane, a >> 2, a & 3, P, QN, KN, args.in[2] + (size_t)l * 16 * 128 * 256, args.in[3] + (size_t)l * 16 * 128 * 256, args.in[25] + l * 16, AO); } }
            { FRESH_LANE(); backfill(args, ws, lds, tid, wid, lane, G, bx, 144 - ((144 - 1) / G) * G, l + 1, 0, MOD_SPLIT, NL, 0, 0); } } SEAM(pb + 4); }
        if (EN(6) && IN(pb + 5)) { for (int rep = 0; rep < NREP(6); ++rep) { FRESH_WS();
            { pg8::Gemm g{SO, (const bf16*)(ws + WS_WPS + l * SZ_WP), NTOK, 2048, 1024}; pg8::PROrder S; S.init(NTOK, 2048, 1024, G, bx, 0);
              pg8::EpiPR<0> E{P, nullptr, T1, (unsigned*)(ws + WS_CTL + 32768) + (size_t)l * 32 * 64};
              pg8::gemm_phase<pg8::EpiPR<0>, pg8::PROrder, PG8_ALIGN, PG8_SP2>(lds + RING_OFF, g, S, E); }
            VM_WAIT(); __syncthreads();
            { pg8::Gemm g{AO, (const bf16*)(ws + WS_WPA + l * SZ_WP), NTOK, 2048, 1024}; pg8::PROrder S; S.init(NTOK, 2048, 1024, G, bx, 4);
              pg8::EpiPR<1> E{P, T1, MX, (unsigned*)(ws + WS_CTL + 32768) + (size_t)l * 32 * 64};
              pg8::gemm_phase<pg8::EpiPR<1>, pg8::PROrder, PG8_ALIGN, PG8_SP2>(lds + RING_OFF, g, S, E); }
            { FRESH_LANE(); backfill(args, ws, lds, tid, wid, lane, G, bx, G == 256 ? 64 : 288 - ((288 - 1) / G) * G, l + 1, 192, 384, l, 16896, 22528); }
            } SEAM(pb + 5); }
        if (EN(7) && IN(pb + 6)) { for (int rep = 0; rep < NREP(7); ++rep) { FRESH_WS(); pg8::Gemm g{MX, (const bf16*)(ws + WS_WOUT + l * SZ_WOUT), NTOK, 2048, 2048}; pg8::SplitOrder S; S.init(2048, G, bx);
            pg8::EpiRes E{(NREP(7) == 2 && rep == 0) ? (bf16*)(ws + WS_ACT) : XB, nullptr, MODL + 4096, SL};
            pg8::gemm_phase<pg8::EpiRes, pg8::SplitOrder, PG8_ALIGN, PG8_SP2>(lds + RING_OFF, g, S, E); } SEAM(pb + 6); }
        if (EN(8) && IN(pb + 7)) { for (int rep = 0; rep < NREP(8); ++rep) { FRESH_WS(); FRESH_LANE(); norm_phase(gw, NGW, lane, XB, nullptr, nullptr, SL, args.in[11] + (size_t)l * DM, MODL, 6144, 8192, H); } SEAM(pb + 7); }
        if (EN(9) && IN(pb + 8)) { for (int rep = 0; rep < NREP(9); ++rep) { FRESH_WS(); pg8::Gemm g{H, (const bf16*)(ws + WS_WGU + l * SZ_WGU), NTOK, 11264, 2048}; pg8::StaticOrder S; S.init(NTOK, 11264, 2048, G, bx);
            pg8::EpiFU E{ACT};
            pg8::gemm_phase<pg8::EpiFU, pg8::StaticOrder, PG8_ALIGN, PG8_SP2>(lds + RING_OFF, g, S, E);
            { FRESH_LANE(); backfill(args, ws, lds, tid, wid, lane, G, bx, 1584 - ((1584 - 1) / G) * G, NL, 0, 0, l, 22528, CONV_PER_L); backfill(args, ws, lds, tid, wid, lane, G, bx, 1584 - ((1584 - 1) / G) * G, NL, 0, 0, l + 1, 0, 6656); backfill(args, ws, lds, tid, wid, lane, G, bx, 1584 - ((1584 - 1) / G) * G, NL, 0, 0, l + 1, 11264, 15360); } } SEAM(pb + 8); }
        if (EN(10) && IN(pb + 9)) { for (int rep = 0; rep < NREP(10); ++rep) { FRESH_WS(); pg8::Gemm g{ACT, (const bf16*)(ws + WS_WDN + l * SZ_WDN), NTOK, 2048, 5632}; pg8::SplitOrder S; S.init(5632, G, bx);
            pg8::EpiRes E{(NREP(10) == 2 && rep == 0) ? (bf16*)(ws + WS_P) : XB, l == NL - 1 ? X : nullptr, MODL + 10240, SL};
            pg8::gemm_phase<pg8::EpiRes, pg8::SplitOrder, PG8_ALIGN, PG8_SP2>(lds + RING_OFF, g, S, E); } SEAM(pb + 9); }
    }
    if (IN(NPHASE - 1)) { FRESH_WS(); FRESH_LANE(); final_phase(gw, NGW, lane, X, XB, SL); }
    if (pass_ + 1 < PROBE_ALL) xcd_barrier(bar);
    }
#undef IN
#undef SEAM
#undef H
#undef P
#undef QN
#undef KN
#undef Z
#undef SO
#undef AO
#undef T1
#undef MX
#undef ACT
#undef X
#undef XB
#undef SL
}

extern "C" void kernel_launch(void* const* d_in, const int* in_sizes, int n_in, void* d_out, int out_size, void* d_ws, size_t ws_size, hipStream_t stream) {
    static int grid = 0;
    if (grid == 0) {
        if (n_in != 34 || out_size != (int)O_END || ws_size < WS_END) { fprintf(stderr, "kernel_launch: built for 34 inputs, %zu outputs, >= %zu bytes of workspace; got n_in %d, out %d, ws %zu; nothing launched\n", (size_t)O_END, (size_t)WS_END, n_in, out_size, ws_size); grid = -1; return; }
        int dev = 0, cus = 0, per_cu = 0;
        if (hipGetDevice(&dev) != hipSuccess || hipDeviceGetAttribute(&cus, hipDeviceAttributeMultiprocessorCount, dev) != hipSuccess) { fprintf(stderr, "kernel_launch: device query failed\n"); grid = -1; return; }
        if (hipFuncSetAttribute((const void*)enc_fwd, hipFuncAttributeMaxDynamicSharedMemorySize, LDS_BYTES) != hipSuccess) { fprintf(stderr, "kernel_launch: hipFuncSetAttribute failed\n"); grid = -1; return; }
        if (hipOccupancyMaxActiveBlocksPerMultiprocessor(&per_cu, (const void*)enc_fwd, NWAVES * 64, LDS_BYTES) != hipSuccess || per_cu < 1)
            fprintf(stderr, "kernel_launch: note: occupancy query reports %d workgroups per CU\n", per_cu);
        (void)hipGetLastError();
        grid = cus;
    }
    if (grid < 0) return;
    if (hipMemsetAsync((char*)d_ws + WS_CTL, 0, CTL_ZERO_BYTES, stream) != hipSuccess) { fprintf(stderr, "kernel_launch: memset failed\n"); return; }
    Args a{};
    for (int i = 0; i < 34; ++i) a.in[i] = (const float*)d_in[i];
    a.out = (float*)d_out; a.ws = (unsigned char*)d_ws;
#if MK_ONE_LAUNCH
    a.ph_lo = 0; a.ph_hi = NPHASE;
    hipLaunchKernelGGL(enc_fwd, dim3(grid), dim3(NWAVES * 64), LDS_BYTES, stream, a);
#else
    for (int ph = 0; ph < NPHASE; ++ph) { a.ph_lo = ph; a.ph_hi = ph + 1; hipLaunchKernelGGL(enc_fwd, dim3(grid), dim3(NWAVES * 64), LDS_BYTES, stream, a); }
#endif
    const hipError_t le = hipPeekAtLastError();
    if (le != hipSuccess) fprintf(stderr, "kernel_launch: launch failed: %s\n", hipGetErrorName(le));
}
```

```cpp
#include <hip/hip_runtime.h>
#include <cstdio>
#include <cstdint>
#define GAS __attribute__((address_space(1)))
namespace pg8 {
#define PG8_LAS __attribute__((address_space(3)))
typedef unsigned short bf16_t;
typedef short bf16x8 __attribute__((ext_vector_type(8)));
typedef float f32x4 __attribute__((ext_vector_type(4)));
typedef unsigned u32x4 __attribute__((ext_vector_type(4)));
constexpr int BM = 256, BK = 64, HALF = 128, HTB = HALF * BK * 2  , STAGE_BYTES = 8 * HTB, NXCD = 8, WGM = 6;

__host__ __device__ __forceinline__ int lds_byte(int r, int c) { const int st = (r >> 4) * 2 + (c >> 5), rr = r & 15, cc = c & 31, ob = rr * 64 + cc * 2; return st * 1024 + (ob ^ (((ob >> 9) & 1) << 5)); }
__host__ __device__ __forceinline__ void stage_rc(int b, int& R, int& C) { const int st = b / 1024, sb = b % 1024, swz = sb ^ (((sb >> 9) & 1) << 5); R = (st >> 1) * 16 + swz / 64; C = (st & 1) * 32 + (swz % 64) / 2; }
__host__ __device__ __forceinline__ int perm32(int rho) { const int n = rho >> 4, i = rho & 15; return 8 * (i >> 2) + 4 * n + (i & 3); }

#ifndef SPLIT_SWAP
#define SPLIT_SWAP 0
#endif
#ifndef ORD_TR
#define ORD_TR 0
#endif
#ifndef KROT
#define KROT 0
#endif
struct Unit { int pm, pn, kt0, nkt, slab, krot; };
struct Gemm { const bf16_t* A; const bf16_t* Bt; int M, N, K; };

struct StaticOrder {
    int nM, nN, nwg, G, c, nkt;
    __host__ __device__ void init(int M, int N, int K, int G_, int c_) { nM = M / BM; nN = N / BM; nwg = nM * nN; G = G_; c = c_; nkt = K / BK; }
    __host__ __device__ bool next(int i, Unit& u) const {
        const long L = (long)i * G + c; if (L >= nwg) return false;
        int wgid = (int)L; { const int q = nwg / NXCD, r = nwg % NXCD, xcd = wgid % NXCD, off = wgid / NXCD; wgid = (xcd < r ? xcd * (q + 1) : r * (q + 1) + (xcd - r) * q) + off; }
        if (ORD_TR > 0) {
            const int nig = ORD_TR * nM, gid = wgid / nig, fn = gid * ORD_TR, gsz = (nN - fn) < ORD_TR ? (nN - fn) : ORD_TR;
            u.pn = fn + ((wgid % nig) % gsz); u.pm = (wgid % nig) / gsz; u.kt0 = 0; u.nkt = nkt; u.slab = -1; u.krot = 0; return true; }
        const int nig = WGM * nN, gid = wgid / nig, fm = gid * WGM, gsz = (nM - fm) < WGM ? (nM - fm) : WGM;
        u.pm = fm + ((wgid % nig) % gsz); u.pn = (wgid % nig) / gsz; u.kt0 = 0; u.nkt = nkt; u.slab = -1; u.krot = KROT ? 2 * (((c & 7) * (nkt >> 1)) >> 3) : 0; return true;
    }
    __device__ __forceinline__ void a_ready(const Unit&) const {}
    __device__ __forceinline__ void done(const Unit&) const {}
};
struct PanelOrder {
    StaticOrder so; int nN, nkt, G, c;
    __host__ __device__ void init(int M, int N, int K, int G_, int c_) { so.init(M, N, K, G_, c_); nN = N / BM; nkt = K / BK; G = G_; c = c_; }
    __host__ __device__ bool next(int i, Unit& u) const {
        if (G != 256 || so.nM != 36) return so.next(i, u);
        const int x = c & 7, j = c >> 3, id = 32 * i + j, np = 4 * nN, ns = np >> 3;
        if (id >= np + ns) return false;
        if (id < np) { u.pm = 4 * x + (id & 3); int pn = (id >> 2) + (x * nN) / 8; u.pn = pn >= nN ? pn - nN : pn; }
        else { const int s = x * ns + (id - np); u.pm = 32 + (s & 3); u.pn = s >> 2; }
        u.kt0 = 0; u.nkt = nkt; u.slab = -1; u.krot = 0; return true;
    }
    __device__ __forceinline__ void a_ready(const Unit&) const {}
    __device__ __forceinline__ void done(const Unit&) const {}
};
struct PROrder {
    StaticOrder so; int G, c, nkt, sj0;
    __host__ __device__ void init(int M, int N, int K, int G_, int c_, int sj0_) { so.init(M, N, K, G_, c_); G = G_; c = c_; nkt = K / BK; sj0 = sj0_; }
    __host__ __device__ bool next(int i, Unit& u) const {
        if (G != 256) return so.next(i, u);
        const int x = c & 7, j = c >> 3;
        if (i == 0) { u.pm = 4 * x + (j & 3); const int pn = (j >> 2) + x; u.pn = pn & 7; }
        else if (i == 1) { const int jj = j - sj0; if (jj < 0 || jj >= 4) return false; const int s = 4 * x + jj; u.pm = 32 + (s & 3); u.pn = s >> 2; }
        else return false;
        u.kt0 = 0; u.nkt = nkt; u.slab = -1; u.krot = 0; return true;
    }
    __device__ __forceinline__ void a_ready(const Unit&) const {}
    __device__ __forceinline__ void done(const Unit&) const {}
};
struct BlockOrder {
    StaticOrder so; int nN, nkt, G, c;
    __host__ __device__ void init(int M, int N, int K, int G_, int c_) { so.init(M, N, K, G_, c_); nN = N / BM; nkt = K / BK; G = G_; c = c_; }
    __host__ __device__ bool next(int i, Unit& u) const {
        if (G != 256 || so.nM != 36 || (nN & 1)) return so.next(i, u);
        const int x = c & 7, j = c >> 3, id = 32 * i + j, hn = nN >> 1;
        if (id >= 9 * hn) return false;
        u.pm = 9 * (x >> 1) + id % 9; u.pn = (x & 1) * hn + id / 9; u.kt0 = 0; u.nkt = nkt; u.slab = -1; u.krot = 0; return true;
    }
    __device__ __forceinline__ void a_ready(const Unit&) const {}
    __device__ __forceinline__ void done(const Unit&) const {}
};
struct SplitOrder {
    int G, c, nkt;
    __host__ __device__ void init(int K, int G_, int c_) { G = G_; c = c_; nkt = K / BK; }
    __host__ __device__ bool next(int i, Unit& u) const {
        int e = i * G + c; if (e >= 512) return false;
        if (SPLIT_SWAP && G == 256 && (c & 1)) e ^= 256;
        const int f = e & 255, x = f & 7, j = f >> 3;
        if (e < 256) { u.pm = 4 * x + (j >> 3); u.pn = j & 7; u.kt0 = 0; u.nkt = nkt; u.slab = -1; u.krot = KROT ? 2 * ((x * (nkt >> 1)) >> 3) : 0; }
        else { const int np = nkt >> 1, base = np >> 3, rem = np & 7, pairs = base + (x < rem ? 1 : 0), start = x * base + (x < rem ? x : rem);
            u.pm = 32 + (j >> 3); u.pn = j & 7; u.kt0 = 2 * start; u.nkt = 2 * pairs; u.slab = x; u.krot = 0; }
        return true;
    }
    __device__ __forceinline__ void a_ready(const Unit&) const {}
    __device__ __forceinline__ void done(const Unit&) const {}
};

__device__ __forceinline__ unsigned cvt_pk_bf16(float lo, float hi) { unsigned r; asm volatile("v_cvt_pk_bf16_f32 %0, %1, %2" : "=v"(r) : "v"(lo), "v"(hi)); return r; }
typedef float f32x2 __attribute__((ext_vector_type(2)));
typedef unsigned u32x2 __attribute__((ext_vector_type(2)));
__device__ __forceinline__ float bflo(unsigned w) { return __uint_as_float(w << 16); }
__device__ __forceinline__ float bfhi(unsigned w) { return __uint_as_float(w & 0xffff0000u); }
__device__ __forceinline__ float sigmoidf_(float x) { return __builtin_amdgcn_rcpf(1.0f + __builtin_amdgcn_exp2f(-1.4426950408889634f * x)); }
__device__ __forceinline__ f32x4 sigmoid4(f32x4 v) {
    const f32x2 t0 = (f32x2){v[0], v[1]} * -1.4426950408889634f, t1 = (f32x2){v[2], v[3]} * -1.4426950408889634f;
    const f32x2 d0 = (f32x2){__builtin_amdgcn_exp2f(t0.x), __builtin_amdgcn_exp2f(t0.y)} + 1.0f, d1 = (f32x2){__builtin_amdgcn_exp2f(t1.x), __builtin_amdgcn_exp2f(t1.y)} + 1.0f;
    return (f32x4){__builtin_amdgcn_rcpf(d0.x), __builtin_amdgcn_rcpf(d0.y), __builtin_amdgcn_rcpf(d1.x), __builtin_amdgcn_rcpf(d1.y)}; }
__device__ __forceinline__ u32x4 pack8(f32x4 v0, f32x4 v1) { u32x4 w; w.x = cvt_pk_bf16(v0[0], v0[1]); w.y = cvt_pk_bf16(v0[2], v0[3]); w.z = cvt_pk_bf16(v1[0], v1[1]); w.w = cvt_pk_bf16(v1[2], v1[3]); return w; }
#ifndef WT_STORES
#define WT_STORES 0
#endif
__device__ __forceinline__ void store16_wt(void* p, u32x4 w) {
    if (WT_STORES) asm volatile("global_store_dwordx4 %0, %1, off sc1\n\ts_nop 1" :: "v"(p), "v"(w) : "memory");
    else *(GAS u32x4*)p = w;
}
__device__ __forceinline__ void unpack8(u32x4 w, f32x4& v0, f32x4& v1) { v0 = (f32x4){bflo(w.x), bfhi(w.x), bflo(w.y), bfhi(w.y)}; v1 = (f32x4){bflo(w.z), bfhi(w.z), bflo(w.w), bfhi(w.w)}; }

constexpr int NPJ = 6656;
struct EpiG1 {
    static constexpr bool PERM = true, AFTER_DRAIN = false, IDEMPOTENT = true;
    bf16_t* P; const float* bgate; bf16_t* QN; bf16_t* KN; const float* qg; const float* kg; const float* rope; float* out; int l;
    size_t o_pk, o_pv, o_sk, o_sv;
    __device__ __forceinline__ void operator()(const f32x4 (&acc)[2][2][4][2], const Unit& u, int wr, int wc, int fr_in, int fq_in) const {
        int fr = fr_in, fq = fq_in; asm volatile("" : "+v"(fr), "+v"(fq));
        const int row0 = u.pm * BM + wr * 64 + fr;
        if (u.pn >= 4 && u.pn <= 8) {
            const bool isk = u.pn == 8;
            const float* g = isk ? kg : qg;
            f32x4 gv[2][2];
#pragma unroll
            for (int bj = 0; bj < 2; ++bj)
#pragma unroll
                for (int n = 0; n < 2; ++n) gv[bj][n] = *(const f32x4*)(g + 32 * bj + 8 * fq + 4 * n);
#pragma unroll
            for (int ai = 0; ai < 2; ++ai)
#pragma unroll
                for (int m = 0; m < 4; ++m) {
                    const int row = row0 + ai * HALF + m * 16;
                    const bool smp = row >= 8192; const int t = smp ? ((row - 8192) & 63) : (row & 2047); const int bb = smp ? ((row - 8192) >> 6) : (row >> 11);
                    const float* rt = rope + (smp ? 2048 + t : t) * 16;
                    const f32x4 c0 = *(const GAS f32x4*)(rt), c1 = *(const GAS f32x4*)(rt + 4), s0 = *(const GAS f32x4*)(rt + 8), s1 = *(const GAS f32x4*)(rt + 12);
                    f32x4 y[2][2]; float ss = 0.f;
#pragma unroll
                    for (int bj = 0; bj < 2; ++bj)
#pragma unroll
                        for (int n = 0; n < 2; ++n) { y[bj][n] = acc[ai][bj][m][n]; ss += (y[bj][n][0] * y[bj][n][0] + y[bj][n][1] * y[bj][n][1]) + (y[bj][n][2] * y[bj][n][2] + y[bj][n][3] * y[bj][n][3]); }
                    ss += __shfl_xor(ss, 16); ss += __shfl_xor(ss, 32);
                    const float rstd = 1.0f / sqrtf(ss * (1.0f / 64.0f) + 1e-6f);
#pragma unroll
                    for (int bj = 0; bj < 2; ++bj)
#pragma unroll
                        for (int n = 0; n < 2; ++n) y[bj][n] = y[bj][n] * rstd * gv[bj][n];
                    f32x4 p0, p1;
#pragma unroll
                    for (int i = 0; i < 4; ++i) { p0[i] = __shfl_xor(y[0][0][i], 16); p1[i] = __shfl_xor(y[0][1][i], 16); }
                    if (fq == 0) { y[0][0] = y[0][0] * c0 - p0 * s0; y[0][1] = y[0][1] * c1 - p1 * s1; }
                    else if (fq == 1) { y[0][0] = y[0][0] * c0 + p0 * s0; y[0][1] = y[0][1] * c1 + p1 * s1; }
                    if (!isk) { bf16_t* qp = QN + (size_t)row * 1024 + (4 * (u.pn - 4) + wc) * 64 + 8 * fq;
                        *(GAS u32x4*)(qp) = pack8(y[0][0], y[0][1]); *(GAS u32x4*)(qp + 32) = pack8(y[1][0], y[1][1]); }
                    else { const int co = wc * 64 + 8 * fq; bf16_t* kp = KN + (size_t)row * 256 + co;
                        *(GAS u32x4*)(kp) = pack8(y[0][0], y[0][1]); *(GAS u32x4*)(kp + 32) = pack8(y[1][0], y[1][1]);
                        if (smp || t >= 1920) { float* d = out + (smp ? o_sk + ((size_t)(l * 16 + bb) * 128 + 64 + t) * 256 : o_pk + ((size_t)(l * 4 + bb) * 128 + (t - 1920)) * 256) + co;
                            *(f32x4*)(d) = y[0][0]; *(f32x4*)(d + 4) = y[0][1]; *(f32x4*)(d + 32) = y[1][0]; *(f32x4*)(d + 36) = y[1][1]; } }
                }
            return;
        }
        const int col0 = u.pn * BM + wc * 32 + 8 * fq;
        const bool isg = u.pn >= 10, isv = u.pn == 9;
        bf16_t* const pbase = P + (size_t)row0 * NPJ + col0;
        f32x4 bv[2][2];
#pragma unroll
        for (int bj = 0; bj < 2; ++bj)
#pragma unroll
            for (int n = 0; n < 2; ++n) bv[bj][n] = isg ? *(const f32x4*)(bgate + (col0 - 2560) + bj * HALF + 4 * n) : (f32x4){0.f, 0.f, 0.f, 0.f};
#pragma unroll
        for (int ai = 0; ai < 2; ++ai)
#pragma unroll
            for (int m = 0; m < 4; ++m) { const int row = row0 + ai * HALF + m * 16; bf16_t* rowp = pbase + (size_t)(ai * HALF + m * 16) * NPJ;
#pragma unroll
                for (int bj = 0; bj < 2; ++bj) { f32x4 v0 = acc[ai][bj][m][0] + bv[bj][0], v1 = acc[ai][bj][m][1] + bv[bj][1];
                    if (isg) { v0 = sigmoid4(v0); v1 = sigmoid4(v1); }
                    const u32x4 w = pack8(v0, v1); store16_wt(rowp + bj * HALF, w);
                    if (isv) { const bool smp = row >= 8192; const int t = smp ? ((row - 8192) & 63) : (row & 2047); const int bb = smp ? ((row - 8192) >> 6) : (row >> 11);
                        if (smp || t >= 1920) { float* d = out + (smp ? o_sv + ((size_t)(l * 16 + bb) * 128 + 64 + t) * 256 : o_pv + ((size_t)(l * 4 + bb) * 128 + (t - 1920)) * 256) + (col0 - 2304) + bj * HALF;
                            f32x4 r0, r1; unpack8(w, r0, r1); *(f32x4*)(d) = r0; *(f32x4*)(d + 4) = r1; } } } }
    }
};
struct EpiGLU {
    static constexpr bool PERM = true, AFTER_DRAIN = false, IDEMPOTENT = true;
    const bf16_t* Z; bf16_t* SO; const float* bglu;
    __device__ __forceinline__ void operator()(const f32x4 (&acc)[2][2][4][2], const Unit& u, int wr, int wc, int fr, int fq) const {
        const int row0 = u.pm * BM + wr * 64 + fr, col0 = u.pn * BM + wc * 32 + 8 * fq;
        f32x4 bv[2][2];
#pragma unroll
        for (int bj = 0; bj < 2; ++bj)
#pragma unroll
            for (int n = 0; n < 2; ++n) bv[bj][n] = *(const f32x4*)(bglu + col0 + bj * HALF + 4 * n);
        const bf16_t* const zb = Z + (size_t)row0 * 1024 + col0; bf16_t* const sob = SO + (size_t)row0 * 1024 + col0;
#pragma unroll
        for (int ai = 0; ai < 2; ++ai)
#pragma unroll
            for (int m = 0; m < 4; ++m) { const size_t off = (size_t)(ai * HALF + m * 16) * 1024;
#pragma unroll
                for (int bj = 0; bj < 2; ++bj) { f32x4 z0, z1; unpack8(*(const GAS u32x4*)(zb + off + bj * HALF), z0, z1);
                    const f32x4 v0 = z0 * sigmoid4(acc[ai][bj][m][0] + bv[bj][0]), v1 = z1 * sigmoid4(acc[ai][bj][m][1] + bv[bj][1]);
                    *(GAS u32x4*)(sob + off + bj * HALF) = pack8(v0, v1); } }
    }
};
template <int MODE> struct EpiPR {
    static constexpr bool PERM = true, AFTER_DRAIN = false, IDEMPOTENT = true;
    const bf16_t* P; const bf16_t* T1; bf16_t* O; unsigned* flags;
    __device__ __forceinline__ void operator()(const f32x4 (&acc)[2][2][4][2], const Unit& u, int wr, int wc, int fr, int fq) const {
        const int row0 = u.pm * BM + wr * 64 + fr, col0 = u.pn * BM + wc * 32 + 8 * fq;
        const bool samp = u.pm >= 32;
        GAS unsigned* flag = (GAS unsigned*)(flags + 64 * (u.pn * 4 + (u.pm & 3)));
        if (MODE == 1 && samp) {
            unsigned spins = 0u;
            while (__hip_atomic_load(flag, __ATOMIC_RELAXED, __HIP_MEMORY_SCOPE_AGENT) < 8u) { __builtin_amdgcn_s_sleep(2); if (++spins > (1u << 18)) break; }
            __builtin_amdgcn_fence(__ATOMIC_ACQUIRE, "agent"); asm volatile("s_waitcnt vmcnt(0)" ::: "memory");
        }
#pragma unroll
        for (int ai = 0; ai < 2; ++ai)
#pragma unroll
            for (int m = 0; m < 4; ++m) { const size_t r = (size_t)(row0 + ai * HALF + m * 16); const size_t off = r * 2048 + col0; const bf16_t* gp = P + r * NPJ + 2560 + MODE * 2048 + col0;
#pragma unroll
                for (int bj = 0; bj < 2; ++bj) { f32x4 g0, g1; unpack8(*(const GAS u32x4*)(gp + bj * HALF), g0, g1);
                    f32x4 v0 = g0 * acc[ai][bj][m][0], v1 = g1 * acc[ai][bj][m][1];
                    if (MODE == 1) { f32x4 t0, t1; unpack8(*(const GAS u32x4*)(T1 + off + bj * HALF), t0, t1); v0 += t0; v1 += t1; }
                    const u32x4 w = pack8(v0, v1);
                    if (MODE == 0 && samp) asm volatile("global_store_dwordx4 %0, %1, off sc1\n\ts_nop 1" :: "v"(O + off + bj * HALF), "v"(w) : "memory");
                    else *(GAS u32x4*)(O + off + bj * HALF) = w; } }
        if (MODE == 0 && samp) {
            asm volatile("s_waitcnt vmcnt(0)" ::: "memory");
            if (fr == 0 && fq == 0) __hip_atomic_fetch_add(flag, 1u, __ATOMIC_RELAXED, __HIP_MEMORY_SCOPE_AGENT);
        }
    }
};
struct EpiRes {
    static constexpr bool PERM = true, AFTER_DRAIN = false, IDEMPOTENT = false;
    bf16_t* XB; float* OUTF; const float* gmod; bf16_t* SL;
    __device__ __forceinline__ void operator()(const f32x4 (&acc)[2][2][4][2], const Unit& u, int wr, int wc, int fr, int fq) const {
        const int col0 = u.pn * BM + wc * 32 + 8 * fq;
        const bool part = u.slab >= 0;
#pragma unroll
        for (int ai = 0; ai < 2; ++ai) {
            const int rb = u.pm * BM + ai * HALF + wr * 64;
            const int cb = rb < 8192 ? (rb >> 11) : 4 + ((rb - 8192) >> 6);
            const float* g = gmod + (size_t)cb * 12288 + col0;
            f32x4 gv[2][2];
#pragma unroll
            for (int bj = 0; bj < 2; ++bj)
#pragma unroll
                for (int n = 0; n < 2; ++n) gv[bj][n] = *(const GAS f32x4*)(g + bj * HALF + 4 * n);
            if (part) { bf16_t* base = SL + ((size_t)u.slab * 1024 + (size_t)(rb - 8192 + fr)) * 2048 + col0;
#pragma unroll
                for (int m = 0; m < 4; ++m)
#pragma unroll
                    for (int bj = 0; bj < 2; ++bj) *(GAS u32x4*)(base + (size_t)(m * 16) * 2048 + bj * HALF) = pack8(gv[bj][0] * acc[ai][bj][m][0], gv[bj][1] * acc[ai][bj][m][1]);
            } else { const size_t o0 = (size_t)(rb + fr) * 2048 + col0;
#pragma unroll
                for (int m = 0; m < 4; ++m)
#pragma unroll
                    for (int bj = 0; bj < 2; ++bj) { const size_t o = o0 + (size_t)(m * 16) * 2048 + bj * HALF; f32x4 x0, x1; unpack8(*(const GAS u32x4*)(XB + o), x0, x1);
                        const f32x4 v0 = x0 + gv[bj][0] * acc[ai][bj][m][0], v1 = x1 + gv[bj][1] * acc[ai][bj][m][1];
                        if (OUTF != nullptr) { *(GAS f32x4*)(OUTF + o) = v0; *(GAS f32x4*)(OUTF + o + 4) = v1; } else *(GAS u32x4*)(XB + o) = pack8(v0, v1); }
            }
        }
    }
};
struct EpiFU {
    static constexpr bool PERM = true, AFTER_DRAIN = false, IDEMPOTENT = true;
    bf16_t* ACT;
    __device__ __forceinline__ void operator()(const f32x4 (&acc)[2][2][4][2], const Unit& u, int wr, int wc, int fr, int fq) const {
        const int row0 = u.pm * BM + wr * 64 + fr, col0 = u.pn * HALF + wc * 32 + 8 * fq;
        bf16_t* const p0 = ACT + (size_t)row0 * 5632 + col0;
#pragma unroll
        for (int ai = 0; ai < 2; ++ai)
#pragma unroll
            for (int m = 0; m < 4; ++m) {
                const f32x4 g0 = acc[ai][0][m][0], g1 = acc[ai][0][m][1];
                const f32x4 v0 = g0 * sigmoid4(g0) * acc[ai][1][m][0], v1 = g1 * sigmoid4(g1) * acc[ai][1][m][1];
                store16_wt(p0 + (size_t)(ai * HALF + m * 16) * 5632, pack8(v0, v1)); }
    }
};

template <class Epi, class Sched, bool ALIGN_EPI = false, bool SP2 = false>
__device__ __forceinline__ void gemm_phase(PG8_LAS unsigned char* lds, const Gemm g, const Sched& S, const Epi& E) {
    int tid_l = threadIdx.x; asm volatile("" : "+v"(tid_l));
    const int tid = tid_l, wid = __builtin_amdgcn_readfirstlane(tid >> 6), lane = tid & 63, wr = wid >> 2, wc = wid & 3, fr = lane & 15, fq = lane >> 4;
    const int K = g.K;
    unsigned voffA[2], voffB[2];
#pragma unroll
    for (int i = 0; i < 2; ++i) { int R, C; stage_rc(tid * 16 + i * 8192, R, C); const int Rb = Epi::PERM ? ((R & ~31) + perm32(R & 31)) : R;
        voffA[i] = (unsigned)(R * K + C) * 2u; voffB[i] = (unsigned)(Rb * K + C) * 2u; }
    const size_t kstep = (size_t)(BK * 2);
    const size_t hstep = (size_t)HALF * K * 2;
    const size_t tstep = 2 * hstep;
    const unsigned ldsw = (unsigned)wid * 1024u;
    const int aoff = lds_byte(wr * 64 + fr, fq * 8), boff = lds_byte(wc * 32 + fr, fq * 8);
#define PG8_SA(b, h) (((b) * 2 + (h)) * HTB)
#define PG8_SB(b, h) ((4 + (b) * 2 + (h)) * HTB)
#ifndef AUX_A
#define AUX_A 0
#endif
#ifndef AUX_B
#define AUX_B 0
#endif
#define PG8_STAGE(bufoff, gbase, voff) do { _Pragma("unroll") for (int _i = 0; _i < 2; ++_i) \
        __builtin_amdgcn_global_load_lds((const unsigned*)((const char*)(gbase) + (voff)[_i]), (PG8_LAS unsigned*)(lds + (bufoff) + ldsw + _i * 8192), 16, 0, AUX_A); } while (0)
#define PG8_STAGEB(bufoff, gbase, voff) do { _Pragma("unroll") for (int _i = 0; _i < 2; ++_i) \
        __builtin_amdgcn_global_load_lds((const unsigned*)((const char*)(gbase) + (voff)[_i]), (PG8_LAS unsigned*)(lds + (bufoff) + ldsw + _i * 8192), 16, 0, AUX_B); } while (0)
#define PG8_LDA(dst, b, h) do { _Pragma("unroll") for (int m = 0; m < 4; ++m) _Pragma("unroll") for (int k = 0; k < 2; ++k) dst[m][k] = *(const PG8_LAS bf16x8*)(lds + PG8_SA(b, h) + aoff + m * 2048 + k * 1024); } while (0)
#define PG8_LDB(dst, b, h) do { _Pragma("unroll") for (int n = 0; n < 2; ++n) _Pragma("unroll") for (int k = 0; k < 2; ++k) dst[n][k] = *(const PG8_LAS bf16x8*)(lds + PG8_SB(b, h) + boff + n * 2048 + k * 1024); } while (0)
#define PG8_MMA(ai, bj, At, Bt) do { __builtin_amdgcn_s_setprio(1); _Pragma("unroll") for (int m = 0; m < 4; ++m) _Pragma("unroll") for (int n = 0; n < 2; ++n) _Pragma("unroll") for (int k = 0; k < 2; ++k) \
        acc[ai][bj][m][n] = __builtin_amdgcn_mfma_f32_16x16x32_bf16(Bt[n][k], At[m][k], acc[ai][bj][m][n], 0, 0, 0); __builtin_amdgcn_s_setprio(0); } while (0)
#define PG8_WAIT_V(n) asm volatile("s_waitcnt vmcnt(" #n ")" ::: "memory")
#define PG8_WAIT_L(n) asm volatile("s_waitcnt lgkmcnt(" #n ")" ::: "memory")
#define PG8_BAR __builtin_amdgcn_s_barrier()
#define PG8_SCHED __builtin_amdgcn_sched_barrier(0)
    Unit cur, nxt; int ui = 0;
    if (!S.next(0, cur)) return;
    f32x4 acc[2][2][4][2];
#pragma unroll
    for (int a = 0; a < 2; ++a)
#pragma unroll
        for (int b = 0; b < 2; ++b)
#pragma unroll
            for (int m = 0; m < 4; ++m)
#pragma unroll
                for (int n = 0; n < 2; ++n) acc[a][b][m][n] = (f32x4){0.f, 0.f, 0.f, 0.f};
    bf16x8 At[4][2], B0[2][2], B1[2][2];
    const char* cA = (const char*)g.A + (size_t)cur.pm * tstep + (size_t)cur.kt0 * kstep; const char* cB = (const char*)g.Bt + (size_t)cur.pn * tstep + (size_t)cur.kt0 * kstep;
    S.a_ready(cur);
#define PG8_KP(base, p, rot_, nt_) ((base) + (size_t)((p) + (rot_) < (nt_) ? (p) + (rot_) : (p) + (rot_) - (nt_)) * kstep)
    { const int rot0 = cur.krot, nt0 = cur.nkt; const char* sA0 = PG8_KP(cA, 0, rot0, nt0); const char* sA1 = PG8_KP(cA, 1, rot0, nt0); const char* sB0 = PG8_KP(cB, 0, rot0, nt0); const char* sB1 = PG8_KP(cB, 1, rot0, nt0);
    if constexpr (SP2) {
        PG8_STAGEB(PG8_SB(0, 0), sB0, voffB); PG8_STAGEB(PG8_SB(0, 1), sB0 + hstep, voffB); PG8_STAGE(PG8_SA(0, 0), sA0, voffA); PG8_STAGE(PG8_SA(0, 1), sA0 + hstep, voffA);
        if (wr == 1) PG8_BAR;
        PG8_WAIT_V(2); PG8_BAR;
        PG8_STAGEB(PG8_SB(1, 0), sB1, voffB); PG8_STAGE(PG8_SA(1, 0), sA1, voffA); PG8_STAGEB(PG8_SB(1, 1), sB1 + hstep, voffB);
        PG8_WAIT_V(6); PG8_BAR;
    } else {
        PG8_STAGEB(PG8_SB(0, 0), sB0, voffB); PG8_STAGE(PG8_SA(0, 0), sA0, voffA); PG8_STAGEB(PG8_SB(0, 1), sB0 + hstep, voffB); PG8_STAGE(PG8_SA(0, 1), sA0 + hstep, voffA);
        if (wr == 1) PG8_BAR;
        PG8_WAIT_V(4); PG8_BAR;
        PG8_STAGEB(PG8_SB(1, 0), sB1, voffB); PG8_STAGE(PG8_SA(1, 0), sA1, voffA); PG8_STAGEB(PG8_SB(1, 1), sB1 + hstep, voffB);
        PG8_WAIT_V(6); PG8_BAR;
    }
    }
    for (;;) {
        const bool has_next = S.next(ui + 1, nxt);
        const char* nA = has_next ? (const char*)g.A + (size_t)nxt.pm * tstep + (size_t)nxt.kt0 * kstep : cA; const char* nB = has_next ? (const char*)g.Bt + (size_t)nxt.pn * tstep + (size_t)nxt.kt0 * kstep : cB;
        const int nt = cur.nkt, rot = cur.krot;
        const char* nAr = has_next ? nA + (size_t)nxt.krot * kstep : PG8_KP(cA, 0, rot, nt); const char* nBr = has_next ? nB + (size_t)nxt.krot * kstep : PG8_KP(cB, 0, rot, nt);
        for (int t = 0; t < nt; t += 2) {
            const bool last = (t == nt - 2);
            const char* a1 = PG8_KP(cA, t + 1, rot, nt);
            const char* a2 = last ? nAr : PG8_KP(cA, t + 2, rot, nt); const char* b2 = last ? nBr : PG8_KP(cB, t + 2, rot, nt);
            const char* a3 = a2 + kstep; const char* b3 = b2 + kstep;
            if (last && has_next) S.a_ready(nxt);
            if constexpr (SP2) {
            PG8_LDB(B0, 0, 0); PG8_LDB(B1, 0, 1); PG8_SCHED; PG8_LDA(At, 0, 0); PG8_STAGE(PG8_SA(1, 1), a1 + hstep, voffA);
            PG8_WAIT_V(8); PG8_WAIT_L(0); PG8_BAR; PG8_MMA(0, 0, At, B0); PG8_MMA(0, 1, At, B1); PG8_BAR; PG8_SCHED;
            PG8_LDA(At, 0, 1); PG8_STAGEB(PG8_SB(0, 0), b2, voffB); PG8_STAGEB(PG8_SB(0, 1), b2 + hstep, voffB); PG8_STAGE(PG8_SA(0, 0), a2, voffA);
            PG8_WAIT_V(8); PG8_WAIT_L(0); PG8_BAR; PG8_MMA(1, 0, At, B0); PG8_MMA(1, 1, At, B1); PG8_BAR; PG8_SCHED;
            PG8_LDB(B0, 1, 0); PG8_LDB(B1, 1, 1); PG8_SCHED; PG8_LDA(At, 1, 0); PG8_STAGE(PG8_SA(0, 1), a2 + hstep, voffA);
            PG8_WAIT_V(8); PG8_WAIT_L(0); PG8_BAR; PG8_MMA(0, 0, At, B0); PG8_MMA(0, 1, At, B1); PG8_BAR; PG8_SCHED;
            PG8_LDA(At, 1, 1); PG8_STAGEB(PG8_SB(1, 0), b3, voffB); PG8_STAGEB(PG8_SB(1, 1), b3 + hstep, voffB); PG8_STAGE(PG8_SA(1, 0), a3, voffA);
            PG8_WAIT_V(8); PG8_WAIT_L(0); PG8_BAR; PG8_MMA(1, 0, At, B0); PG8_MMA(1, 1, At, B1); PG8_BAR; PG8_SCHED;
            } else {
            PG8_LDB(B0, 0, 0); PG8_SCHED; PG8_LDA(At, 0, 0); PG8_STAGE(PG8_SA(1, 1), a1 + hstep, voffA);
            PG8_WAIT_L(8); PG8_BAR; PG8_WAIT_L(0); PG8_MMA(0, 0, At, B0); PG8_BAR; PG8_SCHED;
            PG8_LDB(B1, 0, 1); PG8_STAGEB(PG8_SB(0, 0), b2, voffB);
            PG8_BAR; PG8_WAIT_L(0); PG8_MMA(0, 1, At, B1); PG8_BAR;
            PG8_LDA(At, 0, 1); PG8_STAGE(PG8_SA(0, 0), a2, voffA);
            PG8_BAR; PG8_WAIT_L(0); PG8_MMA(1, 0, At, B0); PG8_BAR; PG8_SCHED;
            PG8_STAGEB(PG8_SB(0, 1), b2 + hstep, voffB);
            PG8_WAIT_V(6); PG8_BAR; PG8_MMA(1, 1, At, B1); PG8_BAR;
            PG8_LDB(B0, 1, 0); PG8_SCHED; PG8_LDA(At, 1, 0); PG8_STAGE(PG8_SA(0, 1), a2 + hstep, voffA);
            PG8_WAIT_L(8); PG8_BAR; PG8_WAIT_L(0); PG8_MMA(0, 0, At, B0); PG8_BAR; PG8_SCHED;
            PG8_LDB(B1, 1, 1); PG8_STAGEB(PG8_SB(1, 0), b3, voffB);
            PG8_BAR; PG8_WAIT_L(0); PG8_MMA(0, 1, At, B1); PG8_BAR;
            PG8_LDA(At, 1, 1); PG8_STAGE(PG8_SA(1, 0), a3, voffA);
            PG8_BAR; PG8_WAIT_L(0); PG8_MMA(1, 0, At, B0); PG8_BAR; PG8_SCHED;
            PG8_STAGEB(PG8_SB(1, 1), b3 + hstep, voffB);
            PG8_WAIT_V(6); PG8_BAR; PG8_MMA(1, 1, At, B1); PG8_BAR;
            }
        }
        if constexpr (ALIGN_EPI) { if (wr == 0) PG8_BAR; }
#ifndef PROBE_EPI
#define PROBE_EPI 0
#endif
        if constexpr (!Epi::AFTER_DRAIN) { E(acc, cur, wr, wc, fr, fq); if (PROBE_EPI && Epi::IDEMPOTENT) { asm volatile("" ::: "memory"); E(acc, cur, wr, wc, fr, fq); } S.done(cur); }
        if (!has_next) break;
#pragma unroll
        for (int a = 0; a < 2; ++a)
#pragma unroll
            for (int b = 0; b < 2; ++b)
#pragma unroll
                for (int m = 0; m < 4; ++m)
#pragma unroll
                    for (int n = 0; n < 2; ++n) acc[a][b][m][n] = (f32x4){0.f, 0.f, 0.f, 0.f};
        cur = nxt; cA = nA; cB = nB; ++ui;
        if constexpr (ALIGN_EPI) { if (wr == 1) PG8_BAR; }
    }
    PG8_WAIT_V(0);
    if constexpr (!ALIGN_EPI) { if (wr == 0) PG8_BAR; }
    PG8_BAR;
    if constexpr (Epi::AFTER_DRAIN) { E.fused(acc, cur, wr, wc, fr, fq, lds, wid, lane); S.done(cur); }
#undef PG8_KP
#undef PG8_SA
#undef PG8_SB
#undef PG8_STAGE
#undef PG8_STAGEB
#undef PG8_LDA
#undef PG8_LDB
#undef PG8_MMA
#undef PG8_WAIT_V
#undef PG8_WAIT_L
#undef PG8_BAR
#undef PG8_SCHED
}
}

#ifndef PG8_SP2
#define PG8_SP2 true
#endif
#ifndef PG8_ALIGN
#define PG8_ALIGN true
#endif
#ifndef BACKFILL
#define BACKFILL 1
#endif
#ifndef BF_G1_R0
#define BF_G1_R0 0
#define BF_G1_R1 7168
#endif
#ifndef BF_FU_R0
#define BF_FU_R0 16896
#define BF_FU_R1 28160
#endif
#ifndef MK_ONE_LAUNCH
#define MK_ONE_LAUNCH 1
#endif

constexpr int NWAVES = 8;
constexpr int DM = 2048, NTOK = 9216, TPR = 8192, NL = 4, NCB = 20, MODW = 12288, DFF = 5632, NPJ = pg8::NPJ;
constexpr int NPHASE = 2 + 10 * NL;
constexpr size_t O_Y = 0, O_PK = 18874368, O_PV = O_PK + 524288, O_PSR = O_PV + 524288, O_PSI = O_PSR + 65536, O_SK = O_PSI + 65536, O_SV = O_SK + 2097152, O_SSR = O_SV + 2097152, O_SSI = O_SSR + 262144, O_END = O_SSI + 262144;
static_assert(O_END == 24772608, "output map");
constexpr size_t MiB = 1u << 20;
constexpr size_t WS_CTL = 0, CTL_ZERO_BYTES = 64 * 1024;
constexpr size_t WS_MOD = 1 * MiB;
constexpr size_t WS_LAM = 5 * MiB;
constexpr size_t WS_BBAR = 6 * MiB;
constexpr size_t WS_CM = 7 * MiB;
constexpr size_t WS_ROPE = 8 * MiB;
constexpr size_t WS_W1 = 16 * MiB;
constexpr size_t SZ_W1 = (size_t)6656 * 2048 * 2;
constexpr size_t WS_WGLU = WS_W1 + NL * SZ_W1;
constexpr size_t SZ_WGLU = (size_t)1024 * 1024 * 2;
constexpr size_t WS_WPS = WS_WGLU + NL * SZ_WGLU;
constexpr size_t SZ_WP = (size_t)2048 * 1024 * 2;
constexpr size_t WS_WPA = WS_WPS + NL * SZ_WP;
constexpr size_t WS_WOUT = WS_WPA + NL * SZ_WP;
constexpr size_t SZ_WOUT = (size_t)2048 * 2048 * 2;
constexpr size_t WS_WGU = WS_WOUT + NL * SZ_WOUT;
constexpr size_t SZ_WGU = (size_t)11264 * 2048 * 2;
constexpr size_t WS_WDN = WS_WGU + NL * SZ_WGU;
constexpr size_t SZ_WDN = (size_t)2048 * 5632 * 2;
constexpr size_t WS_H = WS_WDN + NL * SZ_WDN;
constexpr size_t WS_P = WS_H + (size_t)NTOK * 2048 * 2;
constexpr size_t WS_QN = WS_P + (size_t)NTOK * NPJ * 2;
constexpr size_t WS_KN = WS_QN + (size_t)NTOK * 1024 * 2;
constexpr size_t WS_Z = WS_KN + (size_t)NTOK * 256 * 2;
constexpr size_t WS_SO = WS_Z + (size_t)NTOK * 1024 * 2;
constexpr size_t WS_AO = WS_SO + (size_t)NTOK * 1024 * 2;
constexpr size_t WS_T1 = WS_AO + (size_t)NTOK * 1024 * 2;
constexpr size_t WS_MX = WS_T1 + (size_t)NTOK * 2048 * 2;
constexpr size_t WS_ACT = WS_MX + (size_t)NTOK * 2048 * 2;
constexpr size_t WS_SL = WS_ACT + (size_t)NTOK * DFF * 2;
constexpr size_t WS_XB = WS_SL + (size_t)8 * 1024 * 2048 * 4;
constexpr size_t WS_END = WS_XB + (size_t)NTOK * 2048 * 2;
static_assert(WS_ROPE + 2112 * 16 * 4 <= WS_W1 && (WS_W1 % 256) == 0 && (WS_H % 256) == 0, "d_ws map");
constexpr int CW_BAR = 4096;

constexpr int RING_OFF = 0, RING_BYTES = 131072;
constexpr int LDSCTL_OFF = RING_BYTES, MISC_OFF = LDSCTL_OFF + 320;
constexpr int LDS_BYTES = 147456;
static_assert(MISC_OFF + 128 <= LDS_BYTES, "LDS map");

#define GAS __attribute__((address_space(1)))
#define LAS __attribute__((address_space(3)))
typedef unsigned short bf16;
typedef unsigned v4u __attribute__((ext_vector_type(4)));
typedef unsigned v2u __attribute__((ext_vector_type(2)));
typedef float f32x4 __attribute__((ext_vector_type(4)));
typedef float f32x2 __attribute__((ext_vector_type(2)));
typedef float f32x16 __attribute__((ext_vector_type(16)));
typedef short bf16x8 __attribute__((ext_vector_type(8)));
typedef GAS unsigned gu32;
#define RLX_AGENT __ATOMIC_RELAXED, __HIP_MEMORY_SCOPE_AGENT
#define LDS_WAIT() asm volatile("s_waitcnt lgkmcnt(0)" ::: "memory")
#define VM_WAIT() asm volatile("s_waitcnt vmcnt(0)" ::: "memory")
using pg8::cvt_pk_bf16; using pg8::bflo; using pg8::bfhi;
__device__ __forceinline__ unsigned f2bf(float f) { unsigned u = __builtin_bit_cast(unsigned, f); return (u + 0x7fffu + ((u >> 16) & 1u)) >> 16; }
__device__ __forceinline__ float bf2f(unsigned short b) { return __uint_as_float((unsigned)b << 16); }
__device__ __forceinline__ float wave_sum(float v) {
#pragma unroll
    for (int o = 1; o < 64; o <<= 1) v += __shfl_xor(v, o);
    return v;
}
#define XB_TMO      128
#define XB_XCNT(j)  (256  + 64 * (j))
#define XB_XSUB(j)  (1280 + 64 * (j))
#define XB_XGEN(j)  (2304 + 64 * (j))
#define XB_TOP      3328
#define XB_TOPGEN   3392
#define XCD_BAR_WORDS 3456
#define XB_SPIN_CAP (1u << 18)

__device__ __forceinline__ unsigned xb_ld(unsigned* p)              { return __hip_atomic_load(p, __ATOMIC_RELAXED, __HIP_MEMORY_SCOPE_AGENT); }
__device__ __forceinline__ unsigned xb_add(unsigned* p, unsigned v) { return __hip_atomic_fetch_add(p, v, __ATOMIC_RELAXED, __HIP_MEMORY_SCOPE_AGENT); }
__device__ __forceinline__ unsigned xb_xcc_id() { return (unsigned)__builtin_amdgcn_s_getreg((3 << 11) | 20) & 0xFu; }
#define XB_SPIN(cond, bar) do { unsigned _sp = 0; while (cond) { __builtin_amdgcn_s_sleep(1); \
    if ((++_sp & 255u) == 0u) { if (xb_ld(&(bar)[XB_TMO])) break; if (_sp > XB_SPIN_CAP) { atomicAdd(&(bar)[XB_TMO], 1u); break; } } } } while (0)

struct XcdBarrier {
    unsigned* bar; unsigned x;
    volatile LAS unsigned* st;
};

__device__ __forceinline__ XcdBarrier xcd_barrier_post(unsigned* bar, volatile LAS unsigned* st) {
    XcdBarrier b; b.bar = bar; b.x = xb_xcc_id(); b.st = st;
    if (threadIdx.x == 0) (void)xb_add(&bar[XB_XCNT(b.x)], 1u);
    return b;
}
__device__ __forceinline__ void xcd_barrier_complete(unsigned* bar, unsigned x, unsigned& nloc, unsigned& nx) {
    const unsigned G = gridDim.x * gridDim.y * gridDim.z;
    unsigned sum, cnt, mine, sp = 0u;
    for (;;) {
        sum = 0u; cnt = 0u; mine = 0u;
#pragma unroll
        for (unsigned j = 0; j < 16; ++j) { const unsigned c = xb_ld(&bar[XB_XCNT(j)]); sum += c; cnt += (c > 0u) ? 1u : 0u; mine = (j == x) ? c : mine; }
        if (sum == G) break;
        __builtin_amdgcn_s_sleep(1);
        if ((++sp & 255u) == 0u) { if (xb_ld(&bar[XB_TMO])) break; if (sp > XB_SPIN_CAP) { atomicAdd(&bar[XB_TMO], 1u); break; } }
    }
    nloc = mine > 0u ? mine : 1u; nx = cnt > 0u ? cnt : 1u;
}

__device__ __forceinline__ void xcd_barrier(const XcdBarrier& b) {
    asm volatile("s_waitcnt vmcnt(0)" ::: "memory");
    __syncthreads();
    if (threadIdx.x == 0) {
        unsigned* bar = b.bar;
        __builtin_amdgcn_s_waitcnt(0);
        unsigned nloc = b.st[0], nx = b.st[1];
        if (nloc == 0u) { xcd_barrier_complete(bar, b.x, nloc, nx); b.st[0] = nloc; b.st[1] = nx; }
        const unsigned old = xb_add(&bar[XB_XSUB(b.x)], 1u);
        const unsigned gen = old / nloc;
        if (old + 1u == (gen + 1u) * nloc) {
            __builtin_amdgcn_fence(__ATOMIC_RELEASE, "agent");
            asm volatile("s_waitcnt vmcnt(0)" ::: "memory");
            const unsigned og = xb_add(&bar[XB_TOP], 1u);
            const unsigned tg = og / nx;
            if (og + 1u == (tg + 1u) * nx) xb_add(&bar[XB_TOPGEN], 1u);
            else XB_SPIN(xb_ld(&bar[XB_TOPGEN]) == tg, bar);
            __builtin_amdgcn_fence(__ATOMIC_ACQUIRE, "agent");
            xb_add(&bar[XB_XGEN(b.x)], 1u);
            asm volatile("s_waitcnt vmcnt(0)" ::: "memory");
        } else {
            XB_SPIN(xb_ld(&bar[XB_XGEN(b.x)]) == gen, bar);
            __builtin_amdgcn_fence(__ATOMIC_ACQUIRE, "agent");
            asm volatile("s_waitcnt vmcnt(0)" ::: "memory");
        }
    }
    __syncthreads();
}

#ifndef NT_STREAM
#define NT_STREAM 1
#endif
__device__ __forceinline__ unsigned pk2(float lo, float hi) { return cvt_pk_bf16(lo, hi); }
struct ConvDesc { const float* src; bf16* dst; int N, K; };
__device__ __forceinline__ void conv_load(const ConvDesc& d, f32x4 (&v)[8]) {
#pragma unroll
    for (int i = 0; i < 8; ++i) v[i] = NT_STREAM ? __builtin_nontemporal_load((const GAS f32x4*)(d.src + (size_t)(8 * i) * d.N)) : *(const GAS f32x4*)(d.src + (size_t)(8 * i) * d.N);
}
__device__ __forceinline__ void conv_store(const ConvDesc& d, const f32x4 (&v)[8], LAS float* scr, int lane) {
    { const int kr = lane >> 3, n4 = lane & 7;
#pragma unroll
      for (int i = 0; i < 8; ++i) { LAS float* p = scr + (8 * i + kr) * 33 + 4 * n4; p[0] = v[i].x; p[1] = v[i].y; p[2] = v[i].z; p[3] = v[i].w; } }
    LDS_WAIT(); asm volatile("" ::: "memory");
    const int c = lane & 7;
#pragma unroll
    for (int j = 0; j < 4; ++j) { const int n = (lane >> 3) + 8 * j; const LAS float* s = scr + (8 * c) * 33 + n;
        v4u o; o.x = pk2(s[0 * 33], s[1 * 33]); o.y = pk2(s[2 * 33], s[3 * 33]); o.z = pk2(s[4 * 33], s[5 * 33]); o.w = pk2(s[6 * 33], s[7 * 33]);
        if (NT_STREAM) __builtin_nontemporal_store(o, (GAS v4u*)(d.dst + (size_t)n * d.K + 8 * c)); else *(GAS v4u*)(d.dst + (size_t)n * d.K + 8 * c) = o; }
    LDS_WAIT(); asm volatile("" ::: "memory");
}
__device__ __forceinline__ void sincos_d(double x, double& s, double& c) {
    const double k = rint(x * 0.63661977236758134308);
    double y = fma(-k, 1.57079632679489655800e+00, x); y = fma(-k, 6.12323399573676603587e-17, y);
    const double y2 = y * y;
    const double sp = y * (1.0 + y2 * (-1.0 / 6.0 + y2 * (1.0 / 120.0 + y2 * (-1.0 / 5040.0 + y2 * (1.0 / 362880.0 + y2 * (-1.0 / 39916800.0 + y2 * (1.0 / 6227020800.0)))))));
    const double cp = 1.0 + y2 * (-0.5 + y2 * (1.0 / 24.0 + y2 * (-1.0 / 720.0 + y2 * (1.0 / 40320.0 + y2 * (-1.0 / 3628800.0 + y2 * (1.0 / 479001600.0 + y2 * (-1.0 / 87178291200.0)))))));
    const int qd = ((int)k) & 3;
    s = (qd == 0) ? sp : (qd == 1) ? cp : (qd == 2) ? -sp : -cp;
    c = (qd == 0) ? cp : (qd == 1) ? -sp : (qd == 2) ? -cp : sp;
}
__device__ __forceinline__ int crow(int r, int hi) { return (r & 3) + 8 * (r >> 2) + 4 * hi; }
__device__ __forceinline__ bf16x8 mk_bf16x8(unsigned a, unsigned b, unsigned c, unsigned d) { v4u w; w.x = a; w.y = b; w.z = c; w.w = d; return __builtin_bit_cast(bf16x8, w); }

struct Args { const float* in[34]; float* out; unsigned char* ws; int ph_lo, ph_hi; };

__device__ __forceinline__ void p0_mod(LAS unsigned char* lds, int tid, int wid, int lane, int t_first, int t_end, int t_stride, const float* cp, const float* cs, const float* wmod, const float* bmod, float* MOD) {
    LAS float* red = (LAS float*)lds;
    const int q = lane & 31, hi = lane >> 5;
    LAS float* scr = (LAS float*)(lds + 32768 + wid * 8448);
    const int kr = lane >> 3, n4 = lane & 7;
    for (int task = t_first; task < t_end; task += t_stride) {
        const int l = task / 384, nb = task % 384;
        const float* wt = wmod + (size_t)l * 2048 * MODW + 32 * nb + 4 * n4;
        const float* csrc = q < 4 ? cp + q * 2048 : cs + (q < 20 ? (q - 4) : 0) * 2048;
        f32x16 acc;
#pragma unroll
        for (int r = 0; r < 16; ++r) acc[r] = 0.f;
        f32x4 vn[8];
#pragma unroll
        for (int i = 0; i < 8; ++i) vn[i] = __builtin_nontemporal_load((const f32x4*)(wt + (size_t)(256 * wid + 8 * i + kr) * MODW));
#pragma unroll 1
        for (int tt = 0; tt < 4; ++tt) {
            f32x4 vc[8];
#pragma unroll
            for (int i = 0; i < 8; ++i) vc[i] = vn[i];
            if (tt < 3) {
#pragma unroll
                for (int i = 0; i < 8; ++i) vn[i] = __builtin_nontemporal_load((const f32x4*)(wt + (size_t)(256 * wid + 64 * (tt + 1) + 8 * i + kr) * MODW)); }
#pragma unroll
            for (int i = 0; i < 8; ++i) { LAS float* p = scr + (8 * i + kr) * 33 + 4 * n4; p[0] = vc[i].x; p[1] = vc[i].y; p[2] = vc[i].z; p[3] = vc[i].w; }
            LDS_WAIT(); asm volatile("" ::: "memory");
#pragma unroll
            for (int ks = 0; ks < 4; ++ks) {
                const int k0 = 256 * wid + 64 * tt + 16 * ks + 8 * hi;
                f32x4 a0 = *(const f32x4*)(csrc + k0), a1 = *(const f32x4*)(csrc + k0 + 4);
                if (q >= 20) { a0 = (f32x4){0.f, 0.f, 0.f, 0.f}; a1 = a0; }
                float b[8];
#pragma unroll
                for (int jj = 0; jj < 8; ++jj) b[jj] = scr[(16 * ks + 8 * hi + jj) * 33 + q];
                const unsigned ah0 = cvt_pk_bf16(a0[0], a0[1]), ah1 = cvt_pk_bf16(a0[2], a0[3]), ah2 = cvt_pk_bf16(a1[0], a1[1]), ah3 = cvt_pk_bf16(a1[2], a1[3]);
                const unsigned al0 = cvt_pk_bf16(a0[0] - bflo(ah0), a0[1] - bfhi(ah0)), al1 = cvt_pk_bf16(a0[2] - bflo(ah1), a0[3] - bfhi(ah1)), al2 = cvt_pk_bf16(a1[0] - bflo(ah2), a1[1] - bfhi(ah2)), al3 = cvt_pk_bf16(a1[2] - bflo(ah3), a1[3] - bfhi(ah3));
                const unsigned bh0 = cvt_pk_bf16(b[0], b[1]), bh1 = cvt_pk_bf16(b[2], b[3]), bh2 = cvt_pk_bf16(b[4], b[5]), bh3 = cvt_pk_bf16(b[6], b[7]);
                const unsigned bl0 = cvt_pk_bf16(b[0] - bflo(bh0), b[1] - bfhi(bh0)), bl1 = cvt_pk_bf16(b[2] - bflo(bh1), b[3] - bfhi(bh1)), bl2 = cvt_pk_bf16(b[4] - bflo(bh2), b[5] - bfhi(bh2)), bl3 = cvt_pk_bf16(b[6] - bflo(bh3), b[7] - bfhi(bh3));
                const bf16x8 ah = mk_bf16x8(ah0, ah1, ah2, ah3), al = mk_bf16x8(al0, al1, al2, al3), bh = mk_bf16x8(bh0, bh1, bh2, bh3), bl = mk_bf16x8(bl0, bl1, bl2, bl3);
                acc = __builtin_amdgcn_mfma_f32_32x32x16_bf16(ah, bh, acc, 0, 0, 0);
                acc = __builtin_amdgcn_mfma_f32_32x32x16_bf16(ah, bl, acc, 0, 0, 0);
                acc = __builtin_amdgcn_mfma_f32_32x32x16_bf16(al, bh, acc, 0, 0, 0);
            }
            LDS_WAIT(); asm volatile("" ::: "memory");
        }
#pragma unroll
        for (int r = 0; r < 16; ++r) red[(wid * 32 + crow(r, hi)) * 32 + q] = acc[r];
        __syncthreads();
        for (int o = tid; o < 640; o += 512) { const int cb = o >> 5, n = o & 31; float s = bmod[l * MODW + 32 * nb + n];
#pragma unroll
            for (int w8 = 0; w8 < 8; ++w8) s += red[(w8 * 32 + cb) * 32 + n];
            ((GAS float*)MOD)[((size_t)l * NCB + cb) * MODW + 32 * nb + n] = s; }
        __syncthreads();
    }
}

constexpr int CONV_PER_L = 28160;
__device__ __forceinline__ ConvDesc conv_desc(const Args& A, unsigned char* ws, int l, int it, int lane) {
    int r = it;
    const float* W; int K, N; bf16* WT; int mode = 0;
    int rb0 = 0;
    if (r < 2560) { W = A.in[12] + (size_t)l * 2048 * 2560; K = 2048; N = 2560; WT = (bf16*)(ws + WS_W1 + l * SZ_W1); mode = 3; }
    else if ((r -= 2560) < 4096) { W = A.in[26] + (size_t)l * 2048 * 4096; K = 2048; N = 4096; WT = (bf16*)(ws + WS_W1 + l * SZ_W1); rb0 = 2560; }
    else if ((r -= 4096) < 512) { W = A.in[21] + (size_t)l * 1024 * 1024; K = 1024; N = 1024; WT = (bf16*)(ws + WS_WGLU + l * SZ_WGLU); }
    else if ((r -= 512) < 1024) { W = A.in[28] + (size_t)l * 1024 * 2048; K = 1024; N = 2048; WT = (bf16*)(ws + WS_WPS + l * SZ_WP); }
    else if ((r -= 1024) < 1024) { W = A.in[29] + (size_t)l * 1024 * 2048; K = 1024; N = 2048; WT = (bf16*)(ws + WS_WPA + l * SZ_WP); }
    else if ((r -= 1024) < 2048) { W = A.in[30] + (size_t)l * 2048 * 2048; K = 2048; N = 2048; WT = (bf16*)(ws + WS_WOUT + l * SZ_WOUT); }
    else if ((r -= 2048) < 5632) { W = A.in[31] + (size_t)l * 2048 * 5632; K = 2048; N = 5632; WT = (bf16*)(ws + WS_WGU + l * SZ_WGU); mode = 1; }
    else if ((r -= 5632) < 5632) { W = A.in[32] + (size_t)l * 2048 * 5632; K = 2048; N = 5632; WT = (bf16*)(ws + WS_WGU + l * SZ_WGU); mode = 2; }
    else { r -= 5632; W = A.in[33] + (size_t)l * 5632 * 2048; K = 5632; N = 2048; WT = (bf16*)(ws + WS_WDN + l * SZ_WDN); }
    const int nblk = N / 32, kb = r / nblk, nb = r % nblk, k0 = 64 * kb, n0 = 32 * nb;
    const int rowbase = mode == 0 ? rb0 + n0 : mode == 3 ? ((n0 >= 1024 && n0 < 2304) ? (n0 & ~255) + 128 * ((n0 >> 5) & 1) + 32 * ((n0 >> 6) & 3) : n0)
                                  : 256 * (n0 >> 7) + (n0 & 127) + (mode == 2 ? 128 : 0);
    ConvDesc d; d.src = W + (size_t)(k0 + (lane >> 3)) * N + n0 + 4 * (lane & 7); d.dst = WT + (size_t)rowbase * K + k0; d.N = N; d.K = K; return d;
}
__device__ __forceinline__ void conv_items(const Args& A, unsigned char* ws, LAS unsigned char* lds, int wid, int lane, int l, int r0, int r1, int pw, int npw) {
    LAS float* scr = (LAS float*)(lds + RING_OFF + wid * 16384);
    int it = r0 + pw; if (it >= r1) return;
    ConvDesc dn = conv_desc(A, ws, l, it, lane); f32x4 vn[8]; conv_load(dn, vn);
    for (;;) {
        const ConvDesc dc = dn; f32x4 vc[8];
#pragma unroll
        for (int i = 0; i < 8; ++i) vc[i] = vn[i];
        it += npw; const bool more = it < r1;
        if (more) { dn = conv_desc(A, ws, l, it, lane); conv_load(dn, vn); }
        conv_store(dc, vc, scr, lane);
        if (!more) break;
    }
}
__device__ __forceinline__ void backfill(const Args& A, unsigned char* ws, LAS unsigned char* lds, int tid, int wid, int lane, int G, int bx, int c0, int lm, int t0, int t1, int lc, int r0, int r1) {
    if (!BACKFILL) return;
    if (c0 >= G) c0 = 0;
    if (bx < c0) return;
    const int pc = bx - c0, npc = G - c0;
    if (lm < NL) p0_mod(lds, tid, wid, lane, lm * 384 + t0 + pc, lm * 384 + t1, npc, A.in[6], A.in[7], A.in[8], A.in[9], (float*)(ws + WS_MOD));
    if (lc < NL) conv_items(A, ws, lds, wid, lane, lc, r0, r1, pc * NWAVES + wid, npc * NWAVES);
    __syncthreads();
}
__device__ __forceinline__ void p0_prologue(const Args& A, LAS unsigned char* lds, int tid, int wid, int lane, int G, int bx) {
    unsigned char* ws = A.ws;
    const int gw = bx * NWAVES + wid, NGW = G * NWAVES;
    { const int N4 = NL * 16 * 64 * 256 / 4;
      for (int i = bx * 512 + tid; i < 2 * N4; i += G * 512) { const int kv = i >= N4, j = kv ? i - N4 : i; const int lb = j / 4096, w = j % 4096;
          const f32x4 v = *((const f32x4*)A.in[2 + kv] + (size_t)lb * 8192 + 4096 + w); *((f32x4*)(A.out + (kv ? O_SV : O_SK)) + (size_t)lb * 8192 + w) = v; } }
    { float* LAM = (float*)(ws + WS_LAM); bf16* BB = (bf16*)(ws + WS_BBAR); bf16* CM = (bf16*)(ws + WS_CM);
      for (int idx = bx * 512 + tid; idx < NL * 4096; idx += G * 512) {
          const int lg = idx >> 6, p = idx & 63;
          const double dt = exp((double)A.in[15][lg]);
          const double are = (double)A.in[13][idx], aim = (double)A.in[14][idx];
          const double zre = are * dt, zim = aim * dt, mag = exp(zre);
          double s, c; sincos_d(zim, s, c);
          const double lre = mag * c, lim = mag * s;
          const double mag64 = exp(64.0 * zre); double s64, c64; sincos_d(64.0 * zim, s64, c64);
          *(f32x4*)(LAM + (size_t)idx * 4) = (f32x4){(float)lre, (float)lim, (float)(mag64 * c64), (float)(mag64 * s64)};
          const double den = are * are + aim * aim, nre = lre - 1.0;
          const double fre = (nre * are + lim * aim) / den, fim = (lim * are - nre * aim) / den;
          const float* bre = A.in[16] + (size_t)idx * 16; const float* bim = A.in[17] + (size_t)idx * 16;
          bf16* b0 = BB + ((size_t)lg * 128 + 2 * p) * 16;
#pragma unroll
          for (int ch = 0; ch < 16; ++ch) { const double br = (double)bre[ch], bi = (double)bim[ch];
              b0[ch] = (bf16)f2bf((float)(fre * br - fim * bi)); b0[16 + ch] = (bf16)f2bf((float)(fre * bi + fim * br)); }
#pragma unroll
          for (int ch = 0; ch < 16; ++ch) { const size_t ci = ((size_t)lg * 16 + ch) * 64 + p; bf16* cd = CM + ((size_t)lg * 16 + ch) * 128 + 2 * p;
              cd[0] = (bf16)f2bf(A.in[18][ci]); cd[1] = (bf16)f2bf(-A.in[19][ci]); }
      } }
    { float* RT = (float*)(ws + WS_ROPE);
      for (int e = bx * 512 + tid; e < 2112 * 8; e += G * 512) { const int pos = e >> 3, i = e & 7;
          const double inv = exp(-((double)i / 8.0) * 13.122363377404328  ); double s, c; sincos_d((double)pos * inv, s, c);
          RT[pos * 16 + i] = (float)c; RT[pos * 16 + 8 + i] = (float)s; } }
    p0_mod(lds, tid, wid, lane, bx, (BACKFILL ? 1 : NL) * 384, G, A.in[6], A.in[7], A.in[8], A.in[9], (float*)(ws + WS_MOD));
    if (BACKFILL) { conv_items(A, ws, lds, wid, lane, 0, 0, 6656, gw, NGW); conv_items(A, ws, lds, wid, lane, 0, 11264, 15360, gw, NGW); }
    else for (int l = 0; l < NL; ++l) conv_items(A, ws, lds, wid, lane, l, 0, CONV_PER_L, gw, NGW);
}

__device__ __forceinline__ void norm_row(int row, int lane, bf16* XB, const float* xin_p, const float* xin_s, const bf16* SL, const float* gn, const float* modl, int sh_off, int sc_off, bf16* H) {
    const int cb = row < TPR ? (row >> 11) : 4 + ((row - TPR) >> 6);
    GAS v4u* xr = (GAS v4u*)(XB + (size_t)row * DM) + lane;
    f32x4 v[8]; float s = 0.f;
    bool wb = false;
    if (xin_p != nullptr) {
        const GAS f32x4* xi = (const GAS f32x4*)(row < TPR ? xin_p + (size_t)row * DM : xin_s + (size_t)(row - TPR) * DM) + 2 * lane;
#pragma unroll
        for (int j = 0; j < 4; ++j) { v[2 * j] = xi[128 * j]; v[2 * j + 1] = xi[128 * j + 1]; }
        wb = true;
    } else {
#pragma unroll
        for (int j = 0; j < 4; ++j) pg8::unpack8(xr[64 * j], v[2 * j], v[2 * j + 1]);
    }
    if (SL != nullptr && row >= TPR) {
        const GAS v4u* sp = (const GAS v4u*)(SL + (size_t)(row - TPR) * DM) + lane;
        v4u sr[8][4];
#pragma unroll
        for (int sl = 0; sl < 8; ++sl)
#pragma unroll
            for (int j = 0; j < 4; ++j) sr[sl][j] = sp[(size_t)sl * (1024 * DM / 8) + 64 * j];
#pragma unroll
        for (int sl = 0; sl < 8; ++sl)
#pragma unroll
            for (int j = 0; j < 4; ++j) { f32x4 a0, a1; pg8::unpack8(sr[sl][j], a0, a1); v[2 * j] = v[2 * j] + a0; v[2 * j + 1] = v[2 * j + 1] + a1; }
        wb = true;
    }
    if (wb) {
#pragma unroll
        for (int j = 0; j < 4; ++j) { const v4u w = pg8::pack8(v[2 * j], v[2 * j + 1]); xr[64 * j] = w; pg8::unpack8(w, v[2 * j], v[2 * j + 1]); }
    }
#pragma unroll
    for (int j = 0; j < 8; ++j) s += (v[j].x * v[j].x + v[j].y * v[j].y) + (v[j].z * v[j].z + v[j].w * v[j].w);
    const float rstd = 1.0f / sqrtf(wave_sum(s) * (1.0f / DM) + 1e-6f);
    const float* mrow = modl + (size_t)cb * MODW;
    GAS v4u* o16 = (GAS v4u*)(H + (size_t)row * DM) + lane;
#pragma unroll
    for (int j = 0; j < 4; ++j) { const int col = 8 * lane + 512 * j; f32x4 o[2];
#pragma unroll
        for (int h2 = 0; h2 < 2; ++h2) { const f32x4 g = *(const GAS f32x4*)(gn + col + 4 * h2), sc = *(const GAS f32x4*)(mrow + sc_off + col + 4 * h2), sh = *(const GAS f32x4*)(mrow + sh_off + col + 4 * h2);
            o[h2] = v[2 * j + h2] * rstd * g * (1.0f + sc) + sh; }
        o16[64 * j] = pg8::pack8(o[0], o[1]); }
}
__device__ __forceinline__ void norm_phase(int gw, int NGW, int lane, bf16* XB, const float* xin_p, const float* xin_s, const bf16* SL, const float* gn, const float* modl, int sh_off, int sc_off, bf16* H) {
    const bool xcd_deal = (NGW == 2048);
    const int bxw = gw >> 3, widw = gw & 7, xq = bxw & 7, jq = bxw >> 3;
    if (xcd_deal && xin_p == nullptr) {
        const int row0 = 1024 * xq + 32 * jq + 4 * widw, cb = row0 >> 11;
        v4u raw[4][4];
#pragma unroll
        for (int ri = 0; ri < 4; ++ri)
#pragma unroll
            for (int j = 0; j < 4; ++j) raw[ri][j] = ((const GAS v4u*)(XB + (size_t)(row0 + ri) * DM) + lane)[64 * j];
        const float* mrow = modl + (size_t)cb * MODW;
        f32x4 Am[8], Sh[8];
#pragma unroll
        for (int j = 0; j < 4; ++j)
#pragma unroll
            for (int h2 = 0; h2 < 2; ++h2) { const int col = 8 * lane + 512 * j + 4 * h2; const f32x4 g = *(const GAS f32x4*)(gn + col), sc = *(const GAS f32x4*)(mrow + sc_off + col); Sh[2 * j + h2] = *(const GAS f32x4*)(mrow + sh_off + col);
                Am[2 * j + h2] = g * (1.0f + sc); }
#pragma unroll
        for (int ri = 0; ri < 4; ++ri) {
            f32x4 v[8]; float s = 0.f;
#pragma unroll
            for (int j = 0; j < 4; ++j) pg8::unpack8(raw[ri][j], v[2 * j], v[2 * j + 1]);
#pragma unroll
            for (int j = 0; j < 8; ++j) s += (v[j].x * v[j].x + v[j].y * v[j].y) + (v[j].z * v[j].z + v[j].w * v[j].w);
            const float rstd = 1.0f / sqrtf(wave_sum(s) * (1.0f / DM) + 1e-6f);
            GAS v4u* o16 = (GAS v4u*)(H + (size_t)(row0 + ri) * DM) + lane;
#pragma unroll
            for (int j = 0; j < 4; ++j) o16[64 * j] = pg8::pack8(v[2 * j] * rstd * Am[2 * j] + Sh[2 * j], v[2 * j + 1] * rstd * Am[2 * j + 1] + Sh[2 * j + 1]);
        }
        if (widw < 4) norm_row(TPR + 4 * bxw + widw, lane, XB, xin_p, xin_s, SL, gn, modl, sh_off, sc_off, H);
        return;
    }
    const int nrows = xcd_deal ? (widw < 4 ? 5 : 4) : (NTOK - gw + NGW - 1) / NGW;
    for (int ri = 0; ri < nrows; ++ri) {
        const int row = xcd_deal ? (ri < 4 ? 1024 * xq + 32 * jq + 4 * widw + ri : TPR + 4 * bxw + widw) : gw + ri * NGW;
        norm_row(row, lane, XB, xin_p, xin_s, SL, gn, modl, sh_off, sc_off, H);
    }
}
__device__ __forceinline__ void final_phase(int gw, int NGW, int lane, float* X, const bf16* XB, const bf16* SL) {
    for (int row = TPR + gw; row < NTOK; row += NGW) {
        GAS f32x4* xo = (GAS f32x4*)(X + (size_t)row * DM) + 2 * lane; const GAS v4u* xr = (const GAS v4u*)(XB + (size_t)row * DM) + lane; const GAS v4u* sp = (const GAS v4u*)(SL + (size_t)(row - TPR) * DM) + lane;
        f32x4 v[8];
#pragma unroll
        for (int j = 0; j < 4; ++j) pg8::unpack8(xr[64 * j], v[2 * j], v[2 * j + 1]);
        v4u sr[8][4];
#pragma unroll
        for (int sl = 0; sl < 8; ++sl)
#pragma unroll
            for (int j = 0; j < 4; ++j) sr[sl][j] = sp[(size_t)sl * (1024 * DM / 8) + 64 * j];
#pragma unroll
        for (int sl = 0; sl < 8; ++sl)
#pragma unroll
            for (int j = 0; j < 4; ++j) { f32x4 a0, a1; pg8::unpack8(sr[sl][j], a0, a1); v[2 * j] = v[2 * j] + a0; v[2 * j + 1] = v[2 * j + 1] + a1; }
#pragma unroll
        for (int j = 0; j < 4; ++j) { xo[128 * j] = v[2 * j]; xo[128 * j + 1] = v[2 * j + 1]; }
    }
}

constexpr int SSM_ROWB = 528;
constexpr int SSM_WSCR = 16 * SSM_ROWB;
template <bool FULL>
__device__ __forceinline__ void ssm_subblock(LAS unsigned char* sb, int lane, bf16x8 uf, const bf16x8 (&af)[8], const bf16x8 (&cf)[4], float lre, float lim, float& hre, float& him,
                                             f32x4 dsk, v2u uraw, bf16* zdst, bool dost = true) {
    const int tok = lane & 15, q = lane >> 4;
#pragma unroll
    for (int nt = 0; nt < 8; ++nt) { const f32x4 d = __builtin_amdgcn_mfma_f32_16x16x32_bf16(af[nt], uf, (f32x4){0.f, 0.f, 0.f, 0.f}, 0, 0, 0);
        *(LAS f32x4*)(sb + tok * SSM_ROWB + nt * 64 + q * 16) = d; }
    f32x2 bu[16]; unsigned hp[16];
#pragma unroll
    for (int t = 0; t < 16; ++t) bu[t] = *(const LAS f32x2*)(sb + t * SSM_ROWB + 8 * lane);
    f32x2 hv = (f32x2){hre, him}; const f32x2 Lp = (f32x2){lre, lim};
#pragma unroll
    for (int t = 0; t < 16; ++t) {
        f32x2 tt;
        asm("v_pk_fma_f32 %0, %1, %2, %3 op_sel:[1,1,0] op_sel_hi:[1,0,1] neg_lo:[1,0,0]" : "=v"(tt) : "v"(Lp), "v"(hv), "v"(bu[t]));
        asm("v_pk_fma_f32 %0, %1, %2, %3 op_sel:[0,0,0] op_sel_hi:[0,1,1]" : "=v"(hv) : "v"(Lp), "v"(hv), "v"(tt));
        if (FULL) hp[t] = cvt_pk_bf16(hv.x, hv.y); }
    hre = hv.x; him = hv.y;
    if (FULL) {
#pragma unroll
        for (int t = 0; t < 16; ++t) *(LAS unsigned*)(sb + t * SSM_ROWB + 4 * lane) = hp[t]; }
    if (FULL) {
        f32x4 y = (f32x4){0.f, 0.f, 0.f, 0.f};
#pragma unroll
        for (int ks = 0; ks < 4; ++ks) { const bf16x8 hf = *(const LAS bf16x8*)(sb + tok * SSM_ROWB + ks * 64 + q * 16); y = __builtin_amdgcn_mfma_f32_16x16x32_bf16(cf[ks], hf, y, 0, 0, 0); }
        const f32x4 uv = (f32x4){bflo(uraw.x), bfhi(uraw.x), bflo(uraw.y), bfhi(uraw.y)};
        y = y + dsk * uv;
        f32x4 z;
#pragma unroll
        for (int i = 0; i < 4; i += 2) {
            const f32x2 v = (f32x2){y[i], y[i + 1]};
            const f32x2 k2 = (v * v * 0.044715f + 1.0f) * v * (-1.5957691216057308f * 1.4426950408889634f);
            f32x2 e; e.x = __builtin_amdgcn_exp2f(k2.x); e.y = __builtin_amdgcn_exp2f(k2.y);
            const f32x2 d = e + 1.0f; f32x2 r; r.x = __builtin_amdgcn_rcpf(d.x); r.y = __builtin_amdgcn_rcpf(d.y);
            const f32x2 zz = v * r; z[i] = zz.x; z[i + 1] = zz.y; }
        v2u w; w.x = cvt_pk_bf16(z[0], z[1]); w.y = cvt_pk_bf16(z[2], z[3]); if (dost) *(GAS v2u*)zdst = w;
    }
}
template <bool FULL>
__device__ __forceinline__ void ssm_chunk(LAS unsigned char* sb, int lane, const bf16x8 (&uc)[4], const v2u (&ur)[4], const bf16x8 (&af)[8], const bf16x8 (&cf)[4], float lre, float lim, float& hre, float& him,
                                          f32x4 dsk, bf16* Z, size_t row0, int g, bool dost = true) {
    const int tok = lane & 15, q = lane >> 4;
#pragma unroll
    for (int s = 0; s < 4; ++s) ssm_subblock<FULL>(sb, lane, uc[s], af, cf, lre, lim, hre, him, dsk, ur[s], Z + (row0 + 16 * s + tok) * 1024 + 16 * g + 4 * q, dost);
}
__device__ __forceinline__ void ssm_load_u(const bf16* P, size_t row0, int g, int lane, bf16x8 (&u)[4], v2u (&ur)[4], bool full) {
    const int tok = lane & 15, q = lane >> 4;
#pragma unroll
    for (int s = 0; s < 4; ++s) { const bf16* rp = P + (row0 + 16 * s + tok) * NPJ + 16 * g;
        u[s] = q < 2 ? *(const GAS bf16x8*)(rp + 8 * q) : mk_bf16x8(0u, 0u, 0u, 0u);
        ur[s] = full ? *(const GAS v2u*)(rp + 4 * q) : (v2u){0u, 0u}; }
}
__device__ __forceinline__ void ssm_phase(LAS unsigned char* lds, int tid, int wid, int lane, int G, int bx, int l, const Args& A, const bf16* P, bf16* Z) {
    LAS unsigned char* sb = lds + wid * SSM_WSCR;
    LAS f32x2* Sloc = (LAS f32x2*)(lds + 8 * SSM_WSCR);
    const unsigned char* ws = A.ws;
    const int i16 = lane & 15, kb = lane >> 4;
    const int vcu = (G == 256) ? ((bx & 7) >> 1) * 64 + (bx & 1) * 32 + (bx >> 3) : bx;
    for (int unit = vcu; unit < 256; unit += G) {
        const int b = unit >> 6, g = unit & 63, lg = l * 64 + g;
        bf16x8 af[8], cf[4];
        { const bf16* BB = (const bf16*)(ws + WS_BBAR) + (size_t)lg * 128 * 16; const bf16* CM = (const bf16*)(ws + WS_CM) + (size_t)lg * 16 * 128;
#pragma unroll
          for (int nt = 0; nt < 8; ++nt) af[nt] = kb < 2 ? *(const bf16x8*)(BB + (16 * nt + i16) * 16 + 8 * kb) : mk_bf16x8(0u, 0u, 0u, 0u);
#pragma unroll
          for (int ks = 0; ks < 4; ++ks) cf[ks] = *(const bf16x8*)(CM + i16 * 128 + 32 * ks + 8 * kb); }
        const f32x4 lam = *(const f32x4*)((const float*)(ws + WS_LAM) + ((size_t)lg * 64 + lane) * 4);
        const f32x4 dsk = *(const f32x4*)(A.in[20] + (size_t)l * 1024 + 16 * g + 4 * kb);
        const size_t rowb = (size_t)b * 2048 + (size_t)wid * 256;
#ifndef PROBE_SSM
#define PROBE_SSM 0
#endif
        for (int rp1 = 0; rp1 < (PROBE_SSM == 3 ? 2 : 1); ++rp1)
        { bf16x8 un[4]; v2u rn[4]; ssm_load_u(P, rowb, g, lane, un, rn, false);
#pragma unroll 1
          for (int ci = 0; ci < 4; ++ci) { bf16x8 uc[4]; v2u rc[4];
#pragma unroll
              for (int s = 0; s < 4; ++s) { uc[s] = un[s]; rc[s] = rn[s]; }
              if (ci < 3) ssm_load_u(P, rowb + 64 * (ci + 1), g, lane, un, rn, false);
              float hre = 0.f, him = 0.f;
              for (int rp2 = 0; rp2 < (PROBE_SSM == 4 ? 2 : 1); ++rp2) { hre = 0.f; him = 0.f; asm volatile("" : "+v"(hre), "+v"(him));
              ssm_chunk<false>(sb, lane, uc, rc, af, cf, lam.x, lam.y, hre, him, dsk, Z, rowb + 64 * ci, g); }
              Sloc[(4 * wid + ci) * 64 + lane] = (f32x2){hre, him}; } }
        bf16x8 un[4]; v2u rn[4]; ssm_load_u(P, rowb, g, lane, un, rn, true);
        const int sbt = 4 * b + (wid & 3); const size_t so = ((size_t)(l * 16 + sbt) * 64 + g) * 64 + lane; const size_t srow0 = (size_t)TPR + (size_t)sbt * 64;
        bf16x8 us[4]; v2u rs[4]; float sre = 0.f, sim = 0.f;
        if (wid < 4) { ssm_load_u(P, srow0, g, lane, us, rs, true); sre = *(const GAS float*)(A.in[4] + so); sim = *(const GAS float*)(A.in[5] + so); }
        else {
#pragma unroll
            for (int s = 0; s < 4; ++s) { us[s] = mk_bf16x8(0u, 0u, 0u, 0u); rs[s] = (v2u){0u, 0u}; } }
        __syncthreads();
        float hre = 0.f, him = 0.f;
#pragma unroll 4
        for (int c = 0; c < 4 * wid; ++c) { const f32x2 s = Sloc[c * 64 + lane]; const float nre = lam.z * hre - lam.w * him + s.x, nim = lam.z * him + lam.w * hre + s.y; hre = nre; him = nim; }
        {
#pragma unroll 1
          for (int ci = 0; ci < 4; ++ci) { bf16x8 uc[4]; v2u rc[4];
#pragma unroll
              for (int s = 0; s < 4; ++s) { uc[s] = un[s]; rc[s] = rn[s]; }
              if (ci < 3) ssm_load_u(P, rowb + 64 * (ci + 1), g, lane, un, rn, true);
              ssm_chunk<true>(sb, lane, uc, rc, af, cf, lam.x, lam.y, hre, him, dsk, Z, rowb + 64 * ci, g); } }
        if (wid == 7) { const size_t o = ((size_t)(l * 4 + b) * 64 + g) * 64 + lane; A.out[O_PSR + o] = hre; A.out[O_PSI + o] = him; }
        if (wid < 4) {
            ssm_chunk<true>(sb, lane, us, rs, af, cf, lam.x, lam.y, sre, sim, dsk, Z, srow0, g);
            A.out[O_SSR + so] = sre; A.out[O_SSI + so] = sim; }
        __syncthreads();
    }
}

constexpr int AT_KROW = 144, AT_VROW = 392, AT_K = 0, AT_V = 27648, AT_O = 53248, AT_OW = 4608;
__device__ __forceinline__ void attn_unit(LAS unsigned char* lds, int tid, int wid, int lane, int cbk, int hk, const bf16* P, const bf16* QN, const bf16* KN, const float* ck_l, const float* cv_l, const float* sink_l, bf16* AO) {
    LAS unsigned char* Kl = lds + AT_K; LAS unsigned char* Vt = lds + AT_V; LAS unsigned char* Os = lds + AT_O + wid * AT_OW;
    const bool smp = cbk >= 128; const int c = cbk & 31;
    const int kt0 = smp ? 0 : (c >= 2 ? 0 : (c == 1 ? 2 : 4));
    const int q = lane & 31, hi = lane >> 5, rr = wid >> 1, tok0 = 32 * (wid & 1), h = 4 * hk + rr;
    const size_t qrow = (size_t)cbk * 64 + tok0 + q;
    bf16x8 qr[4];
#pragma unroll
    for (int d0 = 0; d0 < 4; ++d0) qr[d0] = *(const GAS bf16x8*)(QN + qrow * 1024 + h * 64 + 16 * d0 + 8 * hi);
    const float sink_h = *(const GAS float*)(sink_l + h);
#pragma unroll
    for (int j = 0; j < 3; ++j) { const int ci = tid + 512 * j, kk = ci >> 3, c8 = ci & 7; v4u kw, vw;
        if (kk < 32 * kt0) { kw = (v4u){0u, 0u, 0u, 0u}; vw = kw; }
        else if (smp && kk < 128) { const size_t so = (((size_t)(cbk - 128) * 128 + kk) * 4 + hk) * 64 + 8 * c8;
            kw = pg8::pack8(*(const f32x4*)(ck_l + so), *(const f32x4*)(ck_l + so + 4)); vw = pg8::pack8(*(const f32x4*)(cv_l + so), *(const f32x4*)(cv_l + so + 4)); }
        else { const size_t grow = (size_t)((cbk - 2) * 64 + kk); kw = *(const GAS v4u*)(KN + grow * 256 + hk * 64 + 8 * c8); vw = *(const GAS v4u*)(P + grow * NPJ + 2304 + hk * 64 + 8 * c8); }
        *(LAS v4u*)(Kl + kk * AT_KROW + 16 * c8) = kw;
        LAS unsigned char* vp = Vt + (8 * c8) * AT_VROW + 2 * kk;
        *(LAS unsigned short*)(vp + 0 * AT_VROW) = (unsigned short)(vw.x & 0xffffu); *(LAS unsigned short*)(vp + 1 * AT_VROW) = (unsigned short)(vw.x >> 16);
        *(LAS unsigned short*)(vp + 2 * AT_VROW) = (unsigned short)(vw.y & 0xffffu); *(LAS unsigned short*)(vp + 3 * AT_VROW) = (unsigned short)(vw.y >> 16);
        *(LAS unsigned short*)(vp + 4 * AT_VROW) = (unsigned short)(vw.z & 0xffffu); *(LAS unsigned short*)(vp + 5 * AT_VROW) = (unsigned short)(vw.z >> 16);
        *(LAS unsigned short*)(vp + 6 * AT_VROW) = (unsigned short)(vw.w & 0xffffu); *(LAS unsigned short*)(vp + 7 * AT_VROW) = (unsigned short)(vw.w >> 16); }
    __syncthreads();
    f32x16 p[6];
#pragma unroll
    for (int T = 0; T < 6; ++T) {
#pragma unroll
        for (int r = 0; r < 16; ++r) p[T][r] = 0.f;
#pragma unroll
        for (int d0 = 0; d0 < 4; ++d0) { const bf16x8 kf = *(const LAS bf16x8*)(Kl + (32 * T + q) * AT_KROW + (16 * d0 + 8 * hi) * 2); p[T] = __builtin_amdgcn_mfma_f32_32x32x16_bf16(kf, qr[d0], p[T], 0, 0, 0); } }
    const float SC = 0.125f * 1.4426950408889634f, sk2 = sink_h * 1.4426950408889634f;
    float mr = -3.0e38f;
#pragma unroll
    for (int T = 0; T < 6; ++T) if (T >= kt0) {
#pragma unroll
        for (int r = 0; r < 16; r += 2) mr = __builtin_fmaxf(__builtin_fmaxf(mr, p[T][r]), p[T][r + 1]); }
    mr = fmaxf(mr, __shfl_xor(mr, 32));
    const float m = fmaxf(mr * SC, sk2), nm = -m;
    float sum = 0.f;
#pragma unroll
    for (int T = 0; T < 6; ++T) {
        if (T >= kt0) {
#pragma unroll
            for (int r = 0; r < 16; ++r) { const float e = __builtin_amdgcn_exp2f(__builtin_fmaf(p[T][r], SC, nm)); p[T][r] = e; sum += e; }
        } else {
#pragma unroll
            for (int r = 0; r < 16; ++r) p[T][r] = 0.f;
        } }
    sum += __shfl_xor(sum, 32);
    const float inv = 1.0f / (sum + __builtin_amdgcn_exp2f(sk2 - m));
    f32x16 o[2];
#pragma unroll
    for (int r = 0; r < 16; ++r) { o[0][r] = 0.f; o[1][r] = 0.f; }
#pragma unroll
    for (int T = 0; T < 6; ++T)
#pragma unroll
        for (int s = 0; s < 2; ++s) {
            const bf16x8 pa = mk_bf16x8(cvt_pk_bf16(p[T][8 * s + 0], p[T][8 * s + 1]), cvt_pk_bf16(p[T][8 * s + 2], p[T][8 * s + 3]), cvt_pk_bf16(p[T][8 * s + 4], p[T][8 * s + 5]), cvt_pk_bf16(p[T][8 * s + 6], p[T][8 * s + 7]));
#pragma unroll
            for (int dt = 0; dt < 2; ++dt) { const LAS unsigned char* vp = Vt + (32 * dt + q) * AT_VROW + 2 * (32 * T + 16 * s + 4 * hi);
                const v2u lo = *(const LAS v2u*)vp, hh = *(const LAS v2u*)(vp + 16);
                o[dt] = __builtin_amdgcn_mfma_f32_32x32x16_bf16(pa, mk_bf16x8(lo.x, lo.y, hh.x, hh.y), o[dt], 0, 0, 0); } }
#pragma unroll
    for (int r = 0; r < 16; ++r) { const int qq = crow(r, hi); const float iv = __shfl(inv, qq);
        *(LAS unsigned short*)(Os + qq * 144 + 2 * q) = (unsigned short)f2bf(o[0][r] * iv);
        *(LAS unsigned short*)(Os + qq * 144 + 2 * (32 + q)) = (unsigned short)f2bf(o[1][r] * iv); }
#pragma unroll
    for (int j = 0; j < 4; ++j) { const int qq = (lane >> 3) + 8 * j, c8 = lane & 7;
        const v4u w = *(const LAS v4u*)(Os + qq * 144 + 16 * c8);
        *(GAS v4u*)(AO + ((size_t)cbk * 64 + tok0 + qq) * 1024 + h * 64 + 8 * c8) = w; }
    __syncthreads();
}

__global__ void __launch_bounds__(NWAVES * 64, 2) enc_fwd(Args args) {
    extern __shared__ __attribute__((aligned(16))) unsigned char lds_raw[];
    LAS unsigned char* lds = (LAS unsigned char*)lds_raw;
    volatile LAS unsigned* MISC = (volatile LAS unsigned*)(lds + MISC_OFF);
    const int wid = __builtin_amdgcn_readfirstlane((int)threadIdx.x >> 6);
    const int G = gridDim.x, bx = blockIdx.x;
    const int gw = bx * NWAVES + wid, NGW = G * NWAVES;
#define MODL ((const float*)(ws + WS_MOD) + (size_t)l * NCB * MODW)
#define FRESH_LANE() int tid_f = threadIdx.x; asm volatile("" : "+v"(tid_f)); const int tid = tid_f, lane = tid & 63; (void)tid; (void)lane
    unsigned char* ws0 = args.ws;
    for (int u = threadIdx.x; u < (LDS_BYTES - LDSCTL_OFF) / 4; u += NWAVES * 64) ((LAS unsigned*)(lds + LDSCTL_OFF))[u] = 0u;
    __syncthreads();
    XcdBarrier bar; bar.bar = (unsigned*)(ws0 + WS_CTL) + CW_BAR; bar.x = 0; bar.st = nullptr;
    if (MK_ONE_LAUNCH) bar = xcd_barrier_post((unsigned*)(ws0 + WS_CTL) + CW_BAR, MISC + 8);
    const int lo = args.ph_lo, hi = args.ph_hi;
#ifndef DISABLE
#define DISABLE 0
#endif
#define IN(k) (lo <= (k) && (k) < hi)
#define EN(i) (((DISABLE >> (i)) & 1) == 0)
#ifndef PROBE_REP
#define PROBE_REP 0
#endif
#ifndef PROBE_L
#define PROBE_L -1
#endif
#define NREP(i) ((((PROBE_REP >> (i)) & 1) && ((i) == 0 || PROBE_L < 0 || l == PROBE_L)) ? 2 : 1)
#ifndef PROBE_BAR
#define PROBE_BAR 1
#endif
#define SEAM(k) do { if (IN((k) + 1)) { for (int nb_ = 0; nb_ < PROBE_BAR; ++nb_) xcd_barrier(bar); } } while (0)
#define H   ((bf16*)(ws + WS_H))
#define P   ((bf16*)(ws + WS_P))
#define QN  ((bf16*)(ws + WS_QN))
#define KN  ((bf16*)(ws + WS_KN))
#define Z   ((bf16*)(ws + WS_Z))
#define SO  ((bf16*)(ws + WS_SO))
#define AO  ((bf16*)(ws + WS_AO))
#define T1  ((bf16*)(ws + WS_T1))
#define MX  ((bf16*)(ws + WS_MX))
#define ACT ((bf16*)(ws + WS_ACT))
#define X   (args.out + O_Y)
#define XB  ((bf16*)(ws + WS_XB))
#define SL  ((bf16*)(ws + WS_SL))
#define FRESH_WS() unsigned char* ws = args.ws; asm volatile("" : "+s"(ws))

#ifndef MOD_SPLIT
#define MOD_SPLIT 112
#endif
#ifndef PROBE_ALL
#define PROBE_ALL 1
#endif
#pragma unroll 1
    for (int pass_ = 0; pass_ < PROBE_ALL; ++pass_) {
    if (EN(0) && IN(0)) { const int l = 0; (void)l; for (int rep = 0; rep < NREP(0); ++rep) { FRESH_LANE(); p0_prologue(args, lds, tid, wid, lane, G, bx); } SEAM(0); }

#pragma unroll 1
    for (int l = 0; l < NL; ++l) {
        const int pb = 1 + 10 * l;
        if (EN(1) && IN(pb + 0)) { for (int rep = 0; rep < NREP(1); ++rep) { FRESH_WS(); FRESH_LANE(); norm_phase(gw, NGW, lane, XB, l == 0 ? args.in[0] : nullptr, args.in[1], l > 0 ? SL : nullptr, args.in[10] + (size_t)l * DM, MODL, 0, 2048, H); } SEAM(pb + 0); }
        if (EN(2) && IN(pb + 1)) { for (int rep = 0; rep < NREP(2); ++rep) { FRESH_WS(); pg8::Gemm g{H, (const bf16*)(ws + WS_W1 + l * SZ_W1), NTOK, 6656, 2048}; pg8::StaticOrder S; S.init(NTOK, 6656, 2048, G, bx);
            pg8::EpiG1 E{P, args.in[27] + (size_t)l * 4096, QN, KN, args.in[23] + l * 64, args.in[24] + l * 64, (const float*)(ws + WS_ROPE), args.out, l, O_PK, O_PV, O_SK, O_SV};
            pg8::gemm_phase<pg8::EpiG1, pg8::StaticOrder, PG8_ALIGN, PG8_SP2>(lds + RING_OFF, g, S, E);
            { FRESH_LANE(); backfill(args, ws, lds, tid, wid, lane, G, bx, 936 - ((936 - 1) / G) * G, l + 1, MOD_SPLIT, 192, l, 6656, 11264); backfill(args, ws, lds, tid, wid, lane, G, bx, 936 - ((936 - 1) / G) * G, NL, 0, 0, l, 15360, 16896); } } SEAM(pb + 1); }
        if (EN(4) && IN(pb + 3)) { for (int rep = 0; rep < NREP(4); ++rep) { FRESH_WS();
#ifndef ATT_IN_GLU
#define ATT_IN_GLU 1
#endif
#ifndef PROBE_SA
#define PROBE_SA 0
#endif
            for (int r2 = 0; r2 < (PROBE_SA == 1 ? 2 : 1); ++r2) { FRESH_LANE(); ssm_phase(lds, tid, wid, lane, G, bx, l, args, P, Z); }
            if (!(ATT_IN_GLU && G == 256)) { FRESH_LANE();
            for (int ai_ = 0; ai_ < 3; ++ai_) { int a = bx + ai_ * G; if (a >= 576) break;
                attn_unit(lds, tid, wid, lane, a >> 2, a & 3, P, QN, KN, args.in[2] + (size_t)l * 16 * 128 * 256, args.in[3] + (size_t)l * 16 * 128 * 256, args.in[25] + l * 16, AO); } }
            } SEAM(pb + 3); }
        if (EN(5) && IN(pb + 4)) { for (int rep = 0; rep < NREP(5); ++rep) { FRESH_WS(); pg8::Gemm g{Z, (const bf16*)(ws + WS_WGLU + l * SZ_WGLU), NTOK, 1024, 1024}; pg8::PanelOrder S; S.init(NTOK, 1024, 1024, G, bx);
            pg8::EpiGLU E{Z, SO, args.in[22] + (size_t)l * 1024};
            pg8::gemm_phase<pg8::EpiGLU, pg8::PanelOrder, PG8_ALIGN, PG8_SP2>(lds + RING_OFF, g, S, E);
            if (ATT_IN_GLU && G == 256) { FRESH_LANE();
                const int j_ = bx >> 3;
                for (int r2 = 0; r2 < (PROBE_SA == 2 ? 2 : 1); ++r2)
                for (int id_ = j_ < 18 ? j_ : 18 + (j_ - 18); id_ < (j_ < 18 ? j_ + 1 : 72); id_ += 14) { const int x_ = bx & 7; const int a = id_ < 64 ? 64 * x_ + id_ : 512 + 8 * x_ + (id_ - 64);
                    attn_unit(lds, tid, wid, lane, a >> 2, a & 3, P, QN, KN, args.in[2] + (size_t)l * 16 * 128 * 256, args.in[3] + (size_t)l * 16 * 128 * 256, args.in[25] + l * 16, AO); } }
            { FRESH_LANE(); backfill(args, ws, lds, tid, wid, lane, G, bx, 144 - ((144 - 1) / G) * G, l + 1, 0, MOD_SPLIT, NL, 0, 0); } } SEAM(pb + 4); }
        if (EN(6) && IN(pb + 5)) { for (int rep = 0; rep < NREP(6); ++rep) { FRESH_WS();
            { pg8::Gemm g{SO, (const bf16*)(ws + WS_WPS + l * SZ_WP), NTOK, 2048, 1024}; pg8::PROrder S; S.init(NTOK, 2048, 1024, G, bx, 0);
              pg8::EpiPR<0> E{P, nullptr, T1, (unsigned*)(ws + WS_CTL + 32768) + (size_t)l * 32 * 64};
              pg8::gemm_phase<pg8::EpiPR<0>, pg8::PROrder, PG8_ALIGN, PG8_SP2>(lds + RING_OFF, g, S, E); }
            VM_WAIT(); __syncthreads();
            { pg8::Gemm g{AO, (const bf16*)(ws + WS_WPA + l * SZ_WP), NTOK, 2048, 1024}; pg8::PROrder S; S.init(NTOK, 2048, 1024, G, bx, 4);
              pg8::EpiPR<1> E{P, T1, MX, (unsigned*)(ws + WS_CTL + 32768) + (size_t)l * 32 * 64};
              pg8::gemm_phase<pg8::EpiPR<1>, pg8::PROrder, PG8_ALIGN, PG8_SP2>(lds + RING_OFF, g, S, E); }
            { FRESH_LANE(); backfill(args, ws, lds, tid, wid, lane, G, bx, G == 256 ? 64 : 288 - ((288 - 1) / G) * G, l + 1, 192, 384, l, 16896, 22528); }
            } SEAM(pb + 5); }
        if (EN(7) && IN(pb + 6)) { for (int rep = 0; rep < NREP(7); ++rep) { FRESH_WS(); pg8::Gemm g{MX, (const bf16*)(ws + WS_WOUT + l * SZ_WOUT), NTOK, 2048, 2048}; pg8::SplitOrder S; S.init(2048, G, bx);
            pg8::EpiRes E{(NREP(7) == 2 && rep == 0) ? (bf16*)(ws + WS_ACT) : XB, nullptr, MODL + 4096, SL};
            pg8::gemm_phase<pg8::EpiRes, pg8::SplitOrder, PG8_ALIGN, PG8_SP2>(lds + RING_OFF, g, S, E); } SEAM(pb + 6); }
        if (EN(8) && IN(pb + 7)) { for (int rep = 0; rep < NREP(8); ++rep) { FRESH_WS(); FRESH_LANE(); norm_phase(gw, NGW, lane, XB, nullptr, nullptr, SL, args.in[11] + (size_t)l * DM, MODL, 6144, 8192, H); } SEAM(pb + 7); }
        if (EN(9) && IN(pb + 8)) { for (int rep = 0; rep < NREP(9); ++rep) { FRESH_WS(); pg8::Gemm g{H, (const bf16*)(ws + WS_WGU + l * SZ_WGU), NTOK, 11264, 2048}; pg8::StaticOrder S; S.init(NTOK, 11264, 2048, G, bx);
            pg8::EpiFU E{ACT};
            pg8::gemm_phase<pg8::EpiFU, pg8::StaticOrder, PG8_ALIGN, PG8_SP2>(lds + RING_OFF, g, S, E);
            { FRESH_LANE(); backfill(args, ws, lds, tid, wid, lane, G, bx, 1584 - ((1584 - 1) / G) * G, NL, 0, 0, l, 22528, CONV_PER_L); backfill(args, ws, lds, tid, wid, lane, G, bx, 1584 - ((1584 - 1) / G) * G, NL, 0, 0, l + 1, 0, 6656); backfill(args, ws, lds, tid, wid, lane, G, bx, 1584 - ((1584 - 1) / G) * G, NL, 0, 0, l + 1, 11264, 15360); } } SEAM(pb + 8); }
        if (EN(10) && IN(pb + 9)) { for (int rep = 0; rep < NREP(10); ++rep) { FRESH_WS(); pg8::Gemm g{ACT, (const bf16*)(ws + WS_WDN + l * SZ_WDN), NTOK, 2048, 5632}; pg8::SplitOrder S; S.init(5632, G, bx);
            pg8::EpiRes E{(NREP(10) == 2 && rep == 0) ? (bf16*)(ws + WS_P) : XB, l == NL - 1 ? X : nullptr, MODL + 10240, SL};
            pg8::gemm_phase<pg8::EpiRes, pg8::SplitOrder, PG8_ALIGN, PG8_SP2>(lds + RING_OFF, g, S, E); } SEAM(pb + 9); }
    }
    if (IN(NPHASE - 1)) { FRESH_WS(); FRESH_LANE(); final_phase(gw, NGW, lane, X, XB, SL); }
    if (pass_ + 1 < PROBE_ALL) xcd_barrier(bar);
    }
#undef IN
#undef SEAM
#undef H
#undef P
#undef QN
#undef KN
#undef Z
#undef SO
#undef AO
#undef T1
#undef MX
#undef ACT
#undef X
#undef XB
#undef SL
}

extern "C" void kernel_launch(void* const* d_in, const int* in_sizes, int n_in, void* d_out, int out_size, void* d_ws, size_t ws_size, hipStream_t stream) {
    static int grid = 0;
    if (grid == 0) {
        if (n_in != 34 || out_size != (int)O_END || ws_size < WS_END) { fprintf(stderr, "kernel_launch: built for 34 inputs, %zu outputs, >= %zu bytes of workspace; got n_in %d, out %d, ws %zu; nothing launched\n", (size_t)O_END, (size_t)WS_END, n_in, out_size, ws_size); grid = -1; return; }
        int dev = 0, cus = 0, per_cu = 0;
        if (hipGetDevice(&dev) != hipSuccess || hipDeviceGetAttribute(&cus, hipDeviceAttributeMultiprocessorCount, dev) != hipSuccess) { fprintf(stderr, "kernel_launch: device query failed\n"); grid = -1; return; }
        if (hipFuncSetAttribute((const void*)enc_fwd, hipFuncAttributeMaxDynamicSharedMemorySize, LDS_BYTES) != hipSuccess) { fprintf(stderr, "kernel_launch: hipFuncSetAttribute failed\n"); grid = -1; return; }
        if (hipOccupancyMaxActiveBlocksPerMultiprocessor(&per_cu, (const void*)enc_fwd, NWAVES * 64, LDS_BYTES) != hipSuccess || per_cu < 1)
            fprintf(stderr, "kernel_launch: note: occupancy query reports %d workgroups per CU\n", per_cu);
        (void)hipGetLastError();
        grid = cus;
    }
    if (grid < 0) return;
    if (hipMemsetAsync((char*)d_ws + WS_CTL, 0, CTL_ZERO_BYTES, stream) != hipSuccess) { fprintf(stderr, "kernel_launch: memset failed\n"); return; }
    Args a{};
    for (int i = 0; i < 34; ++i) a.in[i] = (const float*)d_in[i];
    a.out = (float*)d_out; a.ws = (unsigned char*)d_ws;
#if MK_ONE_LAUNCH
    a.ph_lo = 0; a.ph_hi = NPHASE;
    hipLaunchKernelGGL(enc_fwd, dim3(grid), dim3(NWAVES * 64), LDS_BYTES, stream, a);
#else
    for (int ph = 0; ph < NPHASE; ++ph) { a.ph_lo = ph; a.ph_hi = ph + 1; hipLaunchKernelGGL(enc_fwd, dim3(grid), dim3(NWAVES * 64), LDS_BYTES, stream, a); }
#endif
    const hipError_t le = hipPeekAtLastError();
    if (le != hipSuccess) fprintf(stderr, "kernel_launch: launch failed: %s\n", hipGetErrorName(le));
}
```
